# Optimizing an MI355X kernel written in HIP

```python
import math
import jax, jax.numpy as jnp
from jax import lax
import numpy as np

D_MODEL = 1024
BATCH = 8
SEQ = 4096
DEPTH = 1

CHUNK = 64
Q_BLOCK = 128
HEAD_DIM = 64
DIFF_HEADS = 4
DIFF_V_DIM = 2 * HEAD_DIM
DIFF_WIDTH = DIFF_HEADS * DIFF_V_DIM
FOX_HEADS = 8
FOX_WIDTH = FOX_HEADS * HEAD_DIM
MIX_WIDTH = DIFF_WIDTH + FOX_WIDTH
DIFF_QK_WIDTH = DIFF_HEADS * 2 * HEAD_DIM
IN_COLS = 2 * DIFF_QK_WIDTH + DIFF_WIDTH + 3 * FOX_WIDTH + FOX_HEADS
ROPE_THETA = 10000.0
N_GROUPS = 4
EXPERTS_PER_GROUP = 8
N_EXPERTS = N_GROUPS * EXPERTS_PER_GROUP
TOP_K_IN_GROUP = 2
D_EXPERT = D_MODEL // 2
MOE_BLOCK = 128
EPS = 1e-6
NEG_INF = -1e30

kernel_name = "hybrid_diff_fox_hmoe_block"


def rms_norm(x, g):
    xf = x.astype(jnp.float32)
    y = xf * lax.rsqrt(jnp.mean(xf * xf, axis=-1, keepdims=True) + EPS)
    return (y * g.astype(jnp.float32)).astype(x.dtype)


def rope_tables(seq_len, dtype):
    inv = 1.0 / (ROPE_THETA ** (jnp.arange(0, HEAD_DIM, 2, dtype=jnp.float32) / HEAD_DIM))
    ang = jnp.arange(seq_len, dtype=jnp.float32)[:, None] * inv[None, :]
    return jnp.cos(ang).astype(dtype), jnp.sin(ang).astype(dtype)


def apply_rope(x, cos, sin):
    x1, x2 = jnp.split(x, 2, axis=-1)
    c = cos[None, :, None, :]
    s = sin[None, :, None, :]
    return jnp.concatenate([x1 * c - x2 * s, x2 * c + x1 * s], axis=-1)


def diff_attention(q, k, v, lam, subln_g, lambda_init):
    B, S = q.shape[0], q.shape[1]
    scale = HEAD_DIM ** -0.5
    pos = jnp.arange(S)
    outs = []
    for i in range(S // Q_BLOCK):
        q0, q1 = i * Q_BLOCK, (i + 1) * Q_BLOCK
        s = jnp.einsum('bqhmd,bkhmd->bhmqk', q[:, q0:q1], k[:, :q1]).astype(jnp.float32) * scale
        mask = (pos[None, :q1] // CHUNK) <= (pos[q0:q1, None] // CHUNK)
        p = jax.nn.softmax(jnp.where(mask, s, NEG_INF), axis=-1)
        a = p[:, :, 0] - lam * p[:, :, 1]
        outs.append(jnp.einsum('bhqk,bkhe->bqhe', a.astype(v.dtype), v[:, :q1]))
    o = jnp.concatenate(outs, axis=1)
    return rms_norm(o, subln_g) * (1.0 - lambda_init)


def forgetting_attention(q, k, v, log_f):
    S = q.shape[1]
    scale = HEAD_DIM ** -0.5
    F = jnp.cumsum(log_f, axis=1).transpose(0, 2, 1)
    pos = jnp.arange(S)
    outs = []
    for i in range(S // Q_BLOCK):
        q0, q1 = i * Q_BLOCK, (i + 1) * Q_BLOCK
        s = jnp.einsum('bqhd,bkhd->bhqk', q[:, q0:q1], k[:, :q1]).astype(jnp.float32) * scale
        s = s + F[:, :, q0:q1, None] - F[:, :, None, :q1]
        mask = pos[None, :q1] <= pos[q0:q1, None]
        p = jax.nn.softmax(jnp.where(mask, s, NEG_INF), axis=-1)
        outs.append(jnp.einsum('bhqk,bkhd->bqhd', p.astype(v.dtype), v[:, :q1]))
    return jnp.concatenate(outs, axis=1)


def hierarchical_moe(h, w_group, b_group, w_router, b_router, w_gate, w_up, w_down):
    B, S, D = h.shape
    T = B * S
    xt = h.reshape(T, D)
    g_logits = (xt @ w_group).astype(jnp.float32) + b_group.astype(jnp.float32)
    g_prob = jax.nn.softmax(g_logits, axis=-1)
    g_idx = jnp.argmax(g_logits, axis=-1)
    g_w = jnp.take_along_axis(g_prob, g_idx[:, None], axis=1)[:, 0]
    e_logits = ((xt @ w_router).astype(jnp.float32) + b_router.astype(jnp.float32))
    e_logits = e_logits.reshape(T, N_GROUPS, EXPERTS_PER_GROUP)
    e_sel = jnp.take_along_axis(e_logits, g_idx[:, None, None], axis=1)[:, 0]
    top_v, top_i = lax.top_k(e_sel, TOP_K_IN_GROUP)
    weights = g_w[:, None] * jax.nn.softmax(top_v, axis=-1)
    expert_ids = g_idx[:, None] * EXPERTS_PER_GROUP + top_i
    M = T * TOP_K_IN_GROUP
    flat_e = expert_ids.reshape(M)
    flat_w = weights.reshape(M)
    flat_tok = jnp.arange(M) // TOP_K_IN_GROUP
    order = jnp.argsort(flat_e)
    e_sorted, tok_sorted, w_sorted = flat_e[order], flat_tok[order], flat_w[order]
    counts = jnp.bincount(flat_e, length=N_EXPERTS)
    start = jnp.cumsum(counts) - counts
    padded = ((counts + MOE_BLOCK - 1) // MOE_BLOCK) * MOE_BLOCK
    pend = jnp.cumsum(padded)
    pstart = pend - padded
    dest = pstart[e_sorted] + (jnp.arange(M) - start[e_sorted])
    n_blocks = -(-M // MOE_BLOCK) + N_EXPERTS
    P = n_blocks * MOE_BLOCK
    buf = jnp.zeros((P, D), h.dtype).at[dest].set(xt[tok_sorted])
    block_e = jnp.minimum(jnp.searchsorted(pend, jnp.arange(n_blocks) * MOE_BLOCK, side='right'),
                          N_EXPERTS - 1)

    def expert_block(args):
        xb, e = args
        a = xb @ w_gate[e]
        u = xb @ w_up[e]
        return (jax.nn.silu(a) * u) @ w_down[e]

    out = lax.map(expert_block, (buf.reshape(n_blocks, MOE_BLOCK, D), block_e))
    y_sorted = out.reshape(P, D)[dest] * w_sorted[:, None].astype(h.dtype)
    y = jax.ops.segment_sum(y_sorted, tok_sorted, num_segments=T)
    return y.reshape(B, S, D)


def setup_inputs(seed: int = 0) -> dict:
    key = jax.random.key(seed)
    ks = jax.random.split(key, 24)
    f32 = jnp.float32
    L, D, E, Fd = DEPTH, D_MODEL, N_EXPERTS, D_EXPERT
    nrm = lambda k, shape, s: jax.random.normal(k, shape, f32) * s
    gain = lambda k, shape: 1.0 + 0.01 * jax.random.normal(k, shape, f32)
    return {
        "x": jax.random.normal(ks[0], (BATCH, SEQ, D), f32),
        "c": jax.random.normal(ks[1], (BATCH, D), f32),
        "w_ada": nrm(ks[2], (L, D, 6 * D), 0.5 * D ** -0.5),
        "b_ada": nrm(ks[3], (L, 6 * D), 0.01),
        "g_pre_attn": gain(ks[4], (L, D)),
        "g_post_attn": gain(ks[5], (L, D)),
        "w_in": nrm(ks[6], (L, D, IN_COLS), D ** -0.5),
        "b_forget": 3.0 + 2.0 * jax.random.uniform(ks[7], (L, FOX_HEADS), f32),
        "lambda_q1": nrm(ks[8], (L, HEAD_DIM), 0.1),
        "lambda_k1": nrm(ks[9], (L, HEAD_DIM), 0.1),
        "lambda_q2": nrm(ks[10], (L, HEAD_DIM), 0.1),
        "lambda_k2": nrm(ks[11], (L, HEAD_DIM), 0.1),
        "g_diff_subln": gain(ks[12], (L, DIFF_V_DIM)),
        "w_out": nrm(ks[13], (L, MIX_WIDTH, D), MIX_WIDTH ** -0.5),
        "g_pre_ffn": gain(ks[14], (L, D)),
        "g_post_ffn": gain(ks[15], (L, D)),
        "w_group": nrm(ks[16], (L, D, N_GROUPS), D ** -0.5),
        "b_group": nrm(ks[17], (L, N_GROUPS), 0.01),
        "w_router": nrm(ks[18], (L, D, E), D ** -0.5),
        "b_router": nrm(ks[19], (L, E), 0.01),
        "w_gate": nrm(ks[20], (L, E, D, Fd), D ** -0.5),
        "w_up": nrm(ks[21], (L, E, D, Fd), D ** -0.5),
        "w_down": nrm(ks[22], (L, E, Fd, D), Fd ** -0.5),
    }


def reference(x, c, w_ada, b_ada, g_pre_attn, g_post_attn, w_in, b_forget,
              lambda_q1, lambda_k1, lambda_q2, lambda_k2, g_diff_subln, w_out,
              g_pre_ffn, g_post_ffn, w_group, b_group, w_router, b_router,
              w_gate, w_up, w_down):
    B, S, D = x.shape
    cos, sin = rope_tables(S, x.dtype)
    split_at = np.cumsum([DIFF_QK_WIDTH, DIFF_QK_WIDTH, DIFF_WIDTH,
                          FOX_WIDTH, FOX_WIDTH, FOX_WIDTH]).tolist()
    for l in range(DEPTH):
        lambda_init = 0.8 - 0.6 * math.exp(-0.3 * l)
        mod = (jax.nn.silu(c) @ w_ada[l] + b_ada[l])[:, None, :]
        sh_a, sc_a, gt_a, sh_f, sc_f, gt_f = jnp.split(mod, 6, axis=-1)

        h = rms_norm(x, g_pre_attn[l]) * (1.0 + sc_a) + sh_a
        proj = h @ w_in[l]
        dq, dk, dv, fq, fk, fv, f_logit = jnp.split(proj, split_at, axis=-1)

        dq = apply_rope(dq.reshape(B, S, 2 * DIFF_HEADS, HEAD_DIM), cos, sin)
        dk = apply_rope(dk.reshape(B, S, 2 * DIFF_HEADS, HEAD_DIM), cos, sin)
        dq = dq.reshape(B, S, DIFF_HEADS, 2, HEAD_DIM)
        dk = dk.reshape(B, S, DIFF_HEADS, 2, HEAD_DIM)
        dv = dv.reshape(B, S, DIFF_HEADS, DIFF_V_DIM)
        lam = (jnp.exp(jnp.sum(lambda_q1[l].astype(jnp.float32) * lambda_k1[l].astype(jnp.float32)))
               - jnp.exp(jnp.sum(lambda_q2[l].astype(jnp.float32) * lambda_k2[l].astype(jnp.float32)))
               + lambda_init)
        diff_out = diff_attention(dq, dk, dv, lam, g_diff_subln[l], lambda_init)

        log_f = jax.nn.log_sigmoid((f_logit + b_forget[l]).astype(jnp.float32))
        fox_out = forgetting_attention(fq.reshape(B, S, FOX_HEADS, HEAD_DIM),
                                       fk.reshape(B, S, FOX_HEADS, HEAD_DIM),
                                       fv.reshape(B, S, FOX_HEADS, HEAD_DIM), log_f)

        mixed = jnp.concatenate([diff_out.reshape(B, S, DIFF_WIDTH),
                                 fox_out.reshape(B, S, FOX_WIDTH)], axis=-1) @ w_out[l]
        x = x + gt_a * rms_norm(mixed, g_post_attn[l])

        h = rms_norm(x, g_pre_ffn[l]) * (1.0 + sc_f) + sh_f
        y = hierarchical_moe(h, w_group[l], b_group[l], w_router[l], b_router[l],
                             w_gate[l], w_up[l], w_down[l])
        x = x + gt_f * rms_norm(y, g_post_ffn[l])
    return x
```

```cpp
#include <hip/hip_runtime.h>
#include <cstdio>
#include <cstdint>

namespace {
constexpr int NB = 8, SEQ = 4096, T = NB * SEQ, D = 1024, NQKV = 3072, INC = 3080, NE = 32, DE = 512;
constexpr float EPS = 1e-6f;
constexpr size_t MiB = 1u << 20;
constexpr size_t WS_CTL = 0, CTL_BYTES = 1 * MiB;
constexpr size_t WS_MOD = 1 * MiB;
constexpr size_t WS_SCAL = WS_MOD + 256 * 1024;
constexpr size_t WS_WF = WS_MOD + 512 * 1024;
constexpr size_t WS_ROPE = 2 * MiB;
constexpr size_t WS_LOGF = 3 * MiB;
constexpr size_t WS_F = 4 * MiB;
constexpr size_t WS_TOKE = 5 * MiB;
constexpr size_t WS_TOKW = WS_TOKE + 256 * 1024;
constexpr size_t WS_LIST = 6 * MiB;
constexpr size_t WS_WIN = 10 * MiB;
constexpr size_t WS_WOUT = 16 * MiB;
constexpr size_t WS_WGU = 18 * MiB;
constexpr size_t WS_WD = 82 * MiB;
constexpr size_t WS_H = 114 * MiB;
constexpr size_t WS_R = 178 * MiB;
constexpr size_t WS_ACT = WS_R + 128 * MiB;
constexpr size_t WS_END = WS_R + 192 * MiB;

typedef unsigned short bf16;
typedef unsigned v4u __attribute__((ext_vector_type(4)));
typedef unsigned v2u __attribute__((ext_vector_type(2)));
typedef float f32x4 __attribute__((ext_vector_type(4)));

__device__ __forceinline__ unsigned f2bf(float f) { unsigned u = __builtin_bit_cast(unsigned, f); return (u + 0x7fffu + ((u >> 16) & 1u)) >> 16; }
__device__ __forceinline__ unsigned pk2(float lo, float hi) { return f2bf(lo) | (f2bf(hi) << 16); }
__device__ __forceinline__ float bf2f(unsigned short b) { return __builtin_bit_cast(float, (unsigned)b << 16); }
__device__ __forceinline__ float bflo(unsigned w) { return __builtin_bit_cast(float, w << 16); }
__device__ __forceinline__ float bfhi(unsigned w) { return __builtin_bit_cast(float, w & 0xffff0000u); }
__device__ __forceinline__ float wave_sum(float v) {
#pragma unroll
    for (int o = 1; o < 64; o <<= 1) v += __shfl_xor(v, o);
    return v;
}
__device__ __forceinline__ float wave_max(float v) {
#pragma unroll
    for (int o = 1; o < 64; o <<= 1) v = fmaxf(v, __shfl_xor(v, o));
    return v;
}
__device__ __forceinline__ float siluf(float v) { return v / (1.f + __expf(-v)); }

struct P {
    const float *x, *c, *w_ada, *b_ada, *g_pre_attn, *g_post_attn, *w_in, *b_forget, *lq1, *lk1, *lq2, *lk2, *g_subln, *w_out, *g_pre_ffn, *g_post_ffn,
        *w_group, *b_group, *w_router, *b_router, *w_gate, *w_up, *w_down;
    float* out; unsigned char* ws;
};

__device__ __forceinline__ void transpose_item(const float* W, int ldw, int K, bf16* WT, int k0, int n0, int dst_row0, float* scr, int lane) {
#pragma unroll 8
    for (int i = 0; i < 32; ++i) { const int kk = 2 * i + (lane >> 5); scr[kk * 33 + (lane & 31)] = W[(size_t)(k0 + kk) * ldw + n0 + (lane & 31)]; }
    __builtin_amdgcn_s_waitcnt(0xc07f); asm volatile("" ::: "memory");
    const int c = lane & 7;
#pragma unroll
    for (int j = 0; j < 4; ++j) { const int n = (lane >> 3) + 8 * j; const float* s = scr + (8 * c) * 33 + n;
        v4u o; o.x = pk2(s[0 * 33], s[1 * 33]); o.y = pk2(s[2 * 33], s[3 * 33]); o.z = pk2(s[4 * 33], s[5 * 33]); o.w = pk2(s[6 * 33], s[7 * 33]);
        *(v4u*)(WT + (size_t)(dst_row0 + n) * K + k0 + 8 * c) = o; }
    __builtin_amdgcn_s_waitcnt(0xc07f); asm volatile("" ::: "memory");
}

__device__ __forceinline__ void prologue_phase(const P& p, unsigned char* lds, int bid, int nblk) {
    const int tid = threadIdx.x, lane = tid & 63, wave = tid >> 6;
    bf16* WinT = (bf16*)(p.ws + WS_WIN); bf16* WoutT = (bf16*)(p.ws + WS_WOUT); bf16* WguT = (bf16*)(p.ws + WS_WGU); bf16* WdT = (bf16*)(p.ws + WS_WD);
    float* mod = (float*)(p.ws + WS_MOD);
    {
        float* sc = (float*)lds;
        float* part = (float*)(lds + 32768);
        bool loaded = false;
        for (int it = bid; it < 96; it += nblk) {
            if (!loaded) { for (int i = tid; i < 8192; i += 512) { const int b = i >> 10, k = i & 1023; sc[k * 8 + b] = siluf(p.c[i]); } loaded = true; __syncthreads(); }
            const int n = it * 64 + lane; float acc[8];
#pragma unroll
            for (int b = 0; b < 8; ++b) acc[b] = 0.f;
            const int kb = wave * 128;
#pragma unroll 8
            for (int k = 0; k < 128; ++k) { const float w = p.w_ada[(size_t)(kb + k) * 6144 + n]; const f32x4 s0 = *(const f32x4*)(sc + (kb + k) * 8), s1 = *(const f32x4*)(sc + (kb + k) * 8 + 4);
                acc[0] += s0.x * w; acc[1] += s0.y * w; acc[2] += s0.z * w; acc[3] += s0.w * w; acc[4] += s1.x * w; acc[5] += s1.y * w; acc[6] += s1.z * w; acc[7] += s1.w * w; }
#pragma unroll
            for (int b = 0; b < 8; ++b) part[(wave * 8 + b) * 64 + lane] = acc[b];
            __syncthreads();
            { const int b = tid >> 6; float s = p.b_ada[it * 64 + lane];
#pragma unroll
              for (int w = 0; w < 8; ++w) s += part[(w * 8 + b) * 64 + lane];
              mod[b * 6144 + it * 64 + lane] = s; }
            __syncthreads();
        }
        __syncthreads();
    }
    {
        float* scr = (float*)(lds + wave * 8448);
        const int gw = bid * 8 + wave, ngw = nblk * 8;
        constexpr int I_IN = 16 * 96, I_OUT = 16 * 32, I_G = 16 * 16, I_D = 8 * 32, I_E = 2 * I_G + I_D;
        constexpr int NITEMS = I_IN + I_OUT + NE * I_E;
        for (int it = gw; it < NITEMS; it += ngw) {
            int r = it;
            if (r < I_IN) { const int kb = r / 96, nb = r % 96; transpose_item(p.w_in, INC, D, WinT, 64 * kb, 32 * nb, 32 * nb, scr, lane); continue; } r -= I_IN;
            if (r < I_OUT) { const int kb = r / 32, nb = r % 32; transpose_item(p.w_out, D, D, WoutT, 64 * kb, 32 * nb, 32 * nb, scr, lane); continue; } r -= I_OUT;
            const int e = r / I_E; r -= e * I_E;
            if (r < 2 * I_G) { const int half = r / I_G; r -= half * I_G; const int kb = r / 16, nb = r % 16, j0 = 32 * nb;
                transpose_item((half ? p.w_up : p.w_gate) + (size_t)e * D * DE, DE, D, WguT + (size_t)e * D * D, 64 * kb, j0, (j0 >> 7) * 256 + half * 128 + (j0 & 127), scr, lane); continue; }
            r -= 2 * I_G;
            { const int kb = r / 32, nb = r % 32; transpose_item(p.w_down + (size_t)e * DE * D, D, DE, WdT + (size_t)e * D * DE, 64 * kb, 32 * nb, 32 * nb, scr, lane); }
        }
    }
    {
        const int gt = bid * 512 + tid, ngt = nblk * 512;
        float* cosT = (float*)(p.ws + WS_ROPE); float* sinT = cosT + SEQ * 32;
        for (int i = gt; i < SEQ * 32; i += ngt) { const int pos = i >> 5, f = i & 31;
            const float inv = (float)(1.0 / pow(10000.0, (double)f / 32.0)); const float ang = (float)pos * inv;
            cosT[i] = (float)cos((double)ang); sinT[i] = (float)sin((double)ang); }
        float* wf = (float*)(p.ws + WS_WF);
        for (int i = gt; i < D * 8; i += ngt) wf[i] = p.w_in[(size_t)(i >> 3) * INC + NQKV + (i & 7)];
        if (gt == 0) { float a = 0.f, b = 0.f; for (int i = 0; i < 64; ++i) { a += p.lq1[i] * p.lk1[i]; b += p.lq2[i] * p.lk2[i]; }
            ((float*)(p.ws + WS_SCAL))[0] = expf(a) - expf(b) + 0.2f; }
    }
}

__device__ __forceinline__ void norm1_phase(const P& p, int gw, int ngw, int lane) {
    const float* mod = (const float*)(p.ws + WS_MOD); const float* wf = (const float*)(p.ws + WS_WF);
    bf16* H = (bf16*)(p.ws + WS_H); float* logf_ = (float*)(p.ws + WS_LOGF);
    for (int row = gw; row < T; row += ngw) {
        const int b = row >> 12;
        const f32x4* xr = (const f32x4*)(p.x + (size_t)row * D) + lane;
        f32x4 v[4]; float ss = 0.f;
#pragma unroll
        for (int j = 0; j < 4; ++j) { v[j] = xr[64 * j]; ss += (v[j].x * v[j].x + v[j].y * v[j].y) + (v[j].z * v[j].z + v[j].w * v[j].w); }
        const float rinv = rsqrtf(wave_sum(ss) * (1.f / D) + EPS);
        float fl[8];
#pragma unroll
        for (int q = 0; q < 8; ++q) fl[q] = 0.f;
#pragma unroll
        for (int j = 0; j < 4; ++j) {
            const int col = 4 * lane + 256 * j;
            const f32x4 g = *(const f32x4*)(p.g_pre_attn + col), sc = *(const f32x4*)(mod + b * 6144 + 1024 + col), sh = *(const f32x4*)(mod + b * 6144 + col);
            f32x4 h; h.x = v[j].x * rinv * g.x * (1.f + sc.x) + sh.x; h.y = v[j].y * rinv * g.y * (1.f + sc.y) + sh.y; h.z = v[j].z * rinv * g.z * (1.f + sc.z) + sh.z; h.w = v[j].w * rinv * g.w * (1.f + sc.w) + sh.w;
            v2u o; o.x = pk2(h.x, h.y); o.y = pk2(h.z, h.w); *(v2u*)(H + (size_t)row * D + col) = o;
#pragma unroll
            for (int e = 0; e < 4; ++e) { const float hv = h[e]; const f32x4 w0 = *(const f32x4*)(wf + (col + e) * 8), w1 = *(const f32x4*)(wf + (col + e) * 8 + 4);
                fl[0] += hv * w0.x; fl[1] += hv * w0.y; fl[2] += hv * w0.z; fl[3] += hv * w0.w; fl[4] += hv * w1.x; fl[5] += hv * w1.y; fl[6] += hv * w1.z; fl[7] += hv * w1.w; }
        }
#pragma unroll
        for (int q = 0; q < 8; ++q) fl[q] = wave_sum(fl[q]);
        if (lane < 8) { float z = 0.f;
#pragma unroll
            for (int q = 0; q < 8; ++q) if (lane == q) z = fl[q];
            z += p.b_forget[lane];
            logf_[(size_t)row * 8 + lane] = fminf(z, 0.f) - log1pf(expf(-fabsf(z))); }
    }
}

__device__ __forceinline__ void scan_phase(const P& p, float* red  , int bid, int nblk) {
    const int tid = threadIdx.x, lane = tid & 63, wave = tid >> 6;
    const float* logf_ = (const float*)(p.ws + WS_LOGF); float* F = (float*)(p.ws + WS_F);
    for (int it = bid; it < 64; it += nblk) {
        const int b = it >> 3, h = it & 7;
        float v[8]; float s = 0.f;
#pragma unroll
        for (int i = 0; i < 8; ++i) { v[i] = logf_[((size_t)b * SEQ + tid * 8 + i) * 8 + h]; s += v[i]; v[i] = s; }
        float incl = s;
#pragma unroll
        for (int o = 1; o < 64; o <<= 1) { const float t = __shfl_up(incl, o); if (lane >= o) incl += t; }
        if (lane == 63) red[wave] = incl;
        __syncthreads();
        float base = incl - s;
        for (int w = 0; w < wave; ++w) base += red[w];
#pragma unroll
        for (int i = 0; i < 8; ++i) F[((size_t)b * 8 + h) * SEQ + tid * 8 + i] = base + v[i];
        __syncthreads();
    }
}

__device__ __forceinline__ void router_phase(const P& p, int gw, int ngw, int lane) {
    const float* mod = (const float*)(p.ws + WS_MOD); const float* mixed = (const float*)(p.ws + WS_R);
    bf16* H = (bf16*)(p.ws + WS_H); unsigned* cnt = (unsigned*)(p.ws + WS_CTL);
    int* toke = (int*)(p.ws + WS_TOKE); float* tokw = (float*)(p.ws + WS_TOKW); int* list = (int*)(p.ws + WS_LIST);
    for (int row = gw; row < T; row += ngw) {
        const int b = row >> 12;
        const f32x4* xr = (const f32x4*)(p.x + (size_t)row * D) + lane; const f32x4* mr = (const f32x4*)(mixed + (size_t)row * D) + lane;
        f32x4 xv[4], mv[4]; float ss = 0.f;
#pragma unroll
        for (int j = 0; j < 4; ++j) { xv[j] = xr[64 * j]; mv[j] = mr[64 * j]; ss += (mv[j].x * mv[j].x + mv[j].y * mv[j].y) + (mv[j].z * mv[j].z + mv[j].w * mv[j].w); }
        const float rinv = rsqrtf(wave_sum(ss) * (1.f / D) + EPS);
        float ss2 = 0.f;
#pragma unroll
        for (int j = 0; j < 4; ++j) { const int col = 4 * lane + 256 * j;
            const f32x4 g = *(const f32x4*)(p.g_post_attn + col), gt = *(const f32x4*)(mod + b * 6144 + 2048 + col);
#pragma unroll
            for (int e = 0; e < 4; ++e) { xv[j][e] = xv[j][e] + gt[e] * (mv[j][e] * rinv * g[e]); ss2 += xv[j][e] * xv[j][e]; }
            *((f32x4*)(p.out + (size_t)row * D) + lane + 64 * j) = xv[j]; }
        const float rinv2 = rsqrtf(wave_sum(ss2) * (1.f / D) + EPS);
        float gl[4] = {0.f, 0.f, 0.f, 0.f};
#pragma unroll
        for (int j = 0; j < 4; ++j) { const int col = 4 * lane + 256 * j;
            const f32x4 g = *(const f32x4*)(p.g_pre_ffn + col), sc = *(const f32x4*)(mod + b * 6144 + 4096 + col), sh = *(const f32x4*)(mod + b * 6144 + 3072 + col);
#pragma unroll
            for (int e = 0; e < 4; ++e) { const float h = xv[j][e] * rinv2 * g[e] * (1.f + sc[e]) + sh[e]; xv[j][e] = h; const f32x4 w = *(const f32x4*)(p.w_group + (col + e) * 4);
                gl[0] += h * w.x; gl[1] += h * w.y; gl[2] += h * w.z; gl[3] += h * w.w; }
            v2u o; o.x = pk2(xv[j].x, xv[j].y); o.y = pk2(xv[j].z, xv[j].w); *(v2u*)(H + (size_t)row * D + col) = o; }
#pragma unroll
        for (int q = 0; q < 4; ++q) gl[q] = wave_sum(gl[q]) + p.b_group[q];
        int gi = 0; float gm = gl[0];
#pragma unroll
        for (int q = 1; q < 4; ++q) if (gl[q] > gm) { gm = gl[q]; gi = q; }
        float gs = 0.f;
#pragma unroll
        for (int q = 0; q < 4; ++q) gs += __expf(gl[q] - gm);
        const float gwt = 1.f / gs;
        float el[8];
#pragma unroll
        for (int q = 0; q < 8; ++q) el[q] = 0.f;
#pragma unroll
        for (int j = 0; j < 4; ++j) { const int col = 4 * lane + 256 * j;
#pragma unroll
            for (int e = 0; e < 4; ++e) { const float h = xv[j][e]; const f32x4 w0 = *(const f32x4*)(p.w_router + (col + e) * 32 + gi * 8), w1 = *(const f32x4*)(p.w_router + (col + e) * 32 + gi * 8 + 4);
                el[0] += h * w0.x; el[1] += h * w0.y; el[2] += h * w0.z; el[3] += h * w0.w; el[4] += h * w1.x; el[5] += h * w1.y; el[6] += h * w1.z; el[7] += h * w1.w; } }
#pragma unroll
        for (int q = 0; q < 8; ++q) el[q] = wave_sum(el[q]) + p.b_router[gi * 8 + q];
        int i1 = 0; float v1 = el[0];
#pragma unroll
        for (int q = 1; q < 8; ++q) if (el[q] > v1) { v1 = el[q]; i1 = q; }
        int i2 = -1; float v2 = -3.0e38f;
#pragma unroll
        for (int q = 0; q < 8; ++q) if (q != i1 && el[q] > v2) { v2 = el[q]; i2 = q; }
        const float e2 = __expf(v2 - v1); const float w1 = gwt / (1.f + e2), w2 = gwt * e2 / (1.f + e2);
        if (lane < 2) { const int e = gi * 8 + (lane == 0 ? i1 : i2); const float w = lane == 0 ? w1 : w2; const int slot = row * 2 + lane;
            toke[slot] = e; tokw[slot] = w; const unsigned pos = atomicAdd(cnt + e, 1u); list[e * T + pos] = slot; }
    }
}

__device__ __forceinline__ void final_phase(const P& p, int gw, int ngw, int lane) {
    const float* mod = (const float*)(p.ws + WS_MOD); const bf16* YS = (const bf16*)(p.ws + WS_R); const float* tokw = (const float*)(p.ws + WS_TOKW);
    for (int row = gw; row < T; row += ngw) {
        const int b = row >> 12; const float w0 = tokw[row * 2], w1 = tokw[row * 2 + 1];
        const v2u* y0 = (const v2u*)(YS + (size_t)(row * 2) * D) + lane; const v2u* y1 = (const v2u*)(YS + (size_t)(row * 2 + 1) * D) + lane;
        f32x4 y[4]; float ss = 0.f;
#pragma unroll
        for (int j = 0; j < 4; ++j) { const v2u a = y0[64 * j], c = y1[64 * j];
            y[j].x = w0 * bflo(a.x) + w1 * bflo(c.x); y[j].y = w0 * bfhi(a.x) + w1 * bfhi(c.x); y[j].z = w0 * bflo(a.y) + w1 * bflo(c.y); y[j].w = w0 * bfhi(a.y) + w1 * bfhi(c.y);
            ss += (y[j].x * y[j].x + y[j].y * y[j].y) + (y[j].z * y[j].z + y[j].w * y[j].w); }
        const float rinv = rsqrtf(wave_sum(ss) * (1.f / D) + EPS);
#pragma unroll
        for (int j = 0; j < 4; ++j) { const int col = 4 * lane + 256 * j; f32x4* o = (f32x4*)(p.out + (size_t)row * D) + lane + 64 * j;
            const f32x4 g = *(const f32x4*)(p.g_post_ffn + col), gt = *(const f32x4*)(mod + b * 6144 + 5120 + col); f32x4 x1 = *o;
#pragma unroll
            for (int e = 0; e < 4; ++e) x1[e] += gt[e] * (y[j][e] * rinv * g[e]);
            *o = x1; }
    }
}

template <int NBM> struct NaiveAcc { float a[NBM][4][4]; };
template <int NBM>
__device__ __forceinline__ void naive_tile(const bf16* const (&arow)[1], const bf16* aptr  , const bf16* const (&bptr)[NBM]  , int K, float* lds, NaiveAcc<NBM>& acc) {
    (void)arow;
    const int tid = threadIdx.x, tx = tid & 15, ty = tid >> 4, lr = tid >> 2, kc = tid & 3;
    float* As = lds; float* Bs = lds + 32 * 65;
#pragma unroll
    for (int m = 0; m < NBM; ++m)
#pragma unroll
        for (int i = 0; i < 4; ++i)
#pragma unroll
            for (int j = 0; j < 4; ++j) acc.a[m][i][j] = 0.f;
    for (int k0 = 0; k0 < K; k0 += 32) {
        v4u av = {0u, 0u, 0u, 0u}; if (aptr) av = *(const v4u*)(aptr + k0 + 8 * kc);
        v4u bv[NBM];
#pragma unroll
        for (int m = 0; m < NBM; ++m) bv[m] = *(const v4u*)(bptr[m] + k0 + 8 * kc);
        __syncthreads();
#pragma unroll
        for (int e = 0; e < 4; ++e) { As[(8 * kc + 2 * e) * 65 + lr] = bflo(av[e]); As[(8 * kc + 2 * e + 1) * 65 + lr] = bfhi(av[e]);
#pragma unroll
            for (int m = 0; m < NBM; ++m) { Bs[m * 32 * 65 + (8 * kc + 2 * e) * 65 + lr] = bflo(bv[m][e]); Bs[m * 32 * 65 + (8 * kc + 2 * e + 1) * 65 + lr] = bfhi(bv[m][e]); } }
        __syncthreads();
#pragma unroll 8
        for (int kk = 0; kk < 32; ++kk) { float a[4], bb[NBM][4];
#pragma unroll
            for (int i = 0; i < 4; ++i) a[i] = As[kk * 65 + ty + 16 * i];
#pragma unroll
            for (int m = 0; m < NBM; ++m)
#pragma unroll
                for (int j = 0; j < 4; ++j) bb[m][j] = Bs[m * 32 * 65 + kk * 65 + tx + 16 * j];
#pragma unroll
            for (int m = 0; m < NBM; ++m)
#pragma unroll
                for (int i = 0; i < 4; ++i)
#pragma unroll
                    for (int j = 0; j < 4; ++j) acc.a[m][i][j] += a[i] * bb[m][j]; }
    }
}

__global__ void __launch_bounds__(256) k_inproj(P p) {
    __shared__ float lds[2 * 32 * 65];
    const int tid = threadIdx.x, tx = tid & 15, ty = tid >> 4, lr = tid >> 2;
    const int pm = blockIdx.x, pn = blockIdx.y;
    const bf16* H = (const bf16*)(p.ws + WS_H); const bf16* W = (const bf16*)(p.ws + WS_WIN); bf16* QKV = (bf16*)(p.ws + WS_R);
    const bf16* const dummy[1] = {nullptr}; const bf16* const bp[1] = {W + (size_t)(pn * 64 + lr) * D};
    NaiveAcc<1> acc; naive_tile<1>(dummy, H + (size_t)(pm * 64 + lr) * D, bp, D, lds, acc);
    const float* cosT = (const float*)(p.ws + WS_ROPE); const float* sinT = cosT + SEQ * 32;
    const bool rope = pn < 16; const float scale = (pn < 8 || (pn >= 24 && pn < 32)) ? 0.125f : 1.f;
#pragma unroll
    for (int i = 0; i < 4; ++i) { const int row = pm * 64 + ty + 16 * i, pos = row & (SEQ - 1);
        float v[4];
#pragma unroll
        for (int j = 0; j < 4; ++j) v[j] = acc.a[0][i][j];
        if (rope) {
#pragma unroll
            for (int j = 0; j < 2; ++j) { const int f = tx + 16 * j; const float c = cosT[pos * 32 + f], s = sinT[pos * 32 + f]; const float x1 = v[j], x2 = v[j + 2]; v[j] = x1 * c - x2 * s; v[j + 2] = x2 * c + x1 * s; } }
#pragma unroll
        for (int j = 0; j < 4; ++j) QKV[(size_t)row * NQKV + pn * 64 + tx + 16 * j] = (bf16)f2bf(v[j] * scale); }
}

__global__ void __launch_bounds__(256) k_outproj(P p) {
    __shared__ float lds[2 * 32 * 65];
    const int tid = threadIdx.x, tx = tid & 15, ty = tid >> 4, lr = tid >> 2;
    const int pm = blockIdx.x, pn = blockIdx.y;
    const bf16* A = (const bf16*)(p.ws + WS_H); const bf16* W = (const bf16*)(p.ws + WS_WOUT); float* C = (float*)(p.ws + WS_R);
    const bf16* const dummy[1] = {nullptr}; const bf16* const bp[1] = {W + (size_t)(pn * 64 + lr) * D};
    NaiveAcc<1> acc; naive_tile<1>(dummy, A + (size_t)(pm * 64 + lr) * D, bp, D, lds, acc);
#pragma unroll
    for (int i = 0; i < 4; ++i)
#pragma unroll
        for (int j = 0; j < 4; ++j) C[(size_t)(pm * 64 + ty + 16 * i) * D + pn * 64 + tx + 16 * j] = acc.a[0][i][j];
}

__device__ __forceinline__ bool moe_tile(const unsigned* cnt, int tl, int& e, int& base) {
    for (e = 0; e < NE; ++e) { const int nt = ((int)cnt[e] + 63) >> 6; if (tl < nt) { base = tl * 64; return true; } tl -= nt; }
    return false;
}
__global__ void __launch_bounds__(256) k_moe1(P p) {
    __shared__ float lds[3 * 32 * 65];
    const int tid = threadIdx.x, tx = tid & 15, ty = tid >> 4, lr = tid >> 2;
    const unsigned* cnt = (const unsigned*)(p.ws + WS_CTL); const int* list = (const int*)(p.ws + WS_LIST);
    int e, base; if (!moe_tile(cnt, blockIdx.x, e, base)) return;
    const int n = (int)cnt[e]; const int pn = blockIdx.y;
    const bf16* H = (const bf16*)(p.ws + WS_H); const bf16* W = (const bf16*)(p.ws + WS_WGU) + (size_t)e * D * D; bf16* ACT = (bf16*)(p.ws + WS_ACT);
    const int myslot = (base + lr < n) ? list[e * T + base + lr] : -1;
    const int j = pn * 64 + lr, rg = (j >> 7) * 256 + (j & 127);
    const bf16* const dummy[1] = {nullptr}; const bf16* const bp[2] = {W + (size_t)rg * D, W + (size_t)(rg + 128) * D};
    NaiveAcc<2> acc; naive_tile<2>(dummy, myslot >= 0 ? H + (size_t)(myslot >> 1) * D : nullptr, bp, D, lds, acc);
#pragma unroll
    for (int i = 0; i < 4; ++i) { const int r = base + ty + 16 * i; if (r >= n) continue; const int slot = list[e * T + r];
#pragma unroll
        for (int jj = 0; jj < 4; ++jj) ACT[(size_t)slot * DE + pn * 64 + tx + 16 * jj] = (bf16)f2bf(siluf(acc.a[0][i][jj]) * acc.a[1][i][jj]); }
}
__global__ void __launch_bounds__(256) k_moe2(P p) {
    __shared__ float lds[2 * 32 * 65];
    const int tid = threadIdx.x, tx = tid & 15, ty = tid >> 4, lr = tid >> 2;
    const unsigned* cnt = (const unsigned*)(p.ws + WS_CTL); const int* list = (const int*)(p.ws + WS_LIST);
    int e, base; if (!moe_tile(cnt, blockIdx.x, e, base)) return;
    const int n = (int)cnt[e]; const int pn = blockIdx.y;
    const bf16* ACT = (const bf16*)(p.ws + WS_ACT); const bf16* W = (const bf16*)(p.ws + WS_WD) + (size_t)e * D * DE; bf16* YS = (bf16*)(p.ws + WS_R);
    const int myslot = (base + lr < n) ? list[e * T + base + lr] : -1;
    const bf16* const dummy[1] = {nullptr}; const bf16* const bp[1] = {W + (size_t)(pn * 64 + lr) * DE};
    NaiveAcc<1> acc; naive_tile<1>(dummy, myslot >= 0 ? ACT + (size_t)myslot * DE : nullptr, bp, DE, lds, acc);
#pragma unroll
    for (int i = 0; i < 4; ++i) { const int r = base + ty + 16 * i; if (r >= n) continue; const int slot = list[e * T + r];
#pragma unroll
        for (int jj = 0; jj < 4; ++jj) YS[(size_t)slot * D + pn * 64 + tx + 16 * jj] = (bf16)f2bf(acc.a[0][i][jj]); }
}

__device__ __forceinline__ float qk_dot(const float* q, const bf16* kp) {
    float s = 0.f;
#pragma unroll
    for (int c = 0; c < 8; ++c) { const v4u kv = *(const v4u*)(kp + 8 * c); const f32x4 q0 = *(const f32x4*)(q + 8 * c), q1 = *(const f32x4*)(q + 8 * c + 4);
        s += q0.x * bflo(kv.x) + q0.y * bfhi(kv.x) + q0.z * bflo(kv.y) + q0.w * bfhi(kv.y) + q1.x * bflo(kv.z) + q1.y * bfhi(kv.z) + q1.z * bflo(kv.w) + q1.w * bfhi(kv.w); }
    return s;
}
__global__ void __launch_bounds__(256) k_attn_diff(P p) {
    __shared__ float lds[4][2 * 64 + 2 * 64];
    const int lane = threadIdx.x & 63, wave = threadIdx.x >> 6;
    const int task = blockIdx.x * 4 + wave;
    const int t = task & (SEQ - 1), h = (task >> 12) & 3, b = task >> 14;
    const bf16* QKV = (const bf16*)(p.ws + WS_R); bf16* MIX = (bf16*)(p.ws + WS_H);
    float* q0 = lds[wave]; float* q1 = q0 + 64; float* pp0 = q0 + 128; float* pp1 = q0 + 192;
    const size_t rowb = (size_t)b * SEQ;
    q0[lane] = bf2f(QKV[(rowb + t) * NQKV + (2 * h) * 64 + lane]); q1[lane] = bf2f(QKV[(rowb + t) * NQKV + (2 * h + 1) * 64 + lane]);
    __builtin_amdgcn_s_waitcnt(0xc07f); asm volatile("" ::: "memory");
    const int nk = ((t >> 6) + 1) << 6;
    float m0 = -3.0e38f, m1 = -3.0e38f, l0 = 0.f, l1 = 0.f, oa0 = 0.f, oa1 = 0.f, ob0 = 0.f, ob1 = 0.f;
    for (int s0 = 0; s0 < nk; s0 += 64) {
        const bf16* kr = QKV + (rowb + s0 + lane) * NQKV + 512 + (2 * h) * 64;
        const float sc0 = qk_dot(q0, kr), sc1 = qk_dot(q1, kr + 64);
        const float mn0 = fmaxf(m0, wave_max(sc0)), mn1 = fmaxf(m1, wave_max(sc1));
        const float a0 = __expf(m0 - mn0), a1 = __expf(m1 - mn1); const float e0 = __expf(sc0 - mn0), e1 = __expf(sc1 - mn1);
        l0 = l0 * a0 + wave_sum(e0); l1 = l1 * a1 + wave_sum(e1); oa0 *= a0; oa1 *= a0; ob0 *= a1; ob1 *= a1; m0 = mn0; m1 = mn1;
        pp0[lane] = e0; pp1[lane] = e1;
        __builtin_amdgcn_s_waitcnt(0xc07f); asm volatile("" ::: "memory");
        const bf16* vr = QKV + (rowb + s0) * NQKV + 1024 + h * 128 + lane;
#pragma unroll 4
        for (int j = 0; j < 64; ++j) { const float v0 = bf2f(vr[(size_t)j * NQKV]), v1 = bf2f(vr[(size_t)j * NQKV + 64]); const float w0 = pp0[j], w1 = pp1[j];
            oa0 += w0 * v0; oa1 += w0 * v1; ob0 += w1 * v0; ob1 += w1 * v1; }
        __builtin_amdgcn_s_waitcnt(0xc07f); asm volatile("" ::: "memory");
    }
    const float lam = ((const float*)(p.ws + WS_SCAL))[0];
    const float o0 = oa0 / l0 - lam * (ob0 / l1), o1 = oa1 / l0 - lam * (ob1 / l1);
    const float rinv = rsqrtf(wave_sum(o0 * o0 + o1 * o1) * (1.f / 128.f) + EPS);
    MIX[(rowb + t) * D + h * 128 + lane] = (bf16)f2bf(o0 * rinv * p.g_subln[lane] * 0.8f);
    MIX[(rowb + t) * D + h * 128 + 64 + lane] = (bf16)f2bf(o1 * rinv * p.g_subln[64 + lane] * 0.8f);
}
__global__ void __launch_bounds__(256) k_attn_fox(P p) {
    __shared__ float lds[4][128];
    const int lane = threadIdx.x & 63, wave = threadIdx.x >> 6;
    const int task = blockIdx.x * 4 + wave;
    const int t = task & (SEQ - 1), h = (task >> 12) & 7, b = task >> 15;
    const bf16* QKV = (const bf16*)(p.ws + WS_R); bf16* MIX = (bf16*)(p.ws + WS_H); const float* F = (const float*)(p.ws + WS_F) + ((size_t)b * 8 + h) * SEQ;
    float* q = lds[wave]; float* pp = q + 64;
    const size_t rowb = (size_t)b * SEQ;
    q[lane] = bf2f(QKV[(rowb + t) * NQKV + 1536 + h * 64 + lane]);
    __builtin_amdgcn_s_waitcnt(0xc07f); asm volatile("" ::: "memory");
    const float Ft = F[t];
    float m = -3.0e38f, l = 0.f, o = 0.f;
    for (int s0 = 0; s0 <= t; s0 += 64) {
        const int s = s0 + lane; const bool valid = s <= t; const int sc_ = valid ? s : t;
        float sc = qk_dot(q, QKV + (rowb + sc_) * NQKV + 2048 + h * 64) + Ft - F[sc_];
        if (!valid) sc = -3.0e38f;
        const float mn = fmaxf(m, wave_max(sc)); const float a = __expf(m - mn); const float e = valid ? __expf(sc - mn) : 0.f;
        l = l * a + wave_sum(e); o *= a; m = mn; pp[lane] = e;
        __builtin_amdgcn_s_waitcnt(0xc07f); asm volatile("" ::: "memory");
        const int nj = min(64, t - s0 + 1);
        const bf16* vr = QKV + (rowb + s0) * NQKV + 2560 + h * 64 + lane;
        for (int j = 0; j < nj; ++j) o += pp[j] * bf2f(vr[(size_t)j * NQKV]);
        __builtin_amdgcn_s_waitcnt(0xc07f); asm volatile("" ::: "memory");
    }
    MIX[(rowb + t) * D + 512 + h * 64 + lane] = (bf16)f2bf(o / l);
}

__global__ void __launch_bounds__(512) k_prologue(P p) { __shared__ __attribute__((aligned(16))) unsigned char lds[8 * 8448 + 49152]; prologue_phase(p, lds, blockIdx.x, gridDim.x); }
__global__ void __launch_bounds__(512) k_norm1(P p) { norm1_phase(p, blockIdx.x * 8 + (threadIdx.x >> 6), gridDim.x * 8, threadIdx.x & 63); }
__global__ void __launch_bounds__(512) k_scan(P p) { __shared__ float red[16]; scan_phase(p, red, blockIdx.x, gridDim.x); }
__global__ void __launch_bounds__(512) k_router(P p) { router_phase(p, blockIdx.x * 8 + (threadIdx.x >> 6), gridDim.x * 8, threadIdx.x & 63); }
__global__ void __launch_bounds__(512) k_final(P p) { final_phase(p, blockIdx.x * 8 + (threadIdx.x >> 6), gridDim.x * 8, threadIdx.x & 63); }
}

extern "C" void kernel_launch(void* const* d_in, const int* in_sizes, int n_in, void* d_out, int out_size, void* d_ws, size_t ws_size, hipStream_t stream) {
    if (n_in != 23 || out_size != T * D || ws_size < WS_END) { fprintf(stderr, "kernel_launch: unexpected shapes (n_in %d, out %d, ws %zu)\n", n_in, out_size, ws_size); return; }
    P p{};
    const float** f = (const float**)&p;
    for (int i = 0; i < 23; ++i) f[i] = (const float*)d_in[i];
    p.out = (float*)d_out; p.ws = (unsigned char*)d_ws;
    hipMemsetAsync((char*)d_ws + WS_CTL, 0, CTL_BYTES, stream);
    hipLaunchKernelGGL(k_prologue, dim3(256), dim3(512), 0, stream, p);
    hipLaunchKernelGGL(k_norm1, dim3(1024), dim3(512), 0, stream, p);
    hipLaunchKernelGGL(k_inproj, dim3(512, 48), dim3(256), 0, stream, p);
    hipLaunchKernelGGL(k_scan, dim3(64), dim3(512), 0, stream, p);
    hipLaunchKernelGGL(k_attn_diff, dim3(T * 4 / 4), dim3(256), 0, stream, p);
    hipLaunchKernelGGL(k_attn_fox, dim3(T * 8 / 4), dim3(256), 0, stream, p);
    hipLaunchKernelGGL(k_outproj, dim3(512, 16), dim3(256), 0, stream, p);
    hipLaunchKernelGGL(k_router, dim3(1024), dim3(512), 0, stream, p);
    hipLaunchKernelGGL(k_moe1, dim3(1056, 8), dim3(256), 0, stream, p);
    hipLaunchKernelGGL(k_moe2, dim3(1056, 16), dim3(256), 0, stream, p);
    hipLaunchKernelGGL(k_final, dim3(1024), dim3(512), 0, stream, p);
}
```

```cpp
#include <hip/hip_runtime.h>
#include <hip/hip_bf16.h>
#include <cstdio>
#include <cstdint>
#include <cmath>

namespace {
constexpr int NB = 8, SEQ = 4096, T = NB * SEQ, D = 1024, NQKV = 3072, INC = 3080, NE = 32, DE = 512;
constexpr float EPS = 1e-6f;
constexpr size_t MiB = 1u << 20;
constexpr size_t WS_CTL = 0, CTL_BYTES = 65536;
constexpr size_t WS_MOD = 1 * MiB;
constexpr size_t WS_SCAL = WS_MOD + 256 * 1024;
constexpr size_t WS_WF = WS_MOD + 512 * 1024;
constexpr size_t WS_ROPE = 2 * MiB;
constexpr size_t WS_LOGF = 3 * MiB;
constexpr size_t WS_F = 4 * MiB;
constexpr size_t WS_TOKE = 5 * MiB;
constexpr size_t WS_TOKW = WS_TOKE + 256 * 1024;
constexpr size_t WS_LIST = 6 * MiB;
constexpr size_t WS_WIN = 10 * MiB;
constexpr size_t WS_WOUT = 16 * MiB;
constexpr size_t WS_WGU = 18 * MiB;
constexpr size_t WS_WD = 82 * MiB;
constexpr size_t WS_H = 114 * MiB;
constexpr size_t WS_R = 178 * MiB;
constexpr size_t WS_ACT = WS_R + 192 * MiB;
constexpr size_t WS_X1 = WS_ACT + 72 * MiB;
constexpr size_t WS_END = WS_X1 + 64 * MiB;

typedef unsigned short bf16;
typedef unsigned v4u __attribute__((ext_vector_type(4)));
typedef unsigned v2u __attribute__((ext_vector_type(2)));
typedef float f32x4 __attribute__((ext_vector_type(4)));

__device__ __forceinline__ unsigned f2bf(float f) { unsigned u = __builtin_bit_cast(unsigned, f); return (u + 0x7fffu + ((u >> 16) & 1u)) >> 16; }
typedef float pk2f_t __attribute__((ext_vector_type(2))); typedef __bf16 pk2b_t __attribute__((ext_vector_type(2)));
__device__ __forceinline__ unsigned pk2(float lo, float hi) { const pk2f_t v = {lo, hi}; return __builtin_bit_cast(unsigned, __builtin_convertvector(v, pk2b_t)); }
__device__ __forceinline__ float bf2f(unsigned short b) { return __builtin_bit_cast(float, (unsigned)b << 16); }
__device__ __forceinline__ float bflo(unsigned w) { return __builtin_bit_cast(float, w << 16); }
__device__ __forceinline__ float bfhi(unsigned w) { return __builtin_bit_cast(float, w & 0xffff0000u); }
__device__ __forceinline__ float wave_sum(float v) {
#pragma unroll
    for (int o = 1; o < 64; o <<= 1) v += __shfl_xor(v, o);
    return v;
}
__device__ __forceinline__ float wave_max(float v) {
#pragma unroll
    for (int o = 1; o < 64; o <<= 1) v = fmaxf(v, __shfl_xor(v, o));
    return v;
}
__device__ __forceinline__ int tid_fresh() { int t = threadIdx.x; asm volatile("" : "+v"(t)); return t; }
__device__ __forceinline__ float siluf(float v) { return v / (1.f + __expf(-v)); }

struct P {
    const float *x, *c, *w_ada, *b_ada, *g_pre_attn, *g_post_attn, *w_in, *b_forget, *lq1, *lk1, *lq2, *lk2, *g_subln, *w_out, *g_pre_ffn, *g_post_ffn,
        *w_group, *b_group, *w_router, *b_router, *w_gate, *w_up, *w_down;
    float* out; unsigned char* ws;
};

__device__ __forceinline__ void transpose_item(const float* W, int ldw, int K, bf16* WT, int k0, int n0, int dst_row0, float* scr, int lane) {
#pragma unroll 8
    for (int i = 0; i < 32; ++i) { const int kk = 2 * i + (lane >> 5); scr[kk * 33 + (lane & 31)] = __builtin_nontemporal_load(W + (size_t)(k0 + kk) * ldw + n0 + (lane & 31)); }
    __builtin_amdgcn_s_waitcnt(0xc07f); asm volatile("" ::: "memory");
    const int c = lane & 7;
#pragma unroll
    for (int j = 0; j < 4; ++j) { const int n = (lane >> 3) + 8 * j; const float* s = scr + (8 * c) * 33 + n;
        v4u o; o.x = pk2(s[0 * 33], s[1 * 33]); o.y = pk2(s[2 * 33], s[3 * 33]); o.z = pk2(s[4 * 33], s[5 * 33]); o.w = pk2(s[6 * 33], s[7 * 33]);
        *(v4u*)(WT + (size_t)(dst_row0 + n) * K + k0 + 8 * c) = o; }
    __builtin_amdgcn_s_waitcnt(0xc07f); asm volatile("" ::: "memory");
}

constexpr float Q8_ACT = 127.f / 6.f, Q8_W = 127.f / 0.14f;
constexpr float Q8_ACT2 = 127.f / 8.f, Q8_WD = 127.f / 0.2f;
constexpr float Q8_MIX = 127.f / 4.f;
__device__ __forceinline__ unsigned pk4_i8(float a, float b, float c, float d, float s) {
    unsigned w = __builtin_amdgcn_cvt_pk_u8_f32(__builtin_fmaf(a, s, 128.f), 0, 0u); w = __builtin_amdgcn_cvt_pk_u8_f32(__builtin_fmaf(b, s, 128.f), 1, w);
    w = __builtin_amdgcn_cvt_pk_u8_f32(__builtin_fmaf(c, s, 128.f), 2, w); w = __builtin_amdgcn_cvt_pk_u8_f32(__builtin_fmaf(d, s, 128.f), 3, w); return w ^ 0x80808080u; }
__device__ __forceinline__ void transpose_item_i8(const float* W, int ldw, int Kp, unsigned char* WT8, int k0, int n0, int dst_row0, float* scr, int lane, float qs) {
#pragma unroll 8
    for (int i = 0; i < 32; ++i) { const int kk = 2 * i + (lane >> 5); scr[kk * 33 + (lane & 31)] = __builtin_nontemporal_load(W + (size_t)(k0 + kk) * ldw + n0 + (lane & 31)); }
    __builtin_amdgcn_s_waitcnt(0xc07f); asm volatile("" ::: "memory");
    const int c = lane & 7;
#pragma unroll
    for (int j = 0; j < 4; ++j) { const int n = (lane >> 3) + 8 * j; const float* s = scr + (8 * c) * 33 + n;
        v2u o; o.x = pk4_i8(s[0 * 33], s[1 * 33], s[2 * 33], s[3 * 33], qs); o.y = pk4_i8(s[4 * 33], s[5 * 33], s[6 * 33], s[7 * 33], qs);
        *(v2u*)(WT8 + (size_t)(dst_row0 + n) * Kp + k0 + 8 * c) = o; }
    __builtin_amdgcn_s_waitcnt(0xc07f); asm volatile("" ::: "memory");
}
constexpr int CV_IN = 16 * 96, CV_OUT = 16 * 32, CV_G = 16 * 16, CV_D = 8 * 32, CV_E = 2 * CV_G + CV_D, CV_ITEMS = CV_IN + CV_OUT + NE * CV_E;
__device__ __forceinline__ void convert_items(const P& p, unsigned char* lds, int bid, int nblk, int it0, int it1, int k0, int k1) {
    const int tid = tid_fresh(), lane = tid & 63, wv = __builtin_amdgcn_readfirstlane(tid >> 6);
    unsigned char* WinT = p.ws + WS_WIN; unsigned char* WoutT = p.ws + WS_WOUT; unsigned char* WguT = p.ws + WS_WGU; unsigned char* WdT = p.ws + WS_WD;
    float* scr = (float*)(lds + wv * 8448);
    const int gw = bid * 8 + wv, ngw = nblk * 8;
    struct TrItem { const float* W; unsigned char* WT8; int ldw, Kp, k0, n0, dst_row0; float qs; };
    auto decode = [&](int r) __attribute__((always_inline)) -> TrItem {
        TrItem t;
        if (r < CV_IN) { const int kb = r / 96, nb = r % 96, n0 = 32 * nb, hh = n0 >> 6, hf = (n0 >> 5) & 1;
            const int fo = n0 - 1536 - (n0 >= 2048 ? 512 : 0);
            t.W = p.w_in; t.WT8 = WinT; t.ldw = INC; t.Kp = D; t.k0 = 64 * kb; t.n0 = n0; t.qs = Q8_W;
            t.dst_row0 = n0 < 1024 ? (hh >> 2) * 256 + hf * 128 + (hh & 3) * 32 : (n0 >= 1536 && n0 < 2560) ? (6 + (fo >> 7)) * 256 + (n0 >= 2048 ? 128 : 0) + (fo & 127) : n0; return t; }
        r -= CV_IN;
        if (r < CV_OUT) { const int kb = r / 32, nb = r % 32; t.W = p.w_out; t.WT8 = WoutT; t.ldw = D; t.Kp = D; t.k0 = 64 * kb; t.n0 = 32 * nb; t.dst_row0 = 32 * nb; t.qs = Q8_W; return t; }
        r -= CV_OUT;
        const int e = r / CV_E; r -= e * CV_E;
        if (r < 2 * CV_G) { const int half = r / CV_G; r -= half * CV_G; const int kb = r / 16, nb = r % 16, j0 = 32 * nb;
            t.W = (half ? p.w_up : p.w_gate) + (size_t)e * D * DE; t.WT8 = WguT + (size_t)e * D * D; t.ldw = DE; t.Kp = D; t.k0 = 64 * kb; t.n0 = j0; t.dst_row0 = (j0 >> 7) * 256 + half * 128 + (j0 & 127); t.qs = Q8_W; return t; }
        r -= 2 * CV_G;
        { const int kb = r / 32, nb = r % 32; t.W = p.w_down + (size_t)e * DE * D; t.WT8 = WdT + (size_t)e * D * DE; t.ldw = D; t.Kp = DE; t.k0 = 64 * kb; t.n0 = 32 * nb; t.dst_row0 = 32 * nb; t.qs = Q8_WD; return t; }
    };
    int it = it0 + gw + k0 * ngw;
    if (k0 < k1 && it < it1) {
        float v[32];
        TrItem cur = decode(it);
#pragma unroll
        for (int i = 0; i < 32; ++i) v[i] = __builtin_nontemporal_load(cur.W + (size_t)(cur.k0 + 2 * i + (lane >> 5)) * cur.ldw + cur.n0 + (lane & 31));
        for (int k = k0; k < k1 && it < it1; ++k, it += ngw) {
#pragma unroll
            for (int i = 0; i < 32; ++i) scr[(2 * i + (lane >> 5)) * 33 + (lane & 31)] = v[i];
            const bool more = k + 1 < k1 && it + ngw < it1;
            const TrItem nxt = decode(more ? it + ngw : it);
#pragma unroll
            for (int i = 0; i < 32; ++i) v[i] = __builtin_nontemporal_load(nxt.W + (size_t)(nxt.k0 + 2 * i + (lane >> 5)) * nxt.ldw + nxt.n0 + (lane & 31));
            __builtin_amdgcn_s_waitcnt(0xc07f); asm volatile("" ::: "memory");
            const int c = lane & 7;
#pragma unroll
            for (int j = 0; j < 4; ++j) { const int n = (lane >> 3) + 8 * j; const float* sp = scr + (8 * c) * 33 + n;
                v2u o; o.x = pk4_i8(sp[0 * 33], sp[1 * 33], sp[2 * 33], sp[3 * 33], cur.qs); o.y = pk4_i8(sp[4 * 33], sp[5 * 33], sp[6 * 33], sp[7 * 33], cur.qs);
                *(v2u*)(cur.WT8 + (size_t)(cur.dst_row0 + n) * cur.Kp + cur.k0 + 8 * c) = o; }
            __builtin_amdgcn_s_waitcnt(0xc07f); asm volatile("" ::: "memory");
            cur = nxt;
        }
    }
    __syncthreads();
}
__device__ __forceinline__ void prologue_phase(const P& p, unsigned char* lds, int bid, int nblk) {
    const int tid = tid_fresh(), lane = tid & 63, wave = tid >> 6;
    unsigned char* WinT = p.ws + WS_WIN; unsigned char* WoutT = p.ws + WS_WOUT; unsigned char* WguT = p.ws + WS_WGU; unsigned char* WdT = p.ws + WS_WD;
    float* mod = (float*)(p.ws + WS_MOD);
    {
        float* sc = (float*)lds;
        float* part = (float*)(lds + 32768);
        bool loaded = false;
        for (int it = bid; it < 192; it += nblk) {
            if (!loaded) { for (int i = tid; i < 8192; i += 512) { const int b = i >> 10, k = i & 1023; sc[k * 8 + b] = siluf(p.c[i]); } loaded = true; __syncthreads(); }
            const int kr = lane >> 3, cq = lane & 7, kb = wave * 128 + kr;
            const float* wp = p.w_ada + (size_t)kb * 6144 + it * 32 + 4 * cq;
            f32x4 w[16];
#pragma unroll
            for (int i = 0; i < 16; ++i) w[i] = __builtin_nontemporal_load((const f32x4*)(wp + (size_t)(8 * i) * 6144));
            f32x4 acc[8];
#pragma unroll
            for (int b = 0; b < 8; ++b) acc[b] = (f32x4){0.f, 0.f, 0.f, 0.f};
#pragma unroll
            for (int i = 0; i < 16; ++i) { const f32x4 s0 = *(const f32x4*)(sc + (kb + 8 * i) * 8), s1 = *(const f32x4*)(sc + (kb + 8 * i) * 8 + 4);
                acc[0] += w[i] * s0.x; acc[1] += w[i] * s0.y; acc[2] += w[i] * s0.z; acc[3] += w[i] * s0.w; acc[4] += w[i] * s1.x; acc[5] += w[i] * s1.y; acc[6] += w[i] * s1.z; acc[7] += w[i] * s1.w; }
#pragma unroll
            for (int b = 0; b < 8; ++b) *(f32x4*)(part + (((wave * 8 + kr) * 8 + b) * 32) + 4 * cq) = acc[b];
            __syncthreads();
            if (tid < 256) { const int b = tid >> 5, cc = tid & 31; float s = p.b_ada[it * 32 + cc];
#pragma unroll 8
                for (int g = 0; g < 64; ++g) s += part[(g * 8 + b) * 32 + cc];
                mod[b * 6144 + it * 32 + cc] = s; }
            __syncthreads();
        }
        __syncthreads();
    }
    if (nblk > 192) { if (bid >= 192) convert_items(p, lds, bid - 192, nblk - 192, 0, CV_IN, 0, 1 << 20); }
    else convert_items(p, lds, bid, nblk, 0, CV_IN, 0, 1 << 20);
    {
        const int gt = bid * 512 + tid, ngt = nblk * 512;
        float* cosT = (float*)(p.ws + WS_ROPE); float* sinT = cosT + SEQ * 32;
        for (int i = gt; i < SEQ * 32; i += ngt) { const int pos = i >> 5, f = i & 31;
            const float inv = (float)(1.0 / pow(10000.0, (double)f / 32.0)); const float ang = (float)pos * inv;
            cosT[i] = (float)cos((double)ang); sinT[i] = (float)sin((double)ang); }
        if (gt == 0) { float a = 0.f, b = 0.f; for (int i = 0; i < 64; ++i) { a += p.lq1[i] * p.lk1[i]; b += p.lq2[i] * p.lk2[i]; }
            ((float*)(p.ws + WS_SCAL))[0] = expf(a) - expf(b) + 0.2f; }
    }
}

template <int CTRL> __device__ __forceinline__ float dppf(float x) { return __builtin_bit_cast(float, __builtin_amdgcn_mov_dpp(__builtin_bit_cast(int, x), CTRL, 0xf, 0xf, true)); }
template <int M> struct DppCtl { static constexpr int v = M == 1 ? 0xB1 : M == 2 ? 0x4E : M == 4 ? 0x141 : 0x128; };
__device__ __forceinline__ float swap32_add(float a, float b) { auto r = __builtin_amdgcn_permlane32_swap(__float_as_uint(a), __float_as_uint(b), false, false); return __uint_as_float(r[0]) + __uint_as_float(r[1]); }
__device__ __forceinline__ float swap16_add(float a, float b) { auto r = __builtin_amdgcn_permlane16_swap(__float_as_uint(a), __float_as_uint(b), false, false); return __uint_as_float(r[0]) + __uint_as_float(r[1]); }
__device__ __forceinline__ float wave_sum_v(float v) { v += dppf<0xB1>(v); v += dppf<0x4E>(v); v += dppf<0x141>(v); v += dppf<0x128>(v); v = swap16_add(v, v); return swap32_add(v, v); }
template <int N, int TOT, int M> struct WRM {
    static __device__ __forceinline__ void run(float (&v)[TOT], int lane) {
        if constexpr (M == 32) {
#pragma unroll
            for (int i = 0; i < N / 2; ++i) v[i] = swap32_add(v[i], v[i + N / 2]);
        } else if constexpr (M == 16) {
#pragma unroll
            for (int i = 0; i < N / 2; ++i) v[i] = swap16_add(v[i], v[i + N / 2]);
        } else {
            const bool up = (lane & M) != 0;
#pragma unroll
            for (int i = 0; i < N / 2; ++i) { const float send = up ? v[i] : v[i + N / 2]; const float keep = up ? v[i + N / 2] : v[i]; v[i] = keep + dppf<DppCtl<M>::v>(send); }
        }
        WRM<N / 2, TOT, M / 2>::run(v, lane);
    }
};
template <int TOT, int M> struct WRM<1, TOT, M> { static __device__ __forceinline__ void run(float (&v)[TOT], int lane) {
    if constexpr (M == 32) v[0] = swap32_add(v[0], v[0]); else if constexpr (M == 16) v[0] = swap16_add(v[0], v[0]); else v[0] += dppf<DppCtl<M>::v>(v[0]);
    WRM<1, TOT, M / 2>::run(v, lane); } };
template <int TOT> struct WRM<1, TOT, 0> { static __device__ __forceinline__ void run(float (&)[TOT], int) {} };
template <int N> __device__ __forceinline__ void wave_reduce_multi(float (&v)[N], int lane) { WRM<N, N, 32>::run(v, lane); }
__device__ __forceinline__ float dot4(const f32x4 a, const f32x4 b) { return (a.x * b.x + a.y * b.y) + (a.z * b.z + a.w * b.w); }
__device__ __forceinline__ float hsum4(const f32x4 a) { const pk2f_t t = (pk2f_t){a.x, a.y} + (pk2f_t){a.z, a.w}; return t.x + t.y; }
__device__ __forceinline__ float sumsq4(const f32x4 a) { return (a.x * a.x + a.y * a.y) + (a.z * a.z + a.w * a.w); }

__device__ __forceinline__ void norm1_phase(const P& p, unsigned char* lds, int c, int G) {
    const int tid = tid_fresh(), lane = tid & 63, gw = c * 8 + (tid >> 6), ngw = G * 8;
    const float* mod = (const float*)(p.ws + WS_MOD);
    unsigned char* H8 = p.ws + WS_H; float* logf_ = (float*)(p.ws + WS_LOGF);
    float* wq = (float*)lds;
    for (int i = tid; i < 8192; i += 512) { const int col = i >> 3, q = i & 7; wq[q * 1024 + col] = p.w_in[(size_t)col * INC + NQKV + q]; }
    __syncthreads();
    const int rpw = (((T + ngw - 1) / ngw) + 1) & ~1, r_begin = gw * rpw, r_end = min(T, r_begin + rpw);
    const float bfg = lane < 8 ? p.b_forget[lane] : 0.f;
    for (int seg = r_begin; seg < r_end;) {
        const int b = seg >> 12, seg_end = min(r_end, (b + 1) << 12);
        f32x4 xn[2][4], gs[4], sh[4];
#pragma unroll
        for (int j = 0; j < 4; ++j) { const int col = 4 * lane + 256 * j; const f32x4 g = *(const f32x4*)(p.g_pre_attn + col), sc = *(const f32x4*)(mod + b * 6144 + 1024 + col);
            sh[j] = *(const f32x4*)(mod + b * 6144 + col); gs[j] = g * (1.f + sc); }
#pragma unroll
        for (int r = 0; r < 2; ++r)
#pragma unroll
            for (int j = 0; j < 4; ++j) xn[r][j] = *((const f32x4*)(p.x + (size_t)(seg + r) * D) + lane + 64 * j);
        __builtin_amdgcn_s_waitcnt(0x0f70);
        for (int r0 = seg; r0 < seg_end; r0 += 2) {
            f32x4 x[2][4];
#pragma unroll
            for (int r = 0; r < 2; ++r)
#pragma unroll
                for (int j = 0; j < 4; ++j) x[r][j] = xn[r][j];
            { const int rp = r0 + 2 < seg_end ? r0 + 2 : r0;
#pragma unroll
                for (int r = 0; r < 2; ++r)
#pragma unroll
                    for (int j = 0; j < 4; ++j) xn[r][j] = *((const f32x4*)(p.x + (size_t)(rp + r) * D) + lane + 64 * j);
            }
            float ss[2];
#pragma unroll
            for (int r = 0; r < 2; ++r) ss[r] = hsum4((x[r][0] * x[r][0] + x[r][1] * x[r][1]) + (x[r][2] * x[r][2] + x[r][3] * x[r][3]));
#pragma unroll
            for (int r = 0; r < 2; ++r) ss[r] = wave_sum_v(ss[r]);
#pragma unroll
            for (int r = 0; r < 2; ++r) { const float rinv = rsqrtf(ss[r] * (1.f / D) + EPS);
#pragma unroll
                for (int j = 0; j < 4; ++j) { x[r][j] = x[r][j] * rinv * gs[j] + sh[j];
                    *(unsigned*)(H8 + (size_t)(r0 + r) * D + 4 * lane + 256 * j) = pk4_i8(x[r][j].x, x[r][j].y, x[r][j].z, x[r][j].w, Q8_ACT); } }
            float fl[16];
#pragma unroll
            for (int q = 0; q < 8; ++q) { f32x4 a0 = (f32x4){0.f, 0.f, 0.f, 0.f}, a1 = a0;
#pragma unroll
                for (int j = 0; j < 4; ++j) { const f32x4 w = *(const f32x4*)(wq + q * 1024 + 4 * lane + 256 * j); a0 += x[0][j] * w; a1 += x[1][j] * w; }
                fl[q] = hsum4(a0); fl[8 + q] = hsum4(a1);
                if (q & 1) asm volatile("" ::: "memory"); }
            wave_reduce_multi<16>(fl, lane);
            const float bq = __shfl(bfg, (lane >> 2) & 7);
            if ((lane & 3) == 0) { const int r = lane >> 5, q = (lane >> 2) & 7; const float z = fl[0] + bq;
                logf_[(size_t)(r0 + r) * 8 + q] = fminf(z, 0.f) - log1pf(expf(-fabsf(z))); }
        }
        seg = seg_end;
    }
}

__device__ __forceinline__ void scan_phase(const P& p, float* red  , int bid, int nblk) {
    const int tid = tid_fresh(), lane = tid & 63, wave = tid >> 6;
    const float* logf_ = (const float*)(p.ws + WS_LOGF); float* F = (float*)(p.ws + WS_F);
    for (int it = bid; it < 64; it += nblk) {
        const int b = it >> 3, h = it & 7;
        float v[8]; float s = 0.f;
#pragma unroll
        for (int i = 0; i < 8; ++i) { v[i] = logf_[((size_t)b * SEQ + tid * 8 + i) * 8 + h]; s += v[i]; v[i] = s; }
        float incl = s;
#pragma unroll
        for (int o = 1; o < 64; o <<= 1) { const float t = __shfl_up(incl, o); if (lane >= o) incl += t; }
        if (lane == 63) red[wave] = incl;
        __syncthreads();
        float base = incl - s;
        for (int w = 0; w < wave; ++w) base += red[w];
#pragma unroll
        for (int i = 0; i < 8; ++i) F[((size_t)b * 8 + h) * SEQ + tid * 8 + i] = -(base + v[i]) * 1.4426950408889634f;
        __syncthreads();
    }
}

constexpr int RT_WG = 131072, RT_CTL = 148480;
constexpr int CW_NORM = 2048, CW_FOXQ = 2304;
constexpr int CW_TILE = 10240;
constexpr int CW_SMIN = 8192;
constexpr int CNT_STRIDE = 64;
__device__ __forceinline__ void router_phase(const P& p, unsigned char* lds, int c, int G) {
    const int tid = tid_fresh(), lane = tid & 63, gw = c * 8 + (tid >> 6), ngw = G * 8;
    const float* mod = (const float*)(p.ws + WS_MOD); const bf16* mixed = (const bf16*)(p.ws + WS_R);
    unsigned char* H8 = p.ws + WS_H; bf16* X1 = (bf16*)(p.ws + WS_X1); unsigned* cnt = (unsigned*)(p.ws + WS_CTL);
    float* tokw = (float*)(p.ws + WS_TOKW); int* list = (int*)(p.ws + WS_LIST);
    float* wr = (float*)lds; float* wg = (float*)(lds + RT_WG);
    int* lcnt = (int*)(lds + RT_CTL); int* lbase = lcnt + 32; int* lassign = lcnt + 64;
    if (tid < 32) lcnt[tid] = 0;
    for (int i = tid; i < 8192; i += 512) { const int col = i >> 3, e0 = (i & 7) * 4; const f32x4 w = *(const f32x4*)(p.w_router + col * 32 + e0);
        wr[(e0 + 0) * 1024 + col] = w.x; wr[(e0 + 1) * 1024 + col] = w.y; wr[(e0 + 2) * 1024 + col] = w.z; wr[(e0 + 3) * 1024 + col] = w.w; }
    for (int col = tid; col < 1024; col += 512) { const f32x4 w = *(const f32x4*)(p.w_group + col * 4); wg[col] = w.x; wg[1024 + col] = w.y; wg[2048 + col] = w.z; wg[3072 + col] = w.w; }
    __syncthreads();
    const int rpw = (((T + ngw - 1) / ngw) + 1) & ~1, r_begin = gw * rpw, r_end = min(T, r_begin + rpw);
    const int blk_row0 = c * 8 * rpw, blk_slot0 = blk_row0 * 2, blk_nassign = max(0, min(T, blk_row0 + 8 * rpw) - blk_row0) * 2;
    const float bgl = p.b_group[(lane >> 3) & 3]; const float brt = lane < 32 ? p.b_router[lane] : 0.f;
    for (int seg = r_begin; seg < r_end;) {
        const int b = seg >> 12, seg_end = min(r_end, (b + 1) << 12);
        f32x4 xn[2][4], gta[4], gf[4], shf[4]; v2u mn[2][4];
#pragma unroll
        for (int j = 0; j < 4; ++j) { const int col = 4 * lane + 256 * j;
            gta[j] = *(const f32x4*)(p.g_post_attn + col) * *(const f32x4*)(mod + b * 6144 + 2048 + col);
            gf[j] = *(const f32x4*)(p.g_pre_ffn + col) * (1.f + *(const f32x4*)(mod + b * 6144 + 4096 + col)); shf[j] = *(const f32x4*)(mod + b * 6144 + 3072 + col); }
#pragma unroll
        for (int r = 0; r < 2; ++r)
#pragma unroll
            for (int j = 0; j < 4; ++j) { xn[r][j] = *((const f32x4*)(p.x + (size_t)(seg + r) * D) + lane + 64 * j); mn[r][j] = *((const v2u*)(mixed + (size_t)(seg + r) * D) + lane + 64 * j); }
        __builtin_amdgcn_s_waitcnt(0x0f70);
        for (int r0 = seg; r0 < seg_end; r0 += 2) {
            f32x4 x[2][4], m[2][4];
#pragma unroll
            for (int r = 0; r < 2; ++r)
#pragma unroll
                for (int j = 0; j < 4; ++j) { x[r][j] = xn[r][j]; const v2u w = mn[r][j]; m[r][j].x = bflo(w.x); m[r][j].y = bfhi(w.x); m[r][j].z = bflo(w.y); m[r][j].w = bfhi(w.y); }
            { const int rp = r0 + 2 < seg_end ? r0 + 2 : r0;
#pragma unroll
                for (int r = 0; r < 2; ++r)
#pragma unroll
                    for (int j = 0; j < 4; ++j) { xn[r][j] = *((const f32x4*)(p.x + (size_t)(rp + r) * D) + lane + 64 * j); mn[r][j] = *((const v2u*)(mixed + (size_t)(rp + r) * D) + lane + 64 * j); }
            }
            float s1[2], s2[2];
#pragma unroll
            for (int r = 0; r < 2; ++r) s1[r] = hsum4((m[r][0] * m[r][0] + m[r][1] * m[r][1]) + (m[r][2] * m[r][2] + m[r][3] * m[r][3]));
#pragma unroll
            for (int r = 0; r < 2; ++r) s1[r] = wave_sum_v(s1[r]);
#pragma unroll
            for (int r = 0; r < 2; ++r) { const float rinv = rsqrtf(s1[r] * (1.f / D) + EPS); f32x4 sq = (f32x4){0.f, 0.f, 0.f, 0.f};
#pragma unroll
                for (int j = 0; j < 4; ++j) { x[r][j] = x[r][j] + gta[j] * (m[r][j] * rinv); sq += x[r][j] * x[r][j];
                    v2u o; o.x = pk2(x[r][j].x, x[r][j].y); o.y = pk2(x[r][j].z, x[r][j].w); *(v2u*)(X1 + (size_t)(r0 + r) * D + 4 * lane + 256 * j) = o; }
                s2[r] = hsum4(sq); }
#pragma unroll
            for (int r = 0; r < 2; ++r) s2[r] = wave_sum_v(s2[r]);
#pragma unroll
            for (int r = 0; r < 2; ++r) { const float rinv = rsqrtf(s2[r] * (1.f / D) + EPS);
#pragma unroll
                for (int j = 0; j < 4; ++j) { x[r][j] = x[r][j] * rinv * gf[j] + shf[j];
                    *(unsigned*)(H8 + (size_t)(r0 + r) * D + 4 * lane + 256 * j) = pk4_i8(x[r][j].x, x[r][j].y, x[r][j].z, x[r][j].w, Q8_ACT); } }
            float gl[8];
#pragma unroll
            for (int q = 0; q < 4; ++q) { f32x4 a0 = (f32x4){0.f, 0.f, 0.f, 0.f}, a1 = a0;
#pragma unroll
                for (int j = 0; j < 4; ++j) { const f32x4 w = *(const f32x4*)(wg + q * 1024 + 4 * lane + 256 * j); a0 += x[0][j] * w; a1 += x[1][j] * w; }
                gl[q] = hsum4(a0); gl[4 + q] = hsum4(a1); if (q & 1) asm volatile("" ::: "memory"); }
            wave_reduce_multi<8>(gl, lane);
            const float glv = gl[0] + bgl;
            float v4[4];
#pragma unroll
            for (int q = 0; q < 4; ++q) v4[q] = __shfl(glv, (lane & 32) + q * 8);
            int bi = 0; float bm = v4[0];
#pragma unroll
            for (int q = 1; q < 4; ++q) if (v4[q] > bm) { bm = v4[q]; bi = q; }
            float gsum = 0.f;
#pragma unroll
            for (int q = 0; q < 4; ++q) gsum += __expf(v4[q] - bm);
            const float gwtl = 1.f / gsum;
            int gi[2]; gi[0] = __builtin_amdgcn_readlane(bi, 0); gi[1] = __builtin_amdgcn_readlane(bi, 32);
            float el[16];
#pragma unroll
            for (int r = 0; r < 2; ++r) { const float* wb = wr + gi[r] * 8192 + 4 * lane;
#pragma unroll
                for (int q = 0; q < 8; ++q) { f32x4 a = (f32x4){0.f, 0.f, 0.f, 0.f};
#pragma unroll
                    for (int j = 0; j < 4; ++j) a += x[r][j] * *(const f32x4*)(wb + q * 1024 + 256 * j);
                    el[r * 8 + q] = hsum4(a); if (q & 1) asm volatile("" ::: "memory"); } }
            wave_reduce_multi<16>(el, lane);
            {
                const float elv = el[0] + __shfl(brt, bi * 8 + ((lane >> 2) & 7));
                float v[8];
#pragma unroll
                for (int q = 0; q < 8; ++q) v[q] = __shfl(elv, (lane & 32) + q * 4);
                int i1 = 0; float v1 = v[0];
#pragma unroll
                for (int q = 1; q < 8; ++q) if (v[q] > v1) { v1 = v[q]; i1 = q; }
                int i2 = -1; float v2 = -3.0e38f;
#pragma unroll
                for (int q = 0; q < 8; ++q) if (q != i1 && v[q] > v2) { v2 = v[q]; i2 = q; }
                const float e2 = __expf(v2 - v1); const float w1 = gwtl / (1.f + e2), w2 = gwtl * e2 / (1.f + e2);
                if ((lane & 31) < 2) { const int r = lane >> 5, sl = lane & 1; const int e = bi * 8 + (sl ? i2 : i1); const float w = sl ? w2 : w1; const int slot = (r0 + r) * 2 + sl;
                    tokw[slot] = w; const int lpos = atomicAdd(lcnt + e, 1); lassign[slot - blk_slot0] = e | (lpos << 8); }
            }
        }
        seg = seg_end;
    }
    __syncthreads();
    if (tid < 32) lbase[tid] = lcnt[tid] ? (int)atomicAdd(cnt + tid * CNT_STRIDE, (unsigned)lcnt[tid]) : 0;
    __syncthreads();
    for (int i = tid; i < blk_nassign; i += 512) { const int v = lassign[i], e = v & 255; list[e * T + lbase[e] + (v >> 8)] = blk_slot0 + i; }
}

typedef float f32x2 __attribute__((ext_vector_type(2)));
__device__ __forceinline__ f32x4 fp8x4_to_f32(unsigned w) { const f32x2 lo = __builtin_amdgcn_cvt_pk_f32_fp8((int)w, false), hi = __builtin_amdgcn_cvt_pk_f32_fp8((int)w, true); return (f32x4){lo.x, lo.y, hi.x, hi.y}; }
__device__ __forceinline__ void final_phase(const P& p, int c, int G) {
    const int tid = tid_fresh(), lane = tid & 63, gw = c * 8 + (tid >> 6), ngw = G * 8;
    const float* mod = (const float*)(p.ws + WS_MOD); const unsigned char* YS = p.ws + WS_R; const bf16* X1 = (const bf16*)(p.ws + WS_X1); const float* tokw = (const float*)(p.ws + WS_TOKW);
    const int rpw = (((T + ngw - 1) / ngw) + 1) & ~1, r_begin = gw * rpw, r_end = min(T, r_begin + rpw);
    for (int seg = r_begin; seg < r_end;) {
        const int b = seg >> 12, seg_end = min(r_end, (b + 1) << 12);
        f32x4 gtf[4]; v2u xn[2][4]; unsigned yn[2][2][4];
#pragma unroll
        for (int j = 0; j < 4; ++j) { const int col = 4 * lane + 256 * j; gtf[j] = *(const f32x4*)(p.g_post_ffn + col) * *(const f32x4*)(mod + b * 6144 + 5120 + col); }
#pragma unroll
        for (int r = 0; r < 2; ++r)
#pragma unroll
            for (int j = 0; j < 4; ++j) { xn[r][j] = *((const v2u*)(X1 + (size_t)(seg + r) * D) + lane + 64 * j);
                yn[r][0][j] = *((const unsigned*)(YS + (size_t)((seg + r) * 2) * D) + lane + 64 * j); yn[r][1][j] = *((const unsigned*)(YS + (size_t)((seg + r) * 2 + 1) * D) + lane + 64 * j); }
        __builtin_amdgcn_s_waitcnt(0x0f70);
        for (int r0 = seg; r0 < seg_end; r0 += 2) {
            f32x4 x[2][4], y[2][4];
#pragma unroll
            for (int r = 0; r < 2; ++r) { const float w0 = tokw[(r0 + r) * 2] * 0.0625f, w1 = tokw[(r0 + r) * 2 + 1] * 0.0625f;
#pragma unroll
                for (int j = 0; j < 4; ++j) { const v2u xv = xn[r][j]; x[r][j].x = bflo(xv.x); x[r][j].y = bfhi(xv.x); x[r][j].z = bflo(xv.y); x[r][j].w = bfhi(xv.y);
                    y[r][j] = fp8x4_to_f32(yn[r][0][j]) * w0 + fp8x4_to_f32(yn[r][1][j]) * w1; } }
            { const int rp = r0 + 2 < seg_end ? r0 + 2 : r0;
#pragma unroll
                for (int r = 0; r < 2; ++r)
#pragma unroll
                    for (int j = 0; j < 4; ++j) { xn[r][j] = *((const v2u*)(X1 + (size_t)(rp + r) * D) + lane + 64 * j);
                        yn[r][0][j] = *((const unsigned*)(YS + (size_t)((rp + r) * 2) * D) + lane + 64 * j); yn[r][1][j] = *((const unsigned*)(YS + (size_t)((rp + r) * 2 + 1) * D) + lane + 64 * j); }
            }
            float ss[2];
#pragma unroll
            for (int r = 0; r < 2; ++r) ss[r] = hsum4((y[r][0] * y[r][0] + y[r][1] * y[r][1]) + (y[r][2] * y[r][2] + y[r][3] * y[r][3]));
#pragma unroll
            for (int r = 0; r < 2; ++r) ss[r] = wave_sum_v(ss[r]);
#pragma unroll
            for (int r = 0; r < 2; ++r) { const float rinv = rsqrtf(ss[r] * (1.f / D) + EPS);
#pragma unroll
                for (int j = 0; j < 4; ++j) *((f32x4*)(p.out + (size_t)(r0 + r) * D) + lane + 64 * j) = x[r][j] + gtf[j] * (y[r][j] * rinv); }
        }
        seg = seg_end;
    }
}

namespace pg8 {
#define PG8_LAS __attribute__((address_space(3)))
typedef unsigned short bf16_t;
typedef short bf16x8 __attribute__((ext_vector_type(8)));
typedef float f32x4 __attribute__((ext_vector_type(4)));
typedef unsigned u32x4 __attribute__((ext_vector_type(4)));
constexpr int BM = 256, BK = 64, HALF = 128, HTB = HALF * BK * 2  , STAGE_BYTES = 8 * HTB, NXCD = 8, WGM = 4;

__host__ __device__ __forceinline__ int lds_byte(int r, int c) { const int st = (r >> 4) * 2 + (c >> 5), rr = r & 15, cc = c & 31, ob = rr * 64 + cc * 2; return st * 1024 + (ob ^ (((ob >> 9) & 1) << 5)); }
__host__ __device__ __forceinline__ void stage_rc(int b, int& R, int& C) { const int st = b / 1024, sb = b % 1024, swz = sb ^ (((sb >> 9) & 1) << 5); R = (st >> 1) * 16 + swz / 64; C = (st & 1) * 32 + (swz % 64) / 2; }
__host__ __device__ __forceinline__ int perm32(int rho) { const int n = rho >> 4, i = rho & 15; return 8 * (i >> 2) + 4 * n + (i & 3); }

struct Unit { int pm, pn, aux; };
struct Gemm { const bf16_t* A; const bf16_t* Bt; int M, N, K; };

struct StaticOrder {
    int nM, nN, nwg, G, c;
    __host__ __device__ void init(int M, int N, int G_, int c_) { nM = M / BM; nN = N / BM; nwg = nM * nN; G = G_; c = c_; }
    __host__ __device__ bool next(int i, Unit& u) const {
        const long L = (long)i * G + c; if (L >= nwg) return false;
        int wgid = (int)L; { const int q = nwg / NXCD, r = nwg % NXCD, xcd = wgid % NXCD, off = wgid / NXCD; wgid = (xcd < r ? xcd * (q + 1) : r * (q + 1) + (xcd - r) * q) + off; }
        const int nig = WGM * nN, gid = wgid / nig, fm = gid * WGM, gsz = (nM - fm) < WGM ? (nM - fm) : WGM;
        u.pm = fm + ((wgid % nig) % gsz); u.pn = (wgid % nig) / gsz; return true;
    }
    __device__ __forceinline__ void a_ready(const Unit&) const {}
    __device__ __forceinline__ void done(const Unit&) const {}
};

__device__ __forceinline__ unsigned cvt_pk_bf16(float lo, float hi) { unsigned r; asm volatile("v_cvt_pk_bf16_f32 %0, %1, %2" : "=v"(r) : "v"(lo), "v"(hi)); return r; }
typedef float f32x2 __attribute__((ext_vector_type(2)));

typedef int i32x4 __attribute__((ext_vector_type(4)));
template <class Epi, class Sched, bool ALIGN_EPI = false, bool SP2 = true, bool GATHER = false, bool I8 = false, bool ACOH = false>
__device__ __forceinline__ void gemm_phase(PG8_LAS unsigned char* lds, const Gemm g, const Sched& S, const Epi& E) {
    const int tid = tid_fresh(), wid = __builtin_amdgcn_readfirstlane(tid >> 6), lane = tid & 63, wr = wid >> 2, wc = wid & 3, fr = lane & 15, fq = lane >> 4;
    constexpr int ES = I8 ? 1 : 2;
    const int K = g.K, nt = K * ES / (BK * 2);
    unsigned voffA[2], voffB[2];
#pragma unroll
    for (int i = 0; i < 2; ++i) { int R, C; stage_rc(tid * 16 + i * 8192, R, C); const int Rb = Epi::PERM ? ((R & ~31) + perm32(R & 31)) : R;
        voffA[i] = (unsigned)(R * K * ES + C * 2); voffB[i] = (unsigned)(Rb * K * ES + C * 2); }
    unsigned offC[2][2], offN[2][2]; int gR[2], gC[2];
#pragma unroll
    for (int i = 0; i < 2; ++i) { int R, C; stage_rc(tid * 16 + i * 8192, R, C); gR[i] = R; gC[i] = C * 2; }
#pragma unroll
    for (int h = 0; h < 2; ++h)
#pragma unroll
        for (int i = 0; i < 2; ++i) { offC[h][i] = 0u; offN[h][i] = 0u; }
    const char* gA = (const char*)g.A;
    const size_t kstep = (size_t)(BK * 2);
    const size_t hstep = (size_t)HALF * K * ES;
    const size_t tstep = 2 * hstep;
    const unsigned ldsw = (unsigned)wid * 1024u;
    const int aoff = lds_byte(wr * 64 + fr, fq * 8), boff = lds_byte(wc * 32 + fr, fq * 8);
#define PG8_SA(b, h) (((b) * 2 + (h)) * HTB)
#define PG8_SB(b, h) ((4 + (b) * 2 + (h)) * HTB)
#define PG8_STAGE(bufoff, gbase, voff) do { _Pragma("unroll") for (int _i = 0; _i < 2; ++_i) \
        __builtin_amdgcn_global_load_lds((const unsigned*)((const char*)(gbase) + (voff)[_i]), (PG8_LAS unsigned*)(lds + (bufoff) + ldsw + _i * 8192), 16, 0, 0); } while (0)
#define PG8_STAGE_C(bufoff, gbase, voff) do { _Pragma("unroll") for (int _i = 0; _i < 2; ++_i) \
        __builtin_amdgcn_global_load_lds((const unsigned*)((const char*)(gbase) + (voff)[_i]), (PG8_LAS unsigned*)(lds + (bufoff) + ldsw + _i * 8192), 16, 0, 17); } while (0)
#define PG8_STA(b, h, nb, gb, off) do { if constexpr (GATHER) PG8_STAGE(PG8_SA(b, h), gb, off[h]); else if constexpr (ACOH) PG8_STAGE_C(PG8_SA(b, h), (nb) + (h) * hstep, voffA); else PG8_STAGE(PG8_SA(b, h), (nb) + (h) * hstep, voffA); } while (0)
#define PG8_LDA(dst, b, h) do { _Pragma("unroll") for (int m = 0; m < 4; ++m) _Pragma("unroll") for (int k = 0; k < 2; ++k) dst[m][k] = *(const PG8_LAS bf16x8*)(lds + PG8_SA(b, h) + aoff + m * 2048 + k * 1024); } while (0)
#define PG8_LDB(dst, b, h) do { _Pragma("unroll") for (int n = 0; n < 2; ++n) _Pragma("unroll") for (int k = 0; k < 2; ++k) dst[n][k] = *(const PG8_LAS bf16x8*)(lds + PG8_SB(b, h) + boff + n * 2048 + k * 1024); } while (0)
#define PG8_MMA(ai, bj, At, Bt) do { __builtin_amdgcn_s_setprio(1); _Pragma("unroll") for (int m = 0; m < 4; ++m) _Pragma("unroll") for (int n = 0; n < 2; ++n) _Pragma("unroll") for (int k = 0; k < 2; ++k) { \
        if constexpr (I8) acc[ai][bj][m][n] = __builtin_bit_cast(f32x4, __builtin_amdgcn_mfma_i32_16x16x64_i8(__builtin_bit_cast(i32x4, Bt[n][k]), __builtin_bit_cast(i32x4, At[m][k]), __builtin_bit_cast(i32x4, acc[ai][bj][m][n]), 0, 0, 0)); \
        else acc[ai][bj][m][n] = __builtin_amdgcn_mfma_f32_16x16x32_bf16(Bt[n][k], At[m][k], acc[ai][bj][m][n], 0, 0, 0); } __builtin_amdgcn_s_setprio(0); } while (0)
#define PG8_WAIT_V(n) asm volatile("s_waitcnt vmcnt(" #n ")" ::: "memory")
#define PG8_WAIT_L(n) asm volatile("s_waitcnt lgkmcnt(" #n ")" ::: "memory")
#define PG8_BAR __builtin_amdgcn_s_barrier()
#define PG8_SCHED __builtin_amdgcn_sched_barrier(0)
    Unit cur, nxt; int ui = 0;
    if (!S.next(0, cur)) return;
    f32x4 acc[2][2][4][2];
#pragma unroll
    for (int a = 0; a < 2; ++a)
#pragma unroll
        for (int b = 0; b < 2; ++b)
#pragma unroll
            for (int m = 0; m < 4; ++m)
#pragma unroll
                for (int n = 0; n < 2; ++n) acc[a][b][m][n] = (f32x4){0.f, 0.f, 0.f, 0.f};
    bf16x8 At[4][2], B0[2][2], B1[2][2];
    const char* cA = (const char*)g.A + (size_t)cur.pm * tstep; const char* cB = (const char*)g.Bt + (size_t)cur.pn * tstep;
    S.a_ready(cur);
    static_assert(!GATHER || SP2, "GATHER needs the SP2 loop");
    if constexpr (GATHER) {
#pragma unroll
        for (int h = 0; h < 2; ++h)
#pragma unroll
            for (int i = 0; i < 2; ++i) { offC[h][i] = S.arow(0, 128 * h + gR[i]) + (unsigned)gC[i]; offN[h][i] = offC[h][i]; } }
    if constexpr (SP2) {
        PG8_STAGE(PG8_SB(0, 0), cB, voffB); PG8_STAGE(PG8_SB(0, 1), cB + hstep, voffB); PG8_STA(0, 0, cA, gA, offC); PG8_STA(0, 1, cA, gA, offC);
        if (wr == 1) PG8_BAR;
        PG8_WAIT_V(2); PG8_BAR;
        PG8_STAGE(PG8_SB(1, 0), cB + kstep, voffB); PG8_STA(1, 0, cA + kstep, gA + kstep, offC); PG8_STAGE(PG8_SB(1, 1), cB + hstep + kstep, voffB);
        PG8_WAIT_V(6); PG8_BAR;
    } else {
        PG8_STAGE(PG8_SB(0, 0), cB, voffB); PG8_STAGE(PG8_SA(0, 0), cA, voffA); PG8_STAGE(PG8_SB(0, 1), cB + hstep, voffB); PG8_STAGE(PG8_SA(0, 1), cA + hstep, voffA);
        if (wr == 1) PG8_BAR;
        PG8_WAIT_V(4); PG8_BAR;
        PG8_STAGE(PG8_SB(1, 0), cB + kstep, voffB); PG8_STAGE(PG8_SA(1, 0), cA + kstep, voffA); PG8_STAGE(PG8_SB(1, 1), cB + hstep + kstep, voffB);
        PG8_WAIT_V(6); PG8_BAR;
    }
    for (;;) {
        const bool has_next = S.next(ui + 1, nxt);
        if (has_next) S.a_ready(nxt);
        if constexpr (GATHER) { if (has_next) {
#pragma unroll
            for (int h = 0; h < 2; ++h)
#pragma unroll
                for (int i = 0; i < 2; ++i) offN[h][i] = S.arow(ui + 1, 128 * h + gR[i]) + (unsigned)gC[i]; } }
        const char* nA = has_next ? (const char*)g.A + (size_t)nxt.pm * tstep : cA; const char* nB = has_next ? (const char*)g.Bt + (size_t)nxt.pn * tstep : cB;
        for (int t = 0; t < nt; t += 2) {
            const bool last = (t == nt - 2);
            const char* a1 = cA + (size_t)(t + 1) * kstep;
            const char* a2 = last ? nA : cA + (size_t)(t + 2) * kstep; const char* b2 = last ? nB : cB + (size_t)(t + 2) * kstep;
            const char* a3 = a2 + kstep; const char* b3 = b2 + kstep;
            const char* g2 = gA + (last ? (size_t)0 : (size_t)(t + 2) * kstep); unsigned offS[2][2];
#pragma unroll
            for (int h = 0; h < 2; ++h)
#pragma unroll
                for (int i = 0; i < 2; ++i) offS[h][i] = last ? offN[h][i] : offC[h][i];
            (void)g2; (void)offS;
            if constexpr (SP2) {
            PG8_LDB(B0, 0, 0); PG8_LDB(B1, 0, 1); PG8_SCHED; PG8_LDA(At, 0, 0); PG8_STA(1, 1, a1, gA + (size_t)(t + 1) * kstep, offC);
            PG8_WAIT_V(8); PG8_WAIT_L(0); PG8_BAR; PG8_MMA(0, 0, At, B0); PG8_MMA(0, 1, At, B1); PG8_BAR; PG8_SCHED;
            PG8_LDA(At, 0, 1); PG8_STAGE(PG8_SB(0, 0), b2, voffB); PG8_STAGE(PG8_SB(0, 1), b2 + hstep, voffB); PG8_STA(0, 0, a2, g2, offS);
            PG8_WAIT_V(8); PG8_WAIT_L(0); PG8_BAR; PG8_MMA(1, 0, At, B0); PG8_MMA(1, 1, At, B1); PG8_BAR; PG8_SCHED;
            PG8_LDB(B0, 1, 0); PG8_LDB(B1, 1, 1); PG8_SCHED; PG8_LDA(At, 1, 0); PG8_STA(0, 1, a2, g2, offS);
            PG8_WAIT_V(8); PG8_WAIT_L(0); PG8_BAR; PG8_MMA(0, 0, At, B0); PG8_MMA(0, 1, At, B1); PG8_BAR; PG8_SCHED;
            PG8_LDA(At, 1, 1); PG8_STAGE(PG8_SB(1, 0), b3, voffB); PG8_STAGE(PG8_SB(1, 1), b3 + hstep, voffB); PG8_STA(1, 0, a3, g2 + kstep, offS);
            PG8_WAIT_V(8); PG8_WAIT_L(0); PG8_BAR; PG8_MMA(1, 0, At, B0); PG8_MMA(1, 1, At, B1); PG8_BAR; PG8_SCHED;
            } else {
            PG8_LDB(B0, 0, 0); PG8_SCHED; PG8_LDA(At, 0, 0); PG8_STAGE(PG8_SA(1, 1), a1 + hstep, voffA);
            PG8_WAIT_L(8); PG8_BAR; PG8_WAIT_L(0); PG8_MMA(0, 0, At, B0); PG8_BAR; PG8_SCHED;
            PG8_LDB(B1, 0, 1); PG8_STAGE(PG8_SB(0, 0), b2, voffB);
            PG8_BAR; PG8_WAIT_L(0); PG8_MMA(0, 1, At, B1); PG8_BAR;
            PG8_LDA(At, 0, 1); PG8_STAGE(PG8_SA(0, 0), a2, voffA);
            PG8_BAR; PG8_WAIT_L(0); PG8_MMA(1, 0, At, B0); PG8_BAR; PG8_SCHED;
            PG8_STAGE(PG8_SB(0, 1), b2 + hstep, voffB);
            PG8_WAIT_V(6); PG8_BAR; PG8_MMA(1, 1, At, B1); PG8_BAR;
            PG8_LDB(B0, 1, 0); PG8_SCHED; PG8_LDA(At, 1, 0); PG8_STAGE(PG8_SA(0, 1), a2 + hstep, voffA);
            PG8_WAIT_L(8); PG8_BAR; PG8_WAIT_L(0); PG8_MMA(0, 0, At, B0); PG8_BAR; PG8_SCHED;
            PG8_LDB(B1, 1, 1); PG8_STAGE(PG8_SB(1, 0), b3, voffB);
            PG8_BAR; PG8_WAIT_L(0); PG8_MMA(0, 1, At, B1); PG8_BAR;
            PG8_LDA(At, 1, 1); PG8_STAGE(PG8_SA(1, 0), a3, voffA);
            PG8_BAR; PG8_WAIT_L(0); PG8_MMA(1, 0, At, B0); PG8_BAR; PG8_SCHED;
            PG8_STAGE(PG8_SB(1, 1), b3 + hstep, voffB);
            PG8_WAIT_V(6); PG8_BAR; PG8_MMA(1, 1, At, B1); PG8_BAR;
            }
        }
        if constexpr (ALIGN_EPI) { if (wr == 0) PG8_BAR; }
        if constexpr (!Epi::AFTER_DRAIN) { E(acc, cur, wr, wc, fr, fq); S.done(cur); }
        if (!has_next) break;
#pragma unroll
        for (int a = 0; a < 2; ++a)
#pragma unroll
            for (int b = 0; b < 2; ++b)
#pragma unroll
                for (int m = 0; m < 4; ++m)
#pragma unroll
                    for (int n = 0; n < 2; ++n) acc[a][b][m][n] = (f32x4){0.f, 0.f, 0.f, 0.f};
        cur = nxt; cA = nA; cB = nB; ++ui;
#pragma unroll
        for (int h = 0; h < 2; ++h)
#pragma unroll
            for (int i = 0; i < 2; ++i) offC[h][i] = offN[h][i];
        if constexpr (ALIGN_EPI) { if (wr == 1) PG8_BAR; }
    }
    PG8_WAIT_V(0);
    if constexpr (!ALIGN_EPI) { if (wr == 0) PG8_BAR; }
    PG8_BAR;
    if constexpr (Epi::AFTER_DRAIN) { E.fused(acc, cur, wr, wc, fr, fq, lds, wid, lane); S.done(cur); }
#undef PG8_SA
#undef PG8_SB
#undef PG8_STAGE
#undef PG8_STAGE_C
#undef PG8_STA
#undef PG8_LDA
#undef PG8_LDB
#undef PG8_MMA
#undef PG8_WAIT_V
#undef PG8_WAIT_L
#undef PG8_BAR
#undef PG8_SCHED
}

typedef unsigned u32x4e __attribute__((ext_vector_type(4)));
__device__ __forceinline__ f32x4 i2f4(const f32x4 r, float s) { const float a = r.x, b = r.y, c = r.z, d = r.w; return (f32x4){(float)__float_as_int(a) * s, (float)__float_as_int(b) * s, (float)__float_as_int(c) * s, (float)__float_as_int(d) * s}; }
typedef unsigned u32x2e __attribute__((ext_vector_type(2)));
struct EpiInProj {
    static constexpr bool PERM = true, AFTER_DRAIN = false;
    bf16_t* O; const float* cosT; const float* sinT; float qscale, dq;
    unsigned* smn;
    unsigned* nrm;
    __device__ __forceinline__ void operator()(const f32x4 (&acc)[2][2][4][2], const Unit& u, int wr, int wc, int fr, int fq) const {
        const int row0 = u.pm * BM + wr * 64 + fr;
        if (u.pn < 4) {
            const float sc = u.pn < 2 ? qscale : 1.f; const int colb = (u.pn * 4 + wc) * 64 + 8 * fq;
#pragma unroll
            for (int ai = 0; ai < 2; ++ai)
#pragma unroll
                for (int m = 0; m < 4; ++m) { const int row = row0 + ai * HALF + m * 16, pos = row & 4095;
                    const f32x4 c0 = *(const f32x4*)(cosT + pos * 32 + 8 * fq), c1 = *(const f32x4*)(cosT + pos * 32 + 8 * fq + 4), s0 = *(const f32x4*)(sinT + pos * 32 + 8 * fq), s1 = *(const f32x4*)(sinT + pos * 32 + 8 * fq + 4);
                    const f32x4 a0 = i2f4(acc[ai][0][m][0], dq), a1 = i2f4(acc[ai][0][m][1], dq), b0 = i2f4(acc[ai][1][m][0], dq), b1 = i2f4(acc[ai][1][m][1], dq);
                    const f32x4 p0 = (a0 * c0 - b0 * s0) * sc, p1 = (a1 * c1 - b1 * s1) * sc, q0 = (b0 * c0 + a0 * s0) * sc, q1 = (b1 * c1 + a1 * s1) * sc;
                    u32x4e w; w.x = cvt_pk_bf16(p0[0], p0[1]); w.y = cvt_pk_bf16(p0[2], p0[3]); w.z = cvt_pk_bf16(p1[0], p1[1]); w.w = cvt_pk_bf16(p1[2], p1[3]);
                    bf16_t* rp = O + (size_t)row * 3072 + colb; *(u32x4e*)rp = w;
                    w.x = cvt_pk_bf16(q0[0], q0[1]); w.y = cvt_pk_bf16(q0[2], q0[3]); w.z = cvt_pk_bf16(q1[0], q1[1]); w.w = cvt_pk_bf16(q1[2], q1[3]); *(u32x4e*)(rp + 32) = w; }
        } else {
            if (u.pn >= 6 && u.pn <= 9) {
                const int hp = u.pn - 6, colq = 1536 + hp * 128 + wc * 32 + 8 * fq; const float sq_ = qscale * dq;
                float nq = 0.f, nk = 0.f, smin = 3.0e38f;
#pragma unroll
                for (int ai = 0; ai < 2; ++ai)
#pragma unroll
                    for (int m = 0; m < 4; ++m) { bf16_t* rp = O + (size_t)(row0 + ai * HALF + m * 16) * 3072 + colq;
                        const f32x4 q0 = i2f4(acc[ai][0][m][0], sq_), q1 = i2f4(acc[ai][0][m][1], sq_), k0 = i2f4(acc[ai][1][m][0], dq), k1 = i2f4(acc[ai][1][m][1], dq);
                        u32x4e w; w.x = cvt_pk_bf16(q0[0], q0[1]); w.y = cvt_pk_bf16(q0[2], q0[3]); w.z = cvt_pk_bf16(q1[0], q1[1]); w.w = cvt_pk_bf16(q1[2], q1[3]); *(u32x4e*)rp = w;
                        w.x = cvt_pk_bf16(k0[0], k0[1]); w.y = cvt_pk_bf16(k0[2], k0[3]); w.z = cvt_pk_bf16(k1[0], k1[1]); w.w = cvt_pk_bf16(k1[2], k1[3]); *(u32x4e*)(rp + 512) = w;
                        float a = hsum4(q0 * q0 + q1 * q1), b_ = hsum4(k0 * k0 + k1 * k1), d = hsum4(q0 * k0 + q1 * k1);
                        a = swap16_add(a, a); a = swap32_add(a, a); b_ = swap16_add(b_, b_); b_ = swap32_add(b_, b_); d = swap16_add(d, d); d = swap32_add(d, d);
                        nq = fmaxf(nq, a); nk = fmaxf(nk, b_); smin = fminf(smin, d); }
                nq = fmaxf(nq, dppf<0xB1>(nq)); nq = fmaxf(nq, dppf<0x4E>(nq)); nq = fmaxf(nq, dppf<0x141>(nq)); nq = fmaxf(nq, dppf<0x128>(nq));
                nk = fmaxf(nk, dppf<0xB1>(nk)); nk = fmaxf(nk, dppf<0x4E>(nk)); nk = fmaxf(nk, dppf<0x141>(nk)); nk = fmaxf(nk, dppf<0x128>(nk));
                smin = fminf(smin, dppf<0xB1>(smin)); smin = fminf(smin, dppf<0x4E>(smin)); smin = fminf(smin, dppf<0x141>(smin)); smin = fminf(smin, dppf<0x128>(smin));
                if (fr == 0 && fq == 0) { const int b = (u.pm * BM) >> 12, qb = u.pm & 15, h = hp * 2 + (wc >> 1);
                    atomicMax(nrm + ((b * 8 + h) * 2 + 0) * 2 + (wc & 1), __float_as_uint(nq)); atomicMax(nrm + ((b * 8 + h) * 2 + 1) * 2 + (wc & 1), __float_as_uint(nk));
                    const int si = __float_as_int(smin); atomicMin((int*)smn + (((b * 8 + h) * 16 + qb) * 2 + (wc & 1)), si >= 0 ? si : si ^ 0x7fffffff); }
            } else {
            const float sc = dq; const int col0 = u.pn * BM + wc * 32 + 8 * fq;
#pragma unroll
            for (int ai = 0; ai < 2; ++ai)
#pragma unroll
                for (int m = 0; m < 4; ++m) { bf16_t* rp = O + (size_t)(row0 + ai * HALF + m * 16) * 3072 + col0;
#pragma unroll
                    for (int bj = 0; bj < 2; ++bj) { const f32x4 v0 = i2f4(acc[ai][bj][m][0], sc), v1 = i2f4(acc[ai][bj][m][1], sc);
                        u32x4e w; w.x = cvt_pk_bf16(v0[0], v0[1]); w.y = cvt_pk_bf16(v0[2], v0[3]); w.z = cvt_pk_bf16(v1[0], v1[1]); w.w = cvt_pk_bf16(v1[2], v1[3]); *(u32x4e*)(rp + bj * HALF) = w; } }
            }
        }
    }
};
struct EpiBf16P {
    static constexpr bool PERM = true, AFTER_DRAIN = false;
    bf16_t* C; int ldc; float dq;
    __device__ __forceinline__ void operator()(const f32x4 (&acc)[2][2][4][2], const Unit& u, int wr, int wc, int fr, int fq) const {
        const int row0 = u.pm * BM + wr * 64 + fr, col0 = u.pn * BM + wc * 32 + 8 * fq;
#pragma unroll
        for (int ai = 0; ai < 2; ++ai)
#pragma unroll
            for (int m = 0; m < 4; ++m) { bf16_t* rp = C + (size_t)(row0 + ai * HALF + m * 16) * ldc + col0;
#pragma unroll
                for (int bj = 0; bj < 2; ++bj) { const f32x4 v0 = i2f4(acc[ai][bj][m][0], dq), v1 = i2f4(acc[ai][bj][m][1], dq);
                    u32x4e w; w.x = cvt_pk_bf16(v0[0], v0[1]); w.y = cvt_pk_bf16(v0[2], v0[3]); w.z = cvt_pk_bf16(v1[0], v1[1]); w.w = cvt_pk_bf16(v1[2], v1[3]); *(u32x4e*)(rp + bj * HALF) = w; } }
    }
};
struct EpiF32 {
    static constexpr bool PERM = false, AFTER_DRAIN = false;
    float* C; int ldc;
    __device__ __forceinline__ void operator()(const f32x4 (&acc)[2][2][4][2], const Unit& u, int wr, int wc, int fr, int fq) const {
        const int row0 = u.pm * BM + wr * 64 + fr, col0 = u.pn * BM + wc * 32 + 4 * fq;
#pragma unroll
        for (int ai = 0; ai < 2; ++ai)
#pragma unroll
            for (int m = 0; m < 4; ++m) { float* rp = C + (size_t)(row0 + ai * HALF + m * 16) * ldc + col0;
#pragma unroll
                for (int bj = 0; bj < 2; ++bj)
#pragma unroll
                    for (int n = 0; n < 2; ++n) *(f32x4*)(rp + bj * HALF + n * 16) = acc[ai][bj][m][n]; }
    }
};

__device__ __forceinline__ unsigned qpk4(float a, float b, float c, float d, float s) {
    unsigned w = __builtin_amdgcn_cvt_pk_u8_f32(__builtin_fmaf(a, s, 128.f), 0, 0u); w = __builtin_amdgcn_cvt_pk_u8_f32(__builtin_fmaf(b, s, 128.f), 1, w);
    w = __builtin_amdgcn_cvt_pk_u8_f32(__builtin_fmaf(c, s, 128.f), 2, w); w = __builtin_amdgcn_cvt_pk_u8_f32(__builtin_fmaf(d, s, 128.f), 3, w); return w ^ 0x80808080u; }
struct EpiSwiGLU {
    static constexpr bool PERM = true, AFTER_DRAIN = false;
    bf16_t* ACT; float dq, qa;
    __device__ __forceinline__ void operator()(const f32x4 (&acc)[2][2][4][2], const Unit& u, int wr, int wc, int fr, int fq) const {
        const int row0 = u.pm * BM + wr * 64 + fr, col0 = (u.pn & 3) * 128 + wc * 32 + 8 * fq;
#pragma unroll
        for (int ai = 0; ai < 2; ++ai)
#pragma unroll
            for (int m = 0; m < 4; ++m) { float a[8];
#pragma unroll
                for (int n = 0; n < 2; ++n)
#pragma unroll
                    for (int e = 0; e < 4; ++e) { const float gb = acc[ai][0][m][n][e], ub = acc[ai][1][m][n][e];
                        const float gv = (float)__float_as_int(gb) * dq, uv = (float)__float_as_int(ub) * dq;
                        a[4 * n + e] = gv * __builtin_amdgcn_rcpf(1.f + __expf(-gv)) * uv; }
                u32x2e w; w.x = qpk4(a[0], a[1], a[2], a[3], qa); w.y = qpk4(a[4], a[5], a[6], a[7], qa);
                asm volatile("global_store_dwordx2 %0, %1, off sc0 sc1" :: "v"((unsigned char*)ACT + (size_t)(row0 + ai * HALF + m * 16) * 512 + col0), "v"(w) : "memory"); }
    }
};
struct EpiScatter {
    static constexpr bool PERM = true, AFTER_DRAIN = false;
    bf16_t* YS; const PG8_LAS int* stab; float dq;
    __device__ __forceinline__ void operator()(const f32x4 (&acc)[2][2][4][2], const Unit& u, int wr, int wc, int fr, int fq) const {
        const int col0 = (u.pn & 3) * BM + wc * 32 + 8 * fq;
#pragma unroll
        for (int ai = 0; ai < 2; ++ai)
#pragma unroll
            for (int m = 0; m < 4; ++m) { const int slot = stab[u.aux * 256 + ai * HALF + wr * 64 + m * 16 + fr];
                if (slot >= 0) { unsigned char* rp = (unsigned char*)YS + (size_t)slot * 1024 + col0;
#pragma unroll
                    for (int bj = 0; bj < 2; ++bj) { const f32x4 r0 = acc[ai][bj][m][0], r1 = acc[ai][bj][m][1];
                        const f32x4 v0 = (f32x4){(float)__float_as_int(r0.x), (float)__float_as_int(r0.y), (float)__float_as_int(r0.z), (float)__float_as_int(r0.w)} * dq, v1 = (f32x4){(float)__float_as_int(r1.x), (float)__float_as_int(r1.y), (float)__float_as_int(r1.z), (float)__float_as_int(r1.w)} * dq;
                        u32x2e w; w.x = (unsigned)__builtin_amdgcn_cvt_pk_fp8_f32(v0[2], v0[3], __builtin_amdgcn_cvt_pk_fp8_f32(v0[0], v0[1], 0, false), true);
                        w.y = (unsigned)__builtin_amdgcn_cvt_pk_fp8_f32(v1[2], v1[3], __builtin_amdgcn_cvt_pk_fp8_f32(v1[0], v1[1], 0, false), true); *(u32x2e*)(rp + bj * HALF) = w; } } }
    }
};
struct MoeSched {
    const PG8_LAS int* ut;
    const PG8_LAS unsigned* tab;
    __device__ __forceinline__ bool next(int i, Unit& u) const { if (i >= 8) return false; const int pm = __builtin_amdgcn_readfirstlane(ut[2 * i]); if (pm < 0) return false;
        u.pm = pm; u.pn = __builtin_amdgcn_readfirstlane(ut[2 * i + 1]); u.aux = i; return true; }
    unsigned* tc; int mode;
    __device__ __forceinline__ unsigned arow(int ui, int r) const { return tab[ui * 256 + r]; }
    __device__ __forceinline__ void a_ready(const Unit& u) const { if (mode == 2) { unsigned* q = tc + u.pm * 16;
        while (__hip_atomic_load(q, __ATOMIC_RELAXED, __HIP_MEMORY_SCOPE_AGENT) < 32u) __builtin_amdgcn_s_sleep(2);
        asm volatile("" ::: "memory"); } }
    __device__ __forceinline__ void done(const Unit& u) const { if (mode == 1) { asm volatile("s_waitcnt vmcnt(0)" ::: "memory");
        if ((threadIdx.x & 63) == 0) __hip_atomic_fetch_add(tc + u.pm * 16, 1u, __ATOMIC_RELAXED, __HIP_MEMORY_SCOPE_AGENT); } }
};
}

constexpr int LDS_BYTES = 151552;
constexpr int MOE_LDS = 131072;
constexpr int MISC_OFF = 147712;
constexpr int CW_BAR = 4096;
#define GAS __attribute__((address_space(1)))
#define LAS __attribute__((address_space(3)))
typedef GAS unsigned gu32;
typedef GAS unsigned long long gu64;
#define RLX_AGENT __ATOMIC_RELAXED, __HIP_MEMORY_SCOPE_AGENT
#define LDS_WAIT() asm volatile("s_waitcnt lgkmcnt(0)" ::: "memory")
#define VM_WAIT() asm volatile("s_waitcnt vmcnt(0)" ::: "memory")
#define XB_TMO      128
#define XB_XCNT(j)  (256  + 64 * (j))
#define XB_XSUB(j)  (1280 + 64 * (j))
#define XB_XGEN(j)  (2304 + 64 * (j))
#define XB_TOP      3328
#define XB_TOPGEN   3392
#define XCD_BAR_WORDS 3456
#define XB_SPIN_CAP (1u << 22)

__device__ __forceinline__ unsigned xb_ld(unsigned* p)              { return __hip_atomic_load(p, __ATOMIC_RELAXED, __HIP_MEMORY_SCOPE_AGENT); }
__device__ __forceinline__ unsigned xb_add(unsigned* p, unsigned v) { return __hip_atomic_fetch_add(p, v, __ATOMIC_RELAXED, __HIP_MEMORY_SCOPE_AGENT); }
__device__ __forceinline__ unsigned xb_xcc_id() { return (unsigned)__builtin_amdgcn_s_getreg((3 << 11) | 20) & 0xFu; }
#define XB_SPIN(cond, bar) do { unsigned _sp = 0; while (cond) { __builtin_amdgcn_s_sleep(1); \
    if ((++_sp & 255u) == 0u) { if (xb_ld(&(bar)[XB_TMO])) break; if (_sp > XB_SPIN_CAP) { atomicAdd(&(bar)[XB_TMO], 1u); break; } } } } while (0)

struct XcdBarrier {
    unsigned* bar; unsigned x;
    volatile LAS unsigned* st;
};

__device__ __forceinline__ XcdBarrier xcd_barrier_post(unsigned* bar, volatile LAS unsigned* st) {
    XcdBarrier b; b.bar = bar; b.x = xb_xcc_id(); b.st = st;
    if (threadIdx.x == 0) (void)xb_add(&bar[XB_XCNT(b.x)], 1u);
    return b;
}
__device__ __forceinline__ void xcd_barrier_complete(unsigned* bar, unsigned x, unsigned& nloc, unsigned& nx) {
    const unsigned G = gridDim.x * gridDim.y * gridDim.z;
    unsigned sum, cnt, mine, sp = 0u;
    for (;;) {
        sum = 0u; cnt = 0u; mine = 0u;
#pragma unroll
        for (unsigned j = 0; j < 16; ++j) { const unsigned c = xb_ld(&bar[XB_XCNT(j)]); sum += c; cnt += (c > 0u) ? 1u : 0u; mine = (j == x) ? c : mine; }
        if (sum == G) break;
        __builtin_amdgcn_s_sleep(1);
        if ((++sp & 255u) == 0u) { if (xb_ld(&bar[XB_TMO])) break; if (sp > XB_SPIN_CAP) { atomicAdd(&bar[XB_TMO], 1u); break; } }
    }
    nloc = mine > 0u ? mine : 1u; nx = cnt > 0u ? cnt : 1u;
}

__device__ __forceinline__ void xcd_barrier(const XcdBarrier& b) {
    asm volatile("s_waitcnt vmcnt(0)" ::: "memory");
    __syncthreads();
    if (threadIdx.x == 0) {
        unsigned* bar = b.bar;
        __builtin_amdgcn_s_waitcnt(0);
        unsigned nloc = b.st[0], nx = b.st[1];
        if (nloc == 0u) { xcd_barrier_complete(bar, b.x, nloc, nx); b.st[0] = nloc; b.st[1] = nx; }
        const unsigned old = xb_add(&bar[XB_XSUB(b.x)], 1u);
        const unsigned gen = old / nloc;
        if (old + 1u == (gen + 1u) * nloc) {
            __builtin_amdgcn_fence(__ATOMIC_RELEASE, "agent");
            asm volatile("s_waitcnt vmcnt(0)" ::: "memory");
            const unsigned og = xb_add(&bar[XB_TOP], 1u);
            const unsigned tg = og / nx;
            if (og + 1u == (tg + 1u) * nx) xb_add(&bar[XB_TOPGEN], 1u);
            else XB_SPIN(xb_ld(&bar[XB_TOPGEN]) == tg, bar);
            __builtin_amdgcn_fence(__ATOMIC_ACQUIRE, "agent");
            xb_add(&bar[XB_XGEN(b.x)], 1u);
            asm volatile("s_waitcnt vmcnt(0)" ::: "memory");
        } else {
            XB_SPIN(xb_ld(&bar[XB_XGEN(b.x)]) == gen, bar);
            __builtin_amdgcn_fence(__ATOMIC_ACQUIRE, "agent");
            asm volatile("s_waitcnt vmcnt(0)" ::: "memory");
        }
    }
    __syncthreads();
}

__device__ __forceinline__ void inproj_phase(const P& p, PG8_LAS unsigned char* l3, int c, int G) {
    pg8::Gemm g{(const bf16*)(p.ws + WS_H), (const bf16*)(p.ws + WS_WIN), T, NQKV, D};
    pg8::StaticOrder S; S.init(T, NQKV, G, c);
    const float* cosT = (const float*)(p.ws + WS_ROPE);
    pg8::EpiInProj E{(bf16*)(p.ws + WS_R), cosT, cosT + SEQ * 32, 0.125f * 1.4426950408889634f, 1.f / (Q8_ACT * Q8_W), (unsigned*)(p.ws + WS_CTL) + CW_SMIN, (unsigned*)(p.ws + WS_CTL) + CW_NORM};
    pg8::gemm_phase<pg8::EpiInProj, pg8::StaticOrder, true, true, false, true>(l3, g, S, E);
}
__device__ __forceinline__ void outproj_phase(const P& p, PG8_LAS unsigned char* l3, int c, int G) {
    pg8::Gemm g{(const bf16*)(p.ws + WS_H), (const bf16*)(p.ws + WS_WOUT), T, D, D};
    pg8::StaticOrder S; S.init(T, D, G, c);
    pg8::EpiBf16P E{(bf16*)(p.ws + WS_R), D, 1.f / (Q8_MIX * Q8_W)};
    pg8::gemm_phase<pg8::EpiBf16P, pg8::StaticOrder, true, true, false, true>(l3, g, S, E);
}
__device__ __forceinline__ void moe_setup(const P& p, PG8_LAS unsigned char* ldsx, int c, int G, bool down) {
    const int tid = tid_fresh();
    PG8_LAS int* ts = (PG8_LAS int*)ldsx; PG8_LAS int* ut = (PG8_LAS int*)(ldsx + 256); PG8_LAS int* tab = (PG8_LAS int*)(ldsx + 512);
    const unsigned* cnt = (const unsigned*)(p.ws + WS_CTL); const int* list = (const int*)(p.ws + WS_LIST);
    if (tid == 0) { int s = 0; for (int e = 0; e < NE; ++e) { ts[e] = s; s += ((int)cnt[e * CNT_STRIDE] + 255) >> 8; } ts[NE] = s; }
    __syncthreads();
    if (tid < 8) { const int NU = ts[NE] * 4, cv = down ? (c + G - NU % G) % G : c, L = tid * G + cv;
        if (L < NU) { const int t = L >> 2; int e = 0; for (int q = 1; q < NE; ++q) if (ts[q] <= t) e = q; ut[2 * tid] = t; ut[2 * tid + 1] = e * 4 + (L & 3); } else { ut[2 * tid] = -1; ut[2 * tid + 1] = 0; } }
    __syncthreads();
    for (int idx = tid; idx < 8 * 256; idx += 512) { const int i = idx >> 8, r = idx & 255, pm = ut[2 * i]; int v = down ? -1 : 0;
        if (pm >= 0) { const int e = ut[2 * i + 1] >> 2, k = (pm - ts[e]) * 256 + r; if (k < (int)cnt[e * CNT_STRIDE]) { const int slot = list[e * T + k]; v = down ? slot : (slot >> 1) * D; } }
        tab[idx] = v; }
    __syncthreads();
}
__device__ __forceinline__ void moe1_phase(const P& p, PG8_LAS unsigned char* l3, int c, int G) {
    moe_setup(p, l3 + MOE_LDS, c, G, false);
    pg8::Gemm g{(const bf16*)(p.ws + WS_H), (const bf16*)(p.ws + WS_WGU), 0, 0, D};
    pg8::MoeSched S{(const PG8_LAS int*)(l3 + MOE_LDS + 256), (const PG8_LAS unsigned*)(l3 + MOE_LDS + 512), (unsigned*)(p.ws + WS_CTL) + CW_TILE, 1};
    pg8::EpiSwiGLU E{(bf16*)(p.ws + WS_ACT), 1.f / (Q8_ACT * Q8_W), Q8_ACT2};
    pg8::gemm_phase<pg8::EpiSwiGLU, pg8::MoeSched, true, true, true, true>(l3, g, S, E);
}
__device__ __forceinline__ void moe2_phase(const P& p, PG8_LAS unsigned char* l3, int c, int G) {
    moe_setup(p, l3 + MOE_LDS, c, G, true);
    pg8::Gemm g{(const bf16*)(p.ws + WS_ACT), (const bf16*)(p.ws + WS_WD), 0, 0, DE};
    pg8::MoeSched S{(const PG8_LAS int*)(l3 + MOE_LDS + 256), (const PG8_LAS unsigned*)(l3 + MOE_LDS + 512), (unsigned*)(p.ws + WS_CTL) + CW_TILE, 2};
    pg8::EpiScatter E{(bf16*)(p.ws + WS_R), (const PG8_LAS int*)(l3 + MOE_LDS + 512), 16.f / (Q8_ACT2 * Q8_WD)};
    pg8::gemm_phase<pg8::EpiScatter, pg8::MoeSched, true, true, false, true, true>(l3, g, S, E);
}

namespace attn_body {
using bf16=__hip_bfloat16;
using bf16x8=__attribute__((ext_vector_type(8)))short;
using s16x4=__attribute__((ext_vector_type(4)))short;
using f32x16=__attribute__((ext_vector_type(16)))float;
using u32x4=__attribute__((ext_vector_type(4)))unsigned;
using f32x4v=__attribute__((ext_vector_type(4)))float;
constexpr int SEQ=4096,D=64,QP=3072,OP=1024;
constexpr int NW=8,QBLK=32,QB=QBLK*NW,KVBLK=64,NQB=SEQ/QB;
__device__ __forceinline__ int crow(int r,int hi){return (r&3)+8*(r>>2)+4*hi;}
#define SBAR() __builtin_amdgcn_sched_barrier(0)
__device__ __forceinline__ void cmask(f32x16&p0,f32x16&p1,int jb,int qrel,int hi){
  const float NEG=-INFINITY; int kb=64*jb+4*hi;
  #pragma unroll
  for(int r=0;r<16;++r){int kv=kb+(r&3)+8*(r>>2); if(kv>qrel)p0[r]=NEG; if(kv+32>qrel)p1[r]=NEG;}
}

__device__ __forceinline__ void chmask(f32x16&p0,f32x16&p1,int jb,int wid){
  const float NEG=-INFINITY;
  if(jb>(wid>>1)){
  #pragma unroll
  for(int r=0;r<16;++r){p0[r]=NEG;p1[r]=NEG;}}
}
constexpr int NSLOT=3, SLOTB=8192;
constexpr int LDS_K=0, LDS_V=NSLOT*SLOTB, LDS_WS=LDS_V+2*NSLOT*SLOTB, LDS_OST=LDS_WS+NW*64*4, LDS_BYTES=LDS_OST+NW*4096, LDS_FB=LDS_BYTES, LDS_Y=LDS_OST;
static_assert(LDS_Y+NW*8192<=147456 && LDS_FB+16384<=147456, "attention LDS map");
constexpr float C2=0.125f*1.4426950408889634f;
__device__ __forceinline__ void glds16(const void*gsrc,unsigned lds_dst){unsigned keep;
  asm volatile("s_mov_b32 %0, m0\n\ts_mov_b32 m0, %2\n\ts_nop 0\n\tglobal_load_lds_dwordx4 %1, off\n\ts_mov_b32 m0, %0":"=&s"(keep):"v"(gsrc),"s"(lds_dst):"memory");}
__device__ __forceinline__ void glds16s(const void*sbase0,unsigned voff,unsigned lds_dst){unsigned keep;
  const unsigned long long sb_=(unsigned long long)(uintptr_t)sbase0; const void*sbase=(const void*)(uintptr_t)(((unsigned long long)(unsigned)__builtin_amdgcn_readfirstlane((int)(sb_>>32))<<32)|(unsigned)__builtin_amdgcn_readfirstlane((int)sb_));
  asm volatile("s_mov_b32 %0, m0\n\ts_mov_b32 m0, %2\n\ts_nop 0\n\tglobal_load_lds_dwordx4 %1, %3\n\ts_mov_b32 m0, %0":"=&s"(keep):"v"(voff),"s"(lds_dst),"s"(sbase):"memory");}
__device__ __forceinline__ float max3f(float a,float b,float c){float r;asm("v_max3_f32 %0, %1, %2, %3":"=v"(r):"v"(a),"v"(b),"v"(c));return r;}
__device__ __forceinline__ float max2f(float a,float b){float r;asm("v_max_f32_e32 %0, %1, %2":"=v"(r):"v"(a),"v"(b));return r;}
__device__ __forceinline__ float fadd_s(float a,float b){float r;asm("v_add_f32_e32 %0, %1, %2":"=v"(r):"v"(a),"v"(b));return r;}
__device__ __forceinline__ float fsub_s(float a,float b){float r;asm("v_sub_f32_e32 %0, %1, %2":"=v"(r):"v"(a),"v"(b));return r;}
typedef float f32x2_t __attribute__((ext_vector_type(2))); typedef __bf16 bf16x2_t __attribute__((ext_vector_type(2)));
__device__ __forceinline__ unsigned cvtpk_s(float lo,float hi){f32x2_t v={lo,hi};bf16x2_t b=__builtin_convertvector(v,bf16x2_t);return __builtin_bit_cast(unsigned,b);}
#define WAIT_BAR(N) asm volatile("s_waitcnt vmcnt(" #N ") lgkmcnt(0)\n\ts_barrier":::"memory")

__device__ __forceinline__ void qkt(f32x16&p0,f32x16&p1,const char*Kslot,const bf16x8*qr,const f32x16&negm,int r32,int hi){
  const char*kb=Kslot+hi*1024+r32*16;
  #pragma unroll
  for(int d0=0;d0<4;++d0){
    const bf16x8 b0=*reinterpret_cast<const bf16x8*>(kb+d0*2048);
    const bf16x8 b1=*reinterpret_cast<const bf16x8*>(kb+d0*2048+512);
    if(d0==0){p0=__builtin_amdgcn_mfma_f32_32x32x16_bf16(b0,qr[0],negm,0,0,0);p1=__builtin_amdgcn_mfma_f32_32x32x16_bf16(b1,qr[0],negm,0,0,0);}
    else{p0=__builtin_amdgcn_mfma_f32_32x32x16_bf16(b0,qr[d0],p0,0,0,0);p1=__builtin_amdgcn_mfma_f32_32x32x16_bf16(b1,qr[d0],p1,0,0,0);}}
}
__device__ __forceinline__ void qkt_acc(f32x16&p0,f32x16&p1,const char*Kslot,const bf16x8*qr,int r32,int hi){
  const char*kb=Kslot+hi*1024+r32*16;
  #pragma unroll
  for(int d0=0;d0<4;++d0){
    const bf16x8 b0=*reinterpret_cast<const bf16x8*>(kb+d0*2048);
    const bf16x8 b1=*reinterpret_cast<const bf16x8*>(kb+d0*2048+512);
    p0=__builtin_amdgcn_mfma_f32_32x32x16_bf16(b0,qr[d0],p0,0,0,0);p1=__builtin_amdgcn_mfma_f32_32x32x16_bf16(b1,qr[d0],p1,0,0,0);}
}
typedef __attribute__((address_space(3))) const float* lds_fptr;
__device__ __forceinline__ void bias4(f32x16&p,lds_fptr fb,int g){ const f32x4v v=*(const __attribute__((address_space(3))) f32x4v*)(fb+8*g); p[4*g]=v[0];p[4*g+1]=v[1];p[4*g+2]=v[2];p[4*g+3]=v[3]; }
__device__ __forceinline__ void sub4(f32x16&p,int g,float mh){ p[4*g]-=mh;p[4*g+1]-=mh;p[4*g+2]-=mh;p[4*g+3]-=mh; }
typedef __attribute__((address_space(3))) const char* lds_cptr;
typedef short v4i16_t __attribute__((ext_vector_type(4)));
__device__ __forceinline__ void kload8(bf16x8*kf,lds_cptr kp){
  kf[0]=*(const __attribute__((address_space(3))) bf16x8*)(kp);      kf[1]=*(const __attribute__((address_space(3))) bf16x8*)(kp+512);
  kf[2]=*(const __attribute__((address_space(3))) bf16x8*)(kp+2048); kf[3]=*(const __attribute__((address_space(3))) bf16x8*)(kp+2560);
  kf[4]=*(const __attribute__((address_space(3))) bf16x8*)(kp+4096); kf[5]=*(const __attribute__((address_space(3))) bf16x8*)(kp+4608);
  kf[6]=*(const __attribute__((address_space(3))) bf16x8*)(kp+6144); kf[7]=*(const __attribute__((address_space(3))) bf16x8*)(kp+6656);
}
__device__ __forceinline__ void kload2(bf16x8*kf,lds_cptr kp,int j){ kf[2*j]=*(const __attribute__((address_space(3))) bf16x8*)(kp+j*2048); kf[2*j+1]=*(const __attribute__((address_space(3))) bf16x8*)(kp+j*2048+512); }
__device__ __forceinline__ s16x4 vtr(lds_cptr p){ return __builtin_bit_cast(s16x4,__builtin_amdgcn_ds_read_tr16_b64_v4i16((__attribute__((address_space(3))) v4i16_t*)p)); }
__device__ __forceinline__ float rowmax(const f32x16&p0,const f32x16&p1){
  float a=max3f(p0[0],p0[1],p1[0]),b=max3f(p0[2],p0[3],p1[1]);a=max3f(a,p1[2],p1[3]);
  #pragma unroll
  for(int r=4;r<16;r+=4){a=max3f(a,p0[r],p0[r+1]);b=max3f(b,p0[r+2],p0[r+3]);a=max3f(a,p1[r],p1[r+1]);b=max3f(b,p1[r+2],p1[r+3]);}
  const float m=max2f(a,b);
  auto rr=__builtin_amdgcn_permlane32_swap(__float_as_uint(m),__float_as_uint(m),false,false);
  return max2f(__uint_as_float(rr[0]),__uint_as_float(rr[1]));
}
template<int ND> __device__ __forceinline__ void pv(f32x16*o,int vb,bf16x8 pa0,bf16x8 pa1,bf16x8 pa2,bf16x8 pa3){
  #pragma unroll
  for(int d0=0;d0<ND;++d0){s16x4 lo[4],hi[4];
    #pragma unroll
    for(int ks=0;ks<4;++ks){
      asm volatile("ds_read_b64_tr_b16 %0,%1 offset:%c2":"=&v"(lo[ks]):"v"(vb),"i"(d0*4096+ks*1024):"memory");
      asm volatile("ds_read_b64_tr_b16 %0,%1 offset:%c2":"=&v"(hi[ks]):"v"(vb),"i"(d0*4096+ks*1024+512):"memory");}
    asm volatile("s_waitcnt lgkmcnt(0)":::"memory");SBAR();
    #define PK(k) (bf16x8){lo[k][0],lo[k][1],lo[k][2],lo[k][3],hi[k][0],hi[k][1],hi[k][2],hi[k][3]}
    o[d0]=__builtin_amdgcn_mfma_f32_32x32x16_bf16(pa0,PK(0),o[d0],0,0,0);
    o[d0]=__builtin_amdgcn_mfma_f32_32x32x16_bf16(pa1,PK(1),o[d0],0,0,0);
    o[d0]=__builtin_amdgcn_mfma_f32_32x32x16_bf16(pa2,PK(2),o[d0],0,0,0);
    o[d0]=__builtin_amdgcn_mfma_f32_32x32x16_bf16(pa3,PK(3),o[d0],0,0,0);
    #undef PK
  }
}

#ifndef ATTN_STORE16
#define ATTN_STORE16(p,v) (*(u32x4*)(p)=(v))
#endif
template<int THRL,int MODE,class Epi,bool UREF=false> __device__ __forceinline__ void attn_unit(int qb,int t0,const bf16*Q,const bf16*__restrict__ K,const bf16*__restrict__ V,char*shm,const Epi&epi){
  const int tid=tid_fresh(),lane=tid&63,r32=lane&31,hi=lane>>5; const int wid=__builtin_amdgcn_readfirstlane(tid>>6);
  constexpr int VM=(MODE==1)?2:1, ND=(MODE==1)?4:2;
  const int q0=qb*QB;
  const bf16*Qw=Q+(long)(q0+wid*QBLK)*QP;
  const bf16*Kh=K+(long)t0*KVBLK*QP,*Vh=V+(long)t0*KVBLK*QP;
  const unsigned lds0=(unsigned)(uintptr_t)shm;
  float*wsf=(float*)(shm+LDS_WS)+wid*64;
  const unsigned koff=(unsigned)((lane*QP+wid*8)*2), voff=(unsigned)(((16*(wid&3)+(lane>>2))*QP+(wid>>2)*32+(lane&3)*8)*2);
  const unsigned kdst=lds0+LDS_K+wid*1024, vdst=lds0+LDS_V+wid*1024;
  #define DMA_K(t,slot) glds16s(Kh+(long)(t)*KVBLK*QP,koff,(unsigned)__builtin_amdgcn_readfirstlane(kdst+(slot)))
  #define DMA_V(t,slot) do{ glds16s(Vh+(long)(t)*KVBLK*QP,voff,(unsigned)__builtin_amdgcn_readfirstlane(vdst+VM*(slot))); if constexpr(MODE==1) glds16s(Vh+64+(long)(t)*KVBLK*QP,voff,(unsigned)__builtin_amdgcn_readfirstlane(vdst+VM*(slot)+8192)); }while(0)
  const int vb0=(int)(lds0+LDS_V)+((lane>>4)&1)*32+(lane&3)*8+(4*hi+((lane&15)>>2))*64;
  const char*Kbase=shm+LDS_K; bf16x8 kf[8];
  const lds_cptr shm3=(lds_cptr)shm; const lds_fptr fb0=(lds_fptr)(shm3+LDS_FB)+4*hi; const lds_cptr kp0=shm3+LDS_K+hi*1024+r32*16; const lds_cptr vp0=shm3+LDS_V+((lane>>4)&1)*32+(lane&3)*8+(4*hi+((lane&15)>>2))*64;
  const int NT=(q0+QB)/KVBLK-t0;
  DMA_K(0,0);DMA_V(0,0);DMA_K(1,SLOTB);
  bf16x8 qr[4];
  #pragma unroll
  for(int d0=0;d0<4;++d0)qr[d0]=*reinterpret_cast<const bf16x8*>(&Qw[(long)r32*QP+d0*16+hi*8]);
  const f32x16 zero16=f32x16{}; float mhat=0.f,l_reg=0.f;f32x16 o[ND];
  #pragma unroll
  for(int d_=0;d_<ND;++d_)o[d_]=f32x16{};
  const int qrel=wid*QBLK+r32;
  #define CMASK(P0,P1,t) do{int jb_=(t)-(NT-4); if(jb_>=0){ if constexpr(MODE==0)cmask(P0,P1,jb_,qrel,hi); else chmask(P0,P1,jb_,wid);} }while(0)
  bool resc=false;
  #define START(P0,P1) do{ resc=false; \
    _Pragma("unroll") for(int r=0;r<16;++r)P0[r]=__builtin_amdgcn_exp2f(P0[r]); }while(0)
  #define RESC() do{ if(resc){ asm volatile("s_waitcnt lgkmcnt(0)":::"memory"); \
      _Pragma("unroll") for(int d_=0;d_<ND;++d_) _Pragma("unroll") for(int r=0;r<16;++r)o[d_][r]*=wsf[crow(r,hi)]; } }while(0)
  f32x16 pA0,pA1,pB0,pB1;
  int sl_prev=0,sl_cur=0,sl_next=SLOTB;
  #define ROT() do{sl_prev=sl_cur;sl_cur=sl_next;sl_next=(sl_next==(NSLOT-1)*SLOTB)?0:sl_next+SLOTB;}while(0)
  DMA_K(2,2*SLOTB);
  #define WB(n0,n1) do{ if constexpr(MODE==1){WAIT_BAR(n1);} else {WAIT_BAR(n0);} }while(0)
  WB(3,4);
  if constexpr(MODE==0){ if constexpr(!UREF) mhat=((lds_fptr)(shm3+LDS_FB))[q0-t0*KVBLK+wid*QBLK+r32]+8.0f;
    _Pragma("unroll") for(int g=0;g<4;++g){bias4(pA0,fb0,g);if constexpr(!UREF)sub4(pA0,g,mhat);bias4(pA1,fb0+32,g);if constexpr(!UREF)sub4(pA1,g,mhat);} }
  else { pA0=f32x16{}; pA1=f32x16{}; }
  qkt_acc(pA0,pA1,Kbase,qr,r32,hi);
  asm volatile("s_nop 15\n\ts_nop 7":"+v"(pA0),"+v"(pA1));CMASK(pA0,pA1,0);
  START(pA0,pA1);
  if constexpr(MODE==0){ _Pragma("unroll") for(int g=0;g<4;++g){bias4(pB0,fb0+64,g);if constexpr(!UREF)sub4(pB0,g,mhat);bias4(pB1,fb0+96,g);if constexpr(!UREF)sub4(pB1,g,mhat);} }

  _Pragma("unroll") for(int r=0;r<16;++r)pA1[r]=__builtin_amdgcn_exp2f(pA1[r]);
  WAIT_BAR(0);
  DMA_K(3,0);DMA_V(1,SLOTB);
  ROT();
  kload8(kf,kp0+sl_cur);
  WB(2,3);
  s16x4 vlo[8],vhi[8]; u32x4 pw0,pw1,pw2,pw3;
  #define PKW(P,B) cvtpk_s(P[B],P[B+1])
  #define PAF(k) __builtin_bit_cast(bf16x8,pw##k)
  #define VFR(i) (bf16x8){vlo[i][0],vlo[i][1],vlo[i][2],vlo[i][3],vhi[i][0],vhi[i][1],vhi[i][2],vhi[i][3]}
  #define PIN(x) asm volatile("":"+v"(x))
  #define MX3(a,b,c) __builtin_fmaxf(__builtin_fmaxf((a),(b)),(c))
  #define GAPA(MF,A0,A1,A2,A3,W0,W1,PW) do{ MF; sacc+=A0; sacc+=A1; sacc+=A2; sacc+=A3; PIN(sacc); W0; W1; PIN(PW); SBAR(); }while(0)
  #define EX(v) __builtin_amdgcn_exp2f(v)
  #define GAPB(MF,X,B) do{ MF; X[B]=EX(X[B]); X[B+1]=EX(X[B+1]); X[B+2]=EX(X[B+2]); X[B+3]=EX(X[B+3]); PIN(X); SBAR(); }while(0)
  #define VRD(i) do{ vlo[i]=vtr(vp_+(((i)>>2)*4096+((i)&3)*1024)); vhi[i]=vtr(vp_+(((i)>>2)*4096+((i)&3)*1024+512)); }while(0)
  #define KRD(G,j) do{ if(G){ kload2(kf,kp0+sl_next,j); SBAR(); } }while(0)
  #define CIN(X) (MODE==1?zero16:X)
  #define GAPB2(MF,RD,X,B) do{ MF; RD; X[B]=EX(X[B]); X[B+1]=EX(X[B+1]); PIN(X); SBAR(); }while(0)
  #define VF(k) do{ vlo[(k)&3]=vtr(vp_+(((k)>>3)*8192+((k)&1)*4096+(((k)&7)>>1)*1024)); vhi[(k)&3]=vtr(vp_+(((k)>>3)*8192+((k)&1)*4096+(((k)&7)>>1)*1024+512)); }while(0)
  #define VRDA(i) do{ if constexpr(MODE==0){ VRD(i); } else { if((i)==2){VF(0);} else if((i)==6){VF(1);} else if((i)==3){VF(2);} else if((i)==7){VF(3);} } }while(0)
  #define VFQ(q) (bf16x8){vlo[q][0],vlo[q][1],vlo[q][2],vlo[q][3],vhi[q][0],vhi[q][1],vhi[q][2],vhi[q][3]}
  #define PFM(G,P,g) do{ (void)nm_; }while(0)
  #define PFR(G,P,i,t) do{ if constexpr(MODE==0){ if(G){ bias4(P,fb0+64*((t)+1)+32*((i)>>2),(i)&3); } } }while(0)
  #define PFS(G,P,i) do{ if constexpr(MODE==0&&!UREF){ if(G){ sub4(P,(i)&3,mhat); PIN(P); } } }while(0)
  #define STEP(C0,C1,P0,P1,t,GK,GV,GL) do{ SBAR(); \
    const lds_cptr vp_=vp0+VM*sl_prev; \
    VRDA(0); SBAR(); float sacc=(P0[0]+P0[1]); \
    GAPA(C0=__builtin_amdgcn_mfma_f32_32x32x16_bf16(kf[0],qr[0],CIN(C0),0,0,0), P0[2],P0[3],P0[4],P0[5],     pw0[0]=PKW(P0,0), pw0[1]=PKW(P0,2), pw0); \
    VRDA(4); SBAR(); GAPA(C1=__builtin_amdgcn_mfma_f32_32x32x16_bf16(kf[1],qr[0],CIN(C1),0,0,0), P0[6],P0[7],P0[8],P0[9],     pw0[2]=PKW(P0,4), pw0[3]=PKW(P0,6), pw0); \
    PFR(GL,P0,0,t); VRDA(1); SBAR(); GAPA(C0=__builtin_amdgcn_mfma_f32_32x32x16_bf16(kf[2],qr[1],C0,0,0,0),   P0[10],P0[11],P0[12],P0[13], pw1[0]=PKW(P0,8), pw1[1]=PKW(P0,10), pw1); \
    PFR(GL,P0,1,t); VRDA(5); SBAR(); GAPA(C1=__builtin_amdgcn_mfma_f32_32x32x16_bf16(kf[3],qr[1],C1,0,0,0),   P0[14],P0[15],P1[0],P1[1],   pw1[2]=PKW(P0,12),pw1[3]=PKW(P0,14), pw1); \
    PFR(GL,P0,2,t); VRDA(2); SBAR(); GAPA(C0=__builtin_amdgcn_mfma_f32_32x32x16_bf16(kf[4],qr[2],C0,0,0,0),   P1[2],P1[3],P1[4],P1[5],     pw2[0]=PKW(P1,0), pw2[1]=PKW(P1,2), pw2); \
    PFR(GL,P0,3,t); VRDA(6); SBAR(); GAPA(C1=__builtin_amdgcn_mfma_f32_32x32x16_bf16(kf[5],qr[2],C1,0,0,0),   P1[6],P1[7],P1[8],P1[9],     pw2[2]=PKW(P1,4), pw2[3]=PKW(P1,6), pw2); \
    PFR(GL,P1,4,t); VRDA(3); SBAR(); GAPA(C0=__builtin_amdgcn_mfma_f32_32x32x16_bf16(kf[6],qr[3],C0,0,0,0),   P1[10],P1[11],P1[12],P1[13], pw3[0]=PKW(P1,8), pw3[1]=PKW(P1,10), pw3); \
    PFR(GL,P1,5,t); VRDA(7); SBAR(); GAPA(C1=__builtin_amdgcn_mfma_f32_32x32x16_bf16(kf[7],qr[3],C1,0,0,0),   P1[14],P1[15],0.f,0.f,       pw3[2]=PKW(P1,12),pw3[3]=PKW(P1,14), pw3); \
    l_reg+=sacc; \
    if(GK){DMA_K((t)+3,sl_cur);} if(GV){DMA_V((t)+1,sl_next);} \
    CMASK(C0,C1,t); \
    resc=false; \
    if constexpr(false)   \
    { float a=MX3(C0[0],C0[1],C1[0]),b=MX3(C0[2],C0[3],C1[1]); a=MX3(a,C1[2],C1[3]); \
      _Pragma("unroll") for(int r=4;r<16;r+=4){a=MX3(a,C0[r],C0[r+1]);b=MX3(b,C0[r+2],C0[r+3]);a=MX3(a,C1[r],C1[r+1]);b=MX3(b,C1[r+2],C1[r+3]);} \
      float rm=__builtin_fmaxf(a,b); { auto rr=__builtin_amdgcn_permlane32_swap(__float_as_uint(rm),__float_as_uint(rm),false,false); rm=__builtin_fmaxf(__uint_as_float(rr[0]),__uint_as_float(rr[1])); } \
      resc=false; \
      if(__builtin_expect(__any(rm>(float)THRL),0)){ const float dl=__builtin_fmaxf(rm,0.f); mhat+=dl; \
        _Pragma("unroll") for(int r=0;r<16;++r){C0[r]-=dl;C1[r]-=dl;} \
        const float f=__builtin_amdgcn_exp2f(-dl); l_reg*=f; if(hi==0)wsf[r32]=f; resc=true; } } \
    SBAR(); \
    if constexpr(MODE==0){ \
    PFR(GL,P1,6,t); PFS(GL,P0,0); PFS(GL,P0,1); GAPB(o[0]=__builtin_amdgcn_mfma_f32_32x32x16_bf16(PAF(0),VFR(0),o[0],0,0,0), C0,0); \
    PFR(GL,P1,7,t); PFS(GL,P0,2); PFS(GL,P0,3); GAPB(o[1]=__builtin_amdgcn_mfma_f32_32x32x16_bf16(PAF(0),VFR(4),o[1],0,0,0), C0,4); \
    PFS(GL,P1,4); KRD(GL,0); GAPB(o[0]=__builtin_amdgcn_mfma_f32_32x32x16_bf16(PAF(1),VFR(1),o[0],0,0,0), C0,8); \
    PFS(GL,P1,5); KRD(GL,1); GAPB(o[1]=__builtin_amdgcn_mfma_f32_32x32x16_bf16(PAF(1),VFR(5),o[1],0,0,0), C0,12); \
    PFS(GL,P1,6); KRD(GL,2); GAPB(o[0]=__builtin_amdgcn_mfma_f32_32x32x16_bf16(PAF(2),VFR(2),o[0],0,0,0), C1,0); \
    PFS(GL,P1,7); KRD(GL,3); GAPB(o[1]=__builtin_amdgcn_mfma_f32_32x32x16_bf16(PAF(2),VFR(6),o[1],0,0,0), C1,4); \
    GAPB(o[0]=__builtin_amdgcn_mfma_f32_32x32x16_bf16(PAF(3),VFR(3),o[0],0,0,0), C1,8); \
    GAPB(o[1]=__builtin_amdgcn_mfma_f32_32x32x16_bf16(PAF(3),VFR(7),o[1],0,0,0), C1,12); \
    } else { \
    const float nm_=-mhat; \
    GAPB2(o[0]=__builtin_amdgcn_mfma_f32_32x32x16_bf16(PAF(0),VFQ(0),o[0],0,0,0), VF(4), C0,0); \
    GAPB2(o[1]=__builtin_amdgcn_mfma_f32_32x32x16_bf16(PAF(0),VFQ(1),o[1],0,0,0), VF(5), C0,2); \
    KRD(GL,0); GAPB2(o[0]=__builtin_amdgcn_mfma_f32_32x32x16_bf16(PAF(1),VFQ(2),o[0],0,0,0), VF(6), C0,4); \
    KRD(GL,1); GAPB2(o[1]=__builtin_amdgcn_mfma_f32_32x32x16_bf16(PAF(1),VFQ(3),o[1],0,0,0), VF(7), C0,6); \
    KRD(GL,2); GAPB2(o[0]=__builtin_amdgcn_mfma_f32_32x32x16_bf16(PAF(2),VFQ(0),o[0],0,0,0), VF(8), C0,8); \
    KRD(GL,3); GAPB2(o[1]=__builtin_amdgcn_mfma_f32_32x32x16_bf16(PAF(2),VFQ(1),o[1],0,0,0), VF(9), C0,10); \
    GAPB2(o[0]=__builtin_amdgcn_mfma_f32_32x32x16_bf16(PAF(3),VFQ(2),o[0],0,0,0), VF(10), C0,12); \
    GAPB2(o[1]=__builtin_amdgcn_mfma_f32_32x32x16_bf16(PAF(3),VFQ(3),o[1],0,0,0), VF(11), C0,14); \
    GAPB2(o[2]=__builtin_amdgcn_mfma_f32_32x32x16_bf16(PAF(0),VFQ(0),o[2],0,0,0), VF(12); PFM(GL,P0,0), C1,0); \
    GAPB2(o[3]=__builtin_amdgcn_mfma_f32_32x32x16_bf16(PAF(0),VFQ(1),o[3],0,0,0), VF(13); PFM(GL,P0,1), C1,2); \
    GAPB2(o[2]=__builtin_amdgcn_mfma_f32_32x32x16_bf16(PAF(1),VFQ(2),o[2],0,0,0), VF(14); PFM(GL,P0,2), C1,4); \
    GAPB2(o[3]=__builtin_amdgcn_mfma_f32_32x32x16_bf16(PAF(1),VFQ(3),o[3],0,0,0), VF(15); PFM(GL,P0,3), C1,6); \
    GAPB2(o[2]=__builtin_amdgcn_mfma_f32_32x32x16_bf16(PAF(2),VFQ(0),o[2],0,0,0), (void)0; PFM(GL,P1,0), C1,8); \
    GAPB2(o[3]=__builtin_amdgcn_mfma_f32_32x32x16_bf16(PAF(2),VFQ(1),o[3],0,0,0), (void)0; PFM(GL,P1,1), C1,10); \
    GAPB2(o[2]=__builtin_amdgcn_mfma_f32_32x32x16_bf16(PAF(3),VFQ(2),o[2],0,0,0), (void)0; PFM(GL,P1,2), C1,12); \
    GAPB2(o[3]=__builtin_amdgcn_mfma_f32_32x32x16_bf16(PAF(3),VFQ(3),o[3],0,0,0), (void)0; PFM(GL,P1,3), C1,14); \
    } \
    }while(0)
  int t=1;
  #undef CMASK
  #define CMASK(P0,P1,t) do{}while(0)
  for(;t+5<NT;t+=2){
    STEP(pB0,pB1,pA0,pA1,t,true,true,true);     WB(2,3); RESC(); ROT();
    STEP(pA0,pA1,pB0,pB1,t+1,true,true,true);   WB(2,3); RESC(); ROT();
  }
  #undef CMASK
  #define CMASK(P0,P1,t) do{int jb_=(t)-(NT-4); if(jb_>=0){ if constexpr(MODE==0)cmask(P0,P1,jb_,qrel,hi); else chmask(P0,P1,jb_,wid);} }while(0)
  #define ENDW(tt) do{ if((tt)+3<NT){WB(2,3);} else if((tt)+2<NT){WB(1,2);} else {WAIT_BAR(0);} }while(0)
  for(;t+1<NT;t+=2){
    STEP(pB0,pB1,pA0,pA1,t,(t+3<NT),(t+1<NT),(t+1<NT));       ENDW(t);   RESC(); ROT();
    STEP(pA0,pA1,pB0,pB1,t+1,(t+4<NT),(t+2<NT),(t+2<NT));     ENDW(t+1); RESC(); ROT();
  }
  STEP(pB0,pB1,pA0,pA1,NT-1,false,false,false); RESC();
  { float sacc=pB0[0]+pB0[1]; _Pragma("unroll") for(int r=2;r<16;++r)sacc+=pB0[r]; _Pragma("unroll") for(int r=0;r<16;++r)sacc+=pB1[r]; l_reg+=sacc;
    pw0=(u32x4){PKW(pB0,0),PKW(pB0,2),PKW(pB0,4),PKW(pB0,6)};pw1=(u32x4){PKW(pB0,8),PKW(pB0,10),PKW(pB0,12),PKW(pB0,14)};pw2=(u32x4){PKW(pB1,0),PKW(pB1,2),PKW(pB1,4),PKW(pB1,6)};pw3=(u32x4){PKW(pB1,8),PKW(pB1,10),PKW(pB1,12),PKW(pB1,14)};
    SBAR(); pv<ND>(o,vb0+VM*sl_cur,PAF(0),PAF(1),PAF(2),PAF(3)); }
  #undef PKW
  #undef PAF
  #undef VFR
  #undef PIN
  #undef MX3
  #undef GAPA
  #undef GAPB
  #undef EX
  #undef VRD
  #undef KRD
  #undef STEP
  #undef CIN
  #undef PFR
  #undef PFS
  #undef GAPB2
  #undef VF
  #undef VRDA
  #undef VFQ
  #undef PFM
  #undef WB
  #undef ENDW
  {auto rr=__builtin_amdgcn_permlane32_swap(__float_as_uint(l_reg),__float_as_uint(l_reg),false,false);l_reg=__uint_as_float(rr[0])+__uint_as_float(rr[1]);}
  if(hi==0)wsf[32+r32]=l_reg;asm volatile("s_waitcnt lgkmcnt(0)":::"memory");
  float rli[16];
  #pragma unroll
  for(int r=0;r<16;++r)rli[r]=__builtin_amdgcn_rcpf(wsf[32+crow(r,hi)]);
  epi(o,rli,shm,q0,wid,lane,r32,hi);
  asm volatile("s_waitcnt lgkmcnt(0)\n\ts_barrier":::"memory");
  #undef DMA_K
  #undef DMA_V
  #undef CMASK
  #undef START
  #undef RESC
  #undef ROT
}

typedef unsigned u32x2q __attribute__((ext_vector_type(2)));
__device__ __forceinline__ unsigned q4i8(float a,float b,float c,float d){ unsigned w=__builtin_amdgcn_cvt_pk_u8_f32((a+128.f),0,0u); w=__builtin_amdgcn_cvt_pk_u8_f32((b+128.f),1,w); w=__builtin_amdgcn_cvt_pk_u8_f32((c+128.f),2,w); w=__builtin_amdgcn_cvt_pk_u8_f32((d+128.f),3,w); return w^0x80808080u; }
constexpr float QMIX=127.f/4.f;
struct EpiFox {
  bf16*O;
  __device__ __forceinline__ void operator()(const f32x16(&o)[2],const float(&rli)[16],char*shm,int q0,int wid,int lane,int r32,int hi)const{
    signed char*Ow=(signed char*)O+(long)(q0+wid*QBLK)*OP; signed char*stg=(signed char*)(shm+LDS_OST)+wid*2048;
    #pragma unroll
    for(int r=0;r<16;++r){const int orow=crow(r,hi);
      #pragma unroll
      for(int d0=0;d0<2;++d0)stg[orow*64+d0*32+r32]=(signed char)__float2int_rn(fminf(fmaxf(o[d0][r]*rli[r]*QMIX,-127.f),127.f));}
    asm volatile("s_waitcnt lgkmcnt(0)":::"memory");
    #pragma unroll
    for(int i=0;i<4;++i){const int row=i*8+(lane>>3),ch=lane&7; const u32x2q v=*(const u32x2q*)(stg+row*64+ch*8); *(u32x2q*)(Ow+(long)row*OP+ch*8)=v;} }
};
struct EpiDiff {
  bf16*O; const float*gsub; float lam; int map;
  __device__ __forceinline__ void operator()(const f32x16(&o)[4],const float(&rli)[16],char*shm,int q0,int wid,int lane,int r32,int hi)const{
    bf16*Y=(bf16*)(shm+LDS_Y)+wid*4096;
    if(map==0){
      #pragma unroll
      for(int r=0;r<16;++r){const int orow=crow(r,hi);
        #pragma unroll
        for(int d0=0;d0<4;++d0)Y[orow*128+d0*32+r32]=__float2bfloat16(o[d0][r]*rli[r]);}
    } else {
      #pragma unroll
      for(int r=0;r<16;++r){const int orow=crow(r,hi);
        #pragma unroll
        for(int d0=0;d0<4;++d0){const int idx=orow*128+d0*32+r32; Y[idx]=__float2bfloat16(__bfloat162float(Y[idx])-lam*(o[d0][r]*rli[r]));}}
      asm volatile("s_waitcnt lgkmcnt(0)":::"memory");
      signed char*Ow=(signed char*)O+(long)(q0+wid*QBLK)*OP;
      #pragma unroll
      for(int i=0;i<8;++i){const int row=i*4+(lane>>4),ch=lane&15; const u32x4 v=*(const u32x4*)(Y+row*128+ch*8);
        float f[8];
        #pragma unroll
        for(int e=0;e<4;++e){f[2*e]=__builtin_bit_cast(float,v[e]<<16);f[2*e+1]=__builtin_bit_cast(float,v[e]&0xffff0000u);}
        float ss=0.f;
        #pragma unroll
        for(int e=0;e<8;++e)ss+=f[e]*f[e];
        ss+=__shfl_xor(ss,1);ss+=__shfl_xor(ss,2);ss+=__shfl_xor(ss,4);ss+=__shfl_xor(ss,8);
        const float rinv=rsqrtf(ss*(1.f/128.f)+1e-6f)*0.8f;
        const f32x4v g0=*(const f32x4v*)(gsub+ch*8),g1=*(const f32x4v*)(gsub+ch*8+4);
        const float rq=rinv*QMIX; u32x2q w; w[0]=q4i8(f[0]*rq*g0[0],f[1]*rq*g0[1],f[2]*rq*g0[2],f[3]*rq*g0[3]); w[1]=q4i8(f[4]*rq*g1[0],f[5]*rq*g1[1],f[6]*rq*g1[2],f[7]*rq*g1[3]);
        *(u32x2q*)(Ow+(long)row*OP+ch*8)=w; }
    }
  }
};
#undef SBAR
#undef WAIT_BAR
}

__device__ __forceinline__ void attn_phase(const P& p, char* lds, int c, int G) {
    using attn_body::QP; using attn_body::OP; using attn_body::LDS_FB; using attn_body::EpiDiff; using attn_body::EpiFox; using attn_body::attn_unit;
    const int tid = tid_fresh(), lane = tid & 63;
    const int vcu = (G % 8 == 0) ? (c % 8) * (G / 8) + c / 8 : c;
    const attn_body::bf16* QKV = (const attn_body::bf16*)(p.ws + WS_R); attn_body::bf16* MIX = (attn_body::bf16*)(p.ws + WS_H);
    const float lam = ((const float*)(p.ws + WS_SCAL))[0];
    const float* FB = (const float*)(p.ws + WS_F);
    for (int item = vcu; item < 256; item += G) {
        const int bh = item >> 3, s = item & 7, b = bh >> 2, h = bh & 3;
        const attn_body::bf16* base = QKV + (size_t)b * SEQ * QP;
        for (int qi = 0; qi < 2; ++qi) { const int qb = qi ? s : 15 - s;
            for (int map = 0; map < 2; ++map) {
                const EpiDiff E{(attn_body::bf16*)((signed char*)MIX + (size_t)b * SEQ * OP + h * 128), p.g_subln, lam, map};
                attn_unit<8, 1>(qb, 0, base + (2 * h + map) * 64, base + 512 + (2 * h + map) * 64, base + 1024 + h * 128, lds, E);
                if (qi == 0) { const int nr = (CV_ITEMS - CV_IN + G * 8 - 1) / (G * 8), hr = (nr + 1) / 2;
                    convert_items(p, (unsigned char*)lds, c, G, CV_IN, CV_ITEMS, map ? hr : 0, map ? nr : hr); } } }
    }
    {
        unsigned* ctl = (unsigned*)(p.ws + WS_CTL); volatile int* ubox = (volatile int*)(lds + LDS_FB + 16384);
        const int nb_q = (G % 8 == 0) ? 1 : 8;
        for (int bi = 0; bi < nb_q; ++bi) { const int b = (G % 8 == 0) ? (c % 8) : bi;
            for (;;) {
                if (tid == 0) *ubox = (int)atomicAdd(ctl + CW_FOXQ + 64 * b, 1u);
                __syncthreads();
                const int u = __builtin_amdgcn_readfirstlane(*ubox);
                __syncthreads();
                if (u >= 128) break;
                const int qb = 15 - (u >> 3), h = u & 7;
                const float* Fg = FB + (size_t)(b * 8 + h) * SEQ; const unsigned* nr = ctl + CW_NORM + (b * 8 + h) * 4;
                const float qn = sqrtf(__uint_as_float(nr[0]) + __uint_as_float(nr[1])), kn = sqrtf(__uint_as_float(nr[2]) + __uint_as_float(nr[3]));
                const int* sm = (const int*)ctl + CW_SMIN + ((b * 8 + h) * 16 + qb) * 2; const int s0 = sm[0], s1 = sm[1];
                const float sself = __int_as_float(s0 >= 0 ? s0 : s0 ^ 0x7fffffff) + __int_as_float(s1 >= 0 ? s1 : s1 ^ 0x7fffffff);
                const float bound = 1.03f * qn * kn - sself;
                float drop = lane < 4 * qb ? 64.f * __builtin_amdgcn_exp2f(bound + (Fg[64 * lane + 63] - Fg[256 * qb])) : 0.f;
#pragma unroll
                for (int o = 1; o < 64; o <<= 1) { const float t = __shfl_up(drop, o); if (lane >= o) drop += t; }
                const bool skip = lane < 4 * qb && drop < 5.9604645e-8f;
                const int t0 = __builtin_amdgcn_readfirstlane(__builtin_popcountll(__ballot(skip)) & ~1);
                const attn_body::bf16* base = QKV + (size_t)b * SEQ * QP;
                float* fb = (float*)(lds + LDS_FB); const int nk = (qb + 1) * 256 - 64 * t0;
                const EpiFox E{(attn_body::bf16*)((signed char*)MIX + (size_t)b * SEQ * OP + 512 + h * 64)};
                const float fend = Fg[256 * qb + 255], fbeg = Fg[256 * qb];
                if (__builtin_amdgcn_readfirstlane((int)(fend - fbeg < 64.f))) {
                    const float ref = fend + 8.f;
                    for (int i = tid; i < nk; i += 512) fb[i] = Fg[64 * t0 + i] - ref;
                    attn_unit<16, 0, EpiFox, true>(qb, t0, base + 1536 + h * 64, base + 2048 + h * 64, base + 2560 + h * 64, lds, E);
                } else {
                    for (int i = tid; i < nk; i += 512) fb[i] = Fg[64 * t0 + i];
                    attn_unit<16, 0, EpiFox, false>(qb, t0, base + 1536 + h * 64, base + 2048 + h * 64, base + 2560 + h * 64, lds, E);
                }
            }
        }
    }
}

#ifndef MK_N_LAUNCHES
#define MK_N_LAUNCHES 1
#endif
constexpr int N_PHASES = 9;
#define REP_PRO 1
#define REP_NORM1 1
#define REP_INPROJ 1
#define REP_ATTN 1
#define REP_OUTPROJ 1
#define REP_MOE1 1
#define REP_MOE2 1
#define REPEAT(n) _Pragma("nounroll") for (int r_ = 0; r_ < (n); ++r_)
struct Args { P p; int ph_lo, ph_hi; };
__global__ void __launch_bounds__(512, 2) mega(Args a) {
    extern __shared__ __attribute__((aligned(16))) unsigned char lds[];
    const P& p = a.p;
    PG8_LAS unsigned char* l3 = (PG8_LAS unsigned char*)lds;
    const int G = (int)gridDim.x, c = (int)blockIdx.x;
    volatile LAS unsigned* MISC = (volatile LAS unsigned*)(l3 + MISC_OFF);
    if (threadIdx.x < 32) MISC[threadIdx.x] = 0u;
    __syncthreads();
    XcdBarrier bar; bar.bar = (unsigned*)(p.ws + WS_CTL) + CW_BAR; bar.x = 0; bar.st = nullptr;
    if (MK_N_LAUNCHES == 1) bar = xcd_barrier_post((unsigned*)(p.ws + WS_CTL) + CW_BAR, MISC + 8);
    const int lo = a.ph_lo, hi = a.ph_hi;
#define IN(k) (lo <= (k) && (k) < hi)
#define SEAM(k) do { if (IN(k) && IN((k) + 1)) xcd_barrier(bar); } while (0)
    if (IN(0)) { REPEAT(REP_PRO) { prologue_phase(p, lds, c, G); __syncthreads(); } } SEAM(0);
    if (IN(1)) { REPEAT(REP_NORM1) { norm1_phase(p, lds, c, G); __syncthreads(); } } SEAM(1);
    if (IN(2)) { scan_phase(p, (float*)(lds + 1024), c, G); __syncthreads(); REPEAT(REP_INPROJ) inproj_phase(p, l3, c, G); } SEAM(2);
    if (IN(3)) { REPEAT(REP_ATTN) attn_phase(p, (char*)lds, c, G); } SEAM(3);
    if (IN(4)) { REPEAT(REP_OUTPROJ) outproj_phase(p, l3, c, G); } SEAM(4);
    if (IN(5)) { router_phase(p, lds, c, G); } SEAM(5);
    if (IN(6)) { moe1_phase(p, l3, c, G); moe2_phase(p, l3, c, G); }
    SEAM(7);
    if (IN(8)) { final_phase(p, c, G); }
#undef IN
#undef SEAM
}
}

extern "C" void kernel_launch(void* const* d_in, const int* in_sizes, int n_in, void* d_out, int out_size, void* d_ws, size_t ws_size, hipStream_t stream) {
    if (n_in != 23 || out_size != T * D || ws_size < WS_END) { fprintf(stderr, "kernel_launch: unexpected shapes (n_in %d, out %d, ws %zu)\n", n_in, out_size, ws_size); return; }
    static int grid = 0;
    if (grid == 0) {
        int dev = 0, cus = 0, per_cu = 0;
        if (hipGetDevice(&dev) != hipSuccess || hipDeviceGetAttribute(&cus, hipDeviceAttributeMultiprocessorCount, dev) != hipSuccess) { fprintf(stderr, "kernel_launch: device query failed\n"); grid = -1; return; }
        if (hipFuncSetAttribute((const void*)mega, hipFuncAttributeMaxDynamicSharedMemorySize, LDS_BYTES) != hipSuccess) { fprintf(stderr, "kernel_launch: hipFuncSetAttribute failed\n"); grid = -1; return; }
        if (hipOccupancyMaxActiveBlocksPerMultiprocessor(&per_cu, (const void*)mega, 512, LDS_BYTES) != hipSuccess || per_cu < 1) fprintf(stderr, "kernel_launch: note: occupancy query reports %d workgroups per CU\n", per_cu);
        (void)hipGetLastError();
        grid = cus;
    }
    if (grid < 0) return;
    (void)hipMemsetAsync((char*)d_ws + WS_CTL, 0, CTL_BYTES, stream);
    Args a{};
    const float** f = (const float**)&a.p;
    for (int i = 0; i < 23; ++i) f[i] = (const float*)d_in[i];
    a.p.out = (float*)d_out; a.p.ws = (unsigned char*)d_ws;
    if (MK_N_LAUNCHES == 1) { a.ph_lo = 0; a.ph_hi = N_PHASES; hipLaunchKernelGGL(mega, dim3(grid), dim3(512), LDS_BYTES, stream, a); }
    else for (int k = 0; k < N_PHASES; ++k) { a.ph_lo = k; a.ph_hi = k + 1; hipLaunchKernelGGL(mega, dim3(grid), dim3(512), LDS_BYTES, stream, a); }
}
```

```cpp
#include <hip/hip_runtime.h>
#include <hip/hip_bf16.h>
#include <cstdio>
#include <cstdint>
#include <cmath>

namespace {
constexpr int NB = 8, SEQ = 4096, T = NB * SEQ, D = 1024, NQKV = 3072, INC = 3080, NE = 32, DE = 512;
constexpr float EPS = 1e-6f;
constexpr size_t MiB = 1u << 20;
constexpr size_t WS_CTL = 0, CTL_BYTES = 65536;
constexpr size_t WS_MOD = 1 * MiB;
constexpr size_t WS_SCAL = WS_MOD + 256 * 1024;
constexpr size_t WS_WF = WS_MOD + 512 * 1024;
constexpr size_t WS_ROPE = 2 * MiB;
constexpr size_t WS_LOGF = 3 * MiB;
constexpr size_t WS_F = 4 * MiB;
constexpr size_t WS_TOKE = 5 * MiB;
constexpr size_t WS_TOKW = WS_TOKE + 256 * 1024;
constexpr size_t WS_LIST = 6 * MiB;
constexpr size_t WS_WIN = 10 * MiB;
constexpr size_t WS_WOUT = 16 * MiB;
constexpr size_t WS_WGU = 18 * MiB;
constexpr size_t WS_WD = 82 * MiB;
constexpr size_t WS_H = 114 * MiB;
constexpr size_t WS_R = 178 * MiB;
constexpr size_t WS_ACT = WS_R + 192 * MiB;
constexpr size_t WS_X1 = WS_ACT + 72 * MiB;
constexpr size_t WS_END = WS_X1 + 64 * MiB;

typedef unsigned short bf16;
typedef unsigned v4u __attribute__((ext_vector_type(4)));
typedef unsigned v2u __attribute__((ext_vector_type(2)));
typedef float f32x4 __attribute__((ext_vector_type(4)));

__device__ __forceinline__ unsigned f2bf(float f) { unsigned u = __builtin_bit_cast(unsigned, f); return (u + 0x7fffu + ((u >> 16) & 1u)) >> 16; }
typedef float pk2f_t __attribute__((ext_vector_type(2))); typedef __bf16 pk2b_t __attribute__((ext_vector_type(2)));
__device__ __forceinline__ unsigned pk2(float lo, float hi) { const pk2f_t v = {lo, hi}; return __builtin_bit_cast(unsigned, __builtin_convertvector(v, pk2b_t)); }
__device__ __forceinline__ float bf2f(unsigned short b) { return __builtin_bit_cast(float, (unsigned)b << 16); }
__device__ __forceinline__ float bflo(unsigned w) { return __builtin_bit_cast(float, w << 16); }
__device__ __forceinline__ float bfhi(unsigned w) { return __builtin_bit_cast(float, w & 0xffff0000u); }
__device__ __forceinline__ float wave_sum(float v) {
#pragma unroll
    for (int o = 1; o < 64; o <<= 1) v += __shfl_xor(v, o);
    return v;
}
__device__ __forceinline__ float wave_max(float v) {
#pragma unroll
    for (int o = 1; o < 64; o <<= 1) v = fmaxf(v, __shfl_xor(v, o));
    return v;
}
__device__ __forceinline__ int tid_fresh() { int t = threadIdx.x; asm volatile("" : "+v"(t)); return t; }
__device__ __forceinline__ float siluf(float v) { return v / (1.f + __expf(-v)); }

struct P {
    const float *x, *c, *w_ada, *b_ada, *g_pre_attn, *g_post_attn, *w_in, *b_forget, *lq1, *lk1, *lq2, *lk2, *g_subln, *w_out, *g_pre_ffn, *g_post_ffn,
        *w_group, *b_group, *w_router, *b_router, *w_gate, *w_up, *w_down;
    float* out; unsigned char* ws;
};

__device__ __forceinline__ void transpose_item(const float* W, int ldw, int K, bf16* WT, int k0, int n0, int dst_row0, float* scr, int lane) {
#pragma unroll 8
    for (int i = 0; i < 32; ++i) { const int kk = 2 * i + (lane >> 5); scr[kk * 33 + (lane & 31)] = __builtin_nontemporal_load(W + (size_t)(k0 + kk) * ldw + n0 + (lane & 31)); }
    __builtin_amdgcn_s_waitcnt(0xc07f); asm volatile("" ::: "memory");
    const int c = lane & 7;
#pragma unroll
    for (int j = 0; j < 4; ++j) { const int n = (lane >> 3) + 8 * j; const float* s = scr + (8 * c) * 33 + n;
        v4u o; o.x = pk2(s[0 * 33], s[1 * 33]); o.y = pk2(s[2 * 33], s[3 * 33]); o.z = pk2(s[4 * 33], s[5 * 33]); o.w = pk2(s[6 * 33], s[7 * 33]);
        *(v4u*)(WT + (size_t)(dst_row0 + n) * K + k0 + 8 * c) = o; }
    __builtin_amdgcn_s_waitcnt(0xc07f); asm volatile("" ::: "memory");
}

constexpr float Q8_ACT = 127.f / 6.f, Q8_W = 127.f / 0.14f;
constexpr float Q8_ACT2 = 127.f / 8.f, Q8_WD = 127.f / 0.2f;
constexpr float Q8_MIX = 127.f / 4.f;
__device__ __forceinline__ unsigned pk4_i8(float a, float b, float c, float d, float s) {
    unsigned w = __builtin_amdgcn_cvt_pk_u8_f32(__builtin_fmaf(a, s, 128.f), 0, 0u); w = __builtin_amdgcn_cvt_pk_u8_f32(__builtin_fmaf(b, s, 128.f), 1, w);
    w = __builtin_amdgcn_cvt_pk_u8_f32(__builtin_fmaf(c, s, 128.f), 2, w); w = __builtin_amdgcn_cvt_pk_u8_f32(__builtin_fmaf(d, s, 128.f), 3, w); return w ^ 0x80808080u; }
__device__ __forceinline__ void transpose_item_i8(const float* W, int ldw, int Kp, unsigned char* WT8, int k0, int n0, int dst_row0, float* scr, int lane, float qs) {
#pragma unroll 8
    for (int i = 0; i < 32; ++i) { const int kk = 2 * i + (lane >> 5); scr[kk * 33 + (lane & 31)] = __builtin_nontemporal_load(W + (size_t)(k0 + kk) * ldw + n0 + (lane & 31)); }
    __builtin_amdgcn_s_waitcnt(0xc07f); asm volatile("" ::: "memory");
    const int c = lane & 7;
#pragma unroll
    for (int j = 0; j < 4; ++j) { const int n = (lane >> 3) + 8 * j; const float* s = scr + (8 * c) * 33 + n;
        v2u o; o.x = pk4_i8(s[0 * 33], s[1 * 33], s[2 * 33], s[3 * 33], qs); o.y = pk4_i8(s[4 * 33], s[5 * 33], s[6 * 33], s[7 * 33], qs);
        *(v2u*)(WT8 + (size_t)(dst_row0 + n) * Kp + k0 + 8 * c) = o; }
    __builtin_amdgcn_s_waitcnt(0xc07f); asm volatile("" ::: "memory");
}
constexpr int CV_IN = 16 * 96, CV_OUT = 16 * 32, CV_G = 16 * 16, CV_D = 8 * 32, CV_E = 2 * CV_G + CV_D, CV_ITEMS = CV_IN + CV_OUT + NE * CV_E;
__device__ __forceinline__ void convert_items(const P& p, unsigned char* lds, int bid, int nblk, int it0, int it1, int k0, int k1) {
    const int tid = tid_fresh(), lane = tid & 63, wv = __builtin_amdgcn_readfirstlane(tid >> 6);
    unsigned char* WinT = p.ws + WS_WIN; unsigned char* WoutT = p.ws + WS_WOUT; unsigned char* WguT = p.ws + WS_WGU; unsigned char* WdT = p.ws + WS_WD;
    float* scr = (float*)(lds + wv * 8448);
    const int gw = bid * 8 + wv, ngw = nblk * 8;
    struct TrItem { const float* W; unsigned char* WT8; int ldw, Kp, k0, n0, dst_row0; float qs; };
    auto decode = [&](int r) __attribute__((always_inline)) -> TrItem {
        TrItem t;
        if (r < CV_IN) { const int kb = r / 96, nb = r % 96, n0 = 32 * nb, hh = n0 >> 6, hf = (n0 >> 5) & 1;
            const int fo = n0 - 1536 - (n0 >= 2048 ? 512 : 0);
            t.W = p.w_in; t.WT8 = WinT; t.ldw = INC; t.Kp = D; t.k0 = 64 * kb; t.n0 = n0; t.qs = Q8_W;
            t.dst_row0 = n0 < 1024 ? (hh >> 2) * 256 + hf * 128 + (hh & 3) * 32 : (n0 >= 1536 && n0 < 2560) ? (6 + (fo >> 7)) * 256 + (n0 >= 2048 ? 128 : 0) + (fo & 127) : n0; return t; }
        r -= CV_IN;
        if (r < CV_OUT) { const int kb = r / 32, nb = r % 32; t.W = p.w_out; t.WT8 = WoutT; t.ldw = D; t.Kp = D; t.k0 = 64 * kb; t.n0 = 32 * nb; t.dst_row0 = 32 * nb; t.qs = Q8_W; return t; }
        r -= CV_OUT;
        const int e = r / CV_E; r -= e * CV_E;
        if (r < 2 * CV_G) { const int half = r / CV_G; r -= half * CV_G; const int kb = r / 16, nb = r % 16, j0 = 32 * nb;
            t.W = (half ? p.w_up : p.w_gate) + (size_t)e * D * DE; t.WT8 = WguT + (size_t)e * D * D; t.ldw = DE; t.Kp = D; t.k0 = 64 * kb; t.n0 = j0; t.dst_row0 = (j0 >> 7) * 256 + half * 128 + (j0 & 127); t.qs = Q8_W; return t; }
        r -= 2 * CV_G;
        { const int kb = r / 32, nb = r % 32; t.W = p.w_down + (size_t)e * DE * D; t.WT8 = WdT + (size_t)e * D * DE; t.ldw = D; t.Kp = DE; t.k0 = 64 * kb; t.n0 = 32 * nb; t.dst_row0 = 32 * nb; t.qs = Q8_WD; return t; }
    };
    int it = it0 + gw + k0 * ngw;
    if (k0 < k1 && it < it1) {
        float v[32];
        TrItem cur = decode(it);
#pragma unroll
        for (int i = 0; i < 32; ++i) v[i] = __builtin_nontemporal_load(cur.W + (size_t)(cur.k0 + 2 * i + (lane >> 5)) * cur.ldw + cur.n0 + (lane & 31));
        for (int k = k0; k < k1 && it < it1; ++k, it += ngw) {
#pragma unroll
            for (int i = 0; i < 32; ++i) scr[(2 * i + (lane >> 5)) * 33 + (lane & 31)] = v[i];
            const bool more = k + 1 < k1 && it + ngw < it1;
            const TrItem nxt = decode(more ? it + ngw : it);
#pragma unroll
            for (int i = 0; i < 32; ++i) v[i] = __builtin_nontemporal_load(nxt.W + (size_t)(nxt.k0 + 2 * i + (lane >> 5)) * nxt.ldw + nxt.n0 + (lane & 31));
            __builtin_amdgcn_s_waitcnt(0xc07f); asm volatile("" ::: "memory");
            const int c = lane & 7;
#pragma unroll
            for (int j = 0; j < 4; ++j) { const int n = (lane >> 3) + 8 * j; const float* sp = scr + (8 * c) * 33 + n;
                v2u o; o.x = pk4_i8(sp[0 * 33], sp[1 * 33], sp[2 * 33], sp[3 * 33], cur.qs); o.y = pk4_i8(sp[4 * 33], sp[5 * 33], sp[6 * 33], sp[7 * 33], cur.qs);
                *(v2u*)(cur.WT8 + (size_t)(cur.dst_row0 + n) * cur.Kp + cur.k0 + 8 * c) = o; }
            __builtin_amdgcn_s_waitcnt(0xc07f); asm volatile("" ::: "memory");
            cur = nxt;
        }
    }
    __syncthreads();
}
__device__ __forceinline__ void prologue_phase(const P& p, unsigned char* lds, int bid, int nblk) {
    const int tid = tid_fresh(), lane = tid & 63, wave = tid >> 6;
    unsigned char* WinT = p.ws + WS_WIN; unsigned char* WoutT = p.ws + WS_WOUT; unsigned char* WguT = p.ws + WS_WGU; unsigned char* WdT = p.ws + WS_WD;
    float* mod = (float*)(p.ws + WS_MOD);
    {
        float* sc = (float*)lds;
        float* part = (float*)(lds + 32768);
        bool loaded = false;
        for (int it = bid; it < 192; it += nblk) {
            if (!loaded) { for (int i = tid; i < 8192; i += 512) { const int b = i >> 10, k = i & 1023; sc[k * 8 + b] = siluf(p.c[i]); } loaded = true; __syncthreads(); }
            const int kr = lane >> 3, cq = lane & 7, kb = wave * 128 + kr;
            const float* wp = p.w_ada + (size_t)kb * 6144 + it * 32 + 4 * cq;
            f32x4 w[16];
#pragma unroll
            for (int i = 0; i < 16; ++i) w[i] = __builtin_nontemporal_load((const f32x4*)(wp + (size_t)(8 * i) * 6144));
            f32x4 acc[8];
#pragma unroll
            for (int b = 0; b < 8; ++b) acc[b] = (f32x4){0.f, 0.f, 0.f, 0.f};
#pragma unroll
            for (int i = 0; i < 16; ++i) { const f32x4 s0 = *(const f32x4*)(sc + (kb + 8 * i) * 8), s1 = *(const f32x4*)(sc + (kb + 8 * i) * 8 + 4);
                acc[0] += w[i] * s0.x; acc[1] += w[i] * s0.y; acc[2] += w[i] * s0.z; acc[3] += w[i] * s0.w; acc[4] += w[i] * s1.x; acc[5] += w[i] * s1.y; acc[6] += w[i] * s1.z; acc[7] += w[i] * s1.w; }
#pragma unroll
            for (int b = 0; b < 8; ++b) *(f32x4*)(part + (((wave * 8 + kr) * 8 + b) * 32) + 4 * cq) = acc[b];
            __syncthreads();
            if (tid < 256) { const int b = tid >> 5, cc = tid & 31; float s = p.b_ada[it * 32 + cc];
#pragma unroll 8
                for (int g = 0; g < 64; ++g) s += part[(g * 8 + b) * 32 + cc];
                mod[b * 6144 + it * 32 + cc] = s; }
            __syncthreads();
        }
        __syncthreads();
    }
    if (nblk > 192) { if (bid >= 192) convert_items(p, lds, bid - 192, nblk - 192, 0, CV_IN, 0, 1 << 20); }
    else convert_items(p, lds, bid, nblk, 0, CV_IN, 0, 1 << 20);
    {
        const int gt = bid * 512 + tid, ngt = nblk * 512;
        float* cosT = (float*)(p.ws + WS_ROPE); float* sinT = cosT + SEQ * 32;
        for (int i = gt; i < SEQ * 32; i += ngt) { const int pos = i >> 5, f = i & 31;
            const float inv = (float)(1.0 / pow(10000.0, (double)f / 32.0)); const float ang = (float)pos * inv;
            cosT[i] = (float)cos((double)ang); sinT[i] = (float)sin((double)ang); }
        if (gt == 0) { float a = 0.f, b = 0.f; for (int i = 0; i < 64; ++i) { a += p.lq1[i] * p.lk1[i]; b += p.lq2[i] * p.lk2[i]; }
            ((float*)(p.ws + WS_SCAL))[0] = expf(a) - expf(b) + 0.2f; }
    }
}

template <int CTRL> __device__ __forceinline__ float dppf(float x) { return __builtin_bit_cast(float, __builtin_amdgcn_mov_dpp(__builtin_bit_cast(int, x), CTRL, 0xf, 0xf, true)); }
template <int M> struct DppCtl { static constexpr int v = M == 1 ? 0xB1 : M == 2 ? 0x4E : M == 4 ? 0x141 : 0x128; };
__device__ __forceinline__ float swap32_add(float a, float b) { auto r = __builtin_amdgcn_permlane32_swap(__float_as_uint(a), __float_as_uint(b), false, false); return __uint_as_float(r[0]) + __uint_as_float(r[1]); }
__device__ __forceinline__ float swap16_add(float a, float b) { auto r = __builtin_amdgcn_permlane16_swap(__float_as_uint(a), __float_as_uint(b), false, false); return __uint_as_float(r[0]) + __uint_as_float(r[1]); }
__device__ __forceinline__ float wave_sum_v(float v) { v += dppf<0xB1>(v); v += dppf<0x4E>(v); v += dppf<0x141>(v); v += dppf<0x128>(v); v = swap16_add(v, v); return swap32_add(v, v); }
template <int N, int TOT, int M> struct WRM {
    static __device__ __forceinline__ void run(float (&v)[TOT], int lane) {
        if constexpr (M == 32) {
#pragma unroll
            for (int i = 0; i < N / 2; ++i) v[i] = swap32_add(v[i], v[i + N / 2]);
        } else if constexpr (M == 16) {
#pragma unroll
            for (int i = 0; i < N / 2; ++i) v[i] = swap16_add(v[i], v[i + N / 2]);
        } else {
            const bool up = (lane & M) != 0;
#pragma unroll
            for (int i = 0; i < N / 2; ++i) { const float send = up ? v[i] : v[i + N / 2]; const float keep = up ? v[i + N / 2] : v[i]; v[i] = keep + dppf<DppCtl<M>::v>(send); }
        }
        WRM<N / 2, TOT, M / 2>::run(v, lane);
    }
};
template <int TOT, int M> struct WRM<1, TOT, M> { static __device__ __forceinline__ void run(float (&v)[TOT], int lane) {
    if constexpr (M == 32) v[0] = swap32_add(v[0], v[0]); else if constexpr (M == 16) v[0] = swap16_add(v[0], v[0]); else v[0] += dppf<DppCtl<M>::v>(v[0]);
    WRM<1, TOT, M / 2>::run(v, lane); } };
template <int TOT> struct WRM<1, TOT, 0> { static __device__ __forceinline__ void run(float (&)[TOT], int) {} };
template <int N> __device__ __forceinline__ void wave_reduce_multi(float (&v)[N], int lane) { WRM<N, N, 32>::run(v, lane); }
__device__ __forceinline__ float dot4(const f32x4 a, const f32x4 b) { return (a.x * b.x + a.y * b.y) + (a.z * b.z + a.w * b.w); }
__device__ __forceinline__ float hsum4(const f32x4 a) { const pk2f_t t = (pk2f_t){a.x, a.y} + (pk2f_t){a.z, a.w}; return t.x + t.y; }
__device__ __forceinline__ float sumsq4(const f32x4 a) { return (a.x * a.x + a.y * a.y) + (a.z * a.z + a.w * a.w); }

__device__ __forceinline__ void norm1_phase(const P& p, unsigned char* lds, int c, int G) {
    const int tid = tid_fresh(), lane = tid & 63, gw = c * 8 + (tid >> 6), ngw = G * 8;
    const float* mod = (const float*)(p.ws + WS_MOD);
    unsigned char* H8 = p.ws + WS_H; float* logf_ = (float*)(p.ws + WS_LOGF);
    signed char* wq8 = (signed char*)lds;
    for (int i = tid; i < 8192; i += 512) { const int col = i >> 3, q = i & 7; const float w = p.w_in[(size_t)col * INC + NQKV + q];
        const int l_ = (col & 255) >> 2, j_ = col >> 8, e_ = col & 3;
        wq8[q * 1024 + l_ * 16 + j_ * 4 + e_] = (signed char)__float2int_rn(fminf(fmaxf(w * Q8_W, -127.f), 127.f)); }
    __syncthreads();
    const int rpw = (((T + ngw - 1) / ngw) + 1) & ~1, r_begin = gw * rpw, r_end = min(T, r_begin + rpw);
    const float bfg = lane < 8 ? p.b_forget[lane] : 0.f;
    for (int seg = r_begin; seg < r_end;) {
        const int b = seg >> 12, seg_end = min(r_end, (b + 1) << 12);
        f32x4 xn[2][4], gs[4], sh[4];
#pragma unroll
        for (int j = 0; j < 4; ++j) { const int col = 4 * lane + 256 * j; const f32x4 g = *(const f32x4*)(p.g_pre_attn + col), sc = *(const f32x4*)(mod + b * 6144 + 1024 + col);
            sh[j] = *(const f32x4*)(mod + b * 6144 + col); gs[j] = g * (1.f + sc); }
#pragma unroll
        for (int r = 0; r < 2; ++r)
#pragma unroll
            for (int j = 0; j < 4; ++j) xn[r][j] = *((const f32x4*)(p.x + (size_t)(seg + r) * D) + lane + 64 * j);
        __builtin_amdgcn_s_waitcnt(0x0f70);
        for (int r0 = seg; r0 < seg_end; r0 += 2) {
            f32x4 x[2][4];
#pragma unroll
            for (int r = 0; r < 2; ++r)
#pragma unroll
                for (int j = 0; j < 4; ++j) x[r][j] = xn[r][j];
            { const int rp = r0 + 2 < seg_end ? r0 + 2 : r0;
#pragma unroll
                for (int r = 0; r < 2; ++r)
#pragma unroll
                    for (int j = 0; j < 4; ++j) xn[r][j] = *((const f32x4*)(p.x + (size_t)(rp + r) * D) + lane + 64 * j);
            }
            float ss[2]; unsigned hq[2][4];
#pragma unroll
            for (int r = 0; r < 2; ++r) ss[r] = hsum4((x[r][0] * x[r][0] + x[r][1] * x[r][1]) + (x[r][2] * x[r][2] + x[r][3] * x[r][3]));
#pragma unroll
            for (int r = 0; r < 2; ++r) ss[r] = wave_sum_v(ss[r]);
#pragma unroll
            for (int r = 0; r < 2; ++r) { const float rinv = rsqrtf(ss[r] * (1.f / D) + EPS);
#pragma unroll
                for (int j = 0; j < 4; ++j) { x[r][j] = x[r][j] * rinv * gs[j] + sh[j];
                    hq[r][j] = pk4_i8(x[r][j].x, x[r][j].y, x[r][j].z, x[r][j].w, Q8_ACT);
                    *(unsigned*)(H8 + (size_t)(r0 + r) * D + 4 * lane + 256 * j) = hq[r][j]; } }
            float fl[16];
#pragma unroll
            for (int q = 0; q < 8; ++q) { const v4u w = *(const v4u*)(wq8 + q * 1024 + lane * 16); int a0 = 0, a1 = 0;
                a0 = __builtin_amdgcn_sdot4((int)hq[0][0], (int)w.x, a0, false); a0 = __builtin_amdgcn_sdot4((int)hq[0][1], (int)w.y, a0, false); a0 = __builtin_amdgcn_sdot4((int)hq[0][2], (int)w.z, a0, false); a0 = __builtin_amdgcn_sdot4((int)hq[0][3], (int)w.w, a0, false);
                a1 = __builtin_amdgcn_sdot4((int)hq[1][0], (int)w.x, a1, false); a1 = __builtin_amdgcn_sdot4((int)hq[1][1], (int)w.y, a1, false); a1 = __builtin_amdgcn_sdot4((int)hq[1][2], (int)w.z, a1, false); a1 = __builtin_amdgcn_sdot4((int)hq[1][3], (int)w.w, a1, false);
                fl[q] = (float)a0; fl[8 + q] = (float)a1; }
            wave_reduce_multi<16>(fl, lane);
            const float bq = __shfl(bfg, (lane >> 2) & 7);
            if ((lane & 3) == 0) { const int r = lane >> 5, q = (lane >> 2) & 7; const float z = fl[0] * (1.f / (Q8_ACT * Q8_W)) + bq;
                logf_[(size_t)(r0 + r) * 8 + q] = fminf(z, 0.f) - log1pf(expf(-fabsf(z))); }
        }
        seg = seg_end;
    }
}

__device__ __forceinline__ void scan_phase(const P& p, float* red  , int bid, int nblk) {
    const int tid = tid_fresh(), lane = tid & 63, wave = tid >> 6;
    const float* logf_ = (const float*)(p.ws + WS_LOGF); float* F = (float*)(p.ws + WS_F);
    for (int it = bid; it < 64; it += nblk) {
        const int b = it >> 3, h = it & 7;
        float v[8]; float s = 0.f;
#pragma unroll
        for (int i = 0; i < 8; ++i) { v[i] = logf_[((size_t)b * SEQ + tid * 8 + i) * 8 + h]; s += v[i]; v[i] = s; }
        float incl = s;
#pragma unroll
        for (int o = 1; o < 64; o <<= 1) { const float t = __shfl_up(incl, o); if (lane >= o) incl += t; }
        if (lane == 63) red[wave] = incl;
        __syncthreads();
        float base = incl - s;
        for (int w = 0; w < wave; ++w) base += red[w];
#pragma unroll
        for (int i = 0; i < 8; ++i) F[((size_t)b * 8 + h) * SEQ + tid * 8 + i] = -(base + v[i]) * 1.4426950408889634f;
        __syncthreads();
    }
}

constexpr int RT_WG = 131072, RT_CTL = 148480;
constexpr int CW_NORM = 2048, CW_FOXQ = 2304;
constexpr int CW_TILE = 10240;
constexpr int CW_SMIN = 8192;
constexpr int CNT_STRIDE = 64;
__device__ __forceinline__ void router_phase(const P& p, unsigned char* lds, int c, int G) {
    const int tid = tid_fresh(), lane = tid & 63, gw = c * 8 + (tid >> 6), ngw = G * 8;
    const float* mod = (const float*)(p.ws + WS_MOD); const bf16* mixed = (const bf16*)(p.ws + WS_R);
    unsigned char* H8 = p.ws + WS_H; bf16* X1 = (bf16*)(p.ws + WS_X1); unsigned* cnt = (unsigned*)(p.ws + WS_CTL);
    float* tokw = (float*)(p.ws + WS_TOKW); int* list = (int*)(p.ws + WS_LIST);
    float* wr = (float*)lds; float* wg = (float*)(lds + RT_WG);
    int* lcnt = (int*)(lds + RT_CTL); int* lbase = lcnt + 32; int* lassign = lcnt + 64;
    if (tid < 32) lcnt[tid] = 0;
    for (int i = tid; i < 8192; i += 512) { const int col = i >> 3, e0 = (i & 7) * 4; const f32x4 w = *(const f32x4*)(p.w_router + col * 32 + e0);
        wr[(e0 + 0) * 1024 + col] = w.x; wr[(e0 + 1) * 1024 + col] = w.y; wr[(e0 + 2) * 1024 + col] = w.z; wr[(e0 + 3) * 1024 + col] = w.w; }
    for (int col = tid; col < 1024; col += 512) { const f32x4 w = *(const f32x4*)(p.w_group + col * 4); wg[col] = w.x; wg[1024 + col] = w.y; wg[2048 + col] = w.z; wg[3072 + col] = w.w; }
    __syncthreads();
    const int rpw = (((T + ngw - 1) / ngw) + 1) & ~1, r_begin = gw * rpw, r_end = min(T, r_begin + rpw);
    const int blk_row0 = c * 8 * rpw, blk_slot0 = blk_row0 * 2, blk_nassign = max(0, min(T, blk_row0 + 8 * rpw) - blk_row0) * 2;
    const float bgl = p.b_group[(lane >> 3) & 3]; const float brt = lane < 32 ? p.b_router[lane] : 0.f;
    for (int seg = r_begin; seg < r_end;) {
        const int b = seg >> 12, seg_end = min(r_end, (b + 1) << 12);
        f32x4 xn[2][4], gta[4], gf[4], shf[4]; v2u mn[2][4];
#pragma unroll
        for (int j = 0; j < 4; ++j) { const int col = 4 * lane + 256 * j;
            gta[j] = *(const f32x4*)(p.g_post_attn + col) * *(const f32x4*)(mod + b * 6144 + 2048 + col);
            gf[j] = *(const f32x4*)(p.g_pre_ffn + col) * (1.f + *(const f32x4*)(mod + b * 6144 + 4096 + col)); shf[j] = *(const f32x4*)(mod + b * 6144 + 3072 + col); }
#pragma unroll
        for (int r = 0; r < 2; ++r)
#pragma unroll
            for (int j = 0; j < 4; ++j) { xn[r][j] = *((const f32x4*)(p.x + (size_t)(seg + r) * D) + lane + 64 * j); mn[r][j] = *((const v2u*)(mixed + (size_t)(seg + r) * D) + lane + 64 * j); }
        __builtin_amdgcn_s_waitcnt(0x0f70);
        for (int r0 = seg; r0 < seg_end; r0 += 2) {
            f32x4 x[2][4], m[2][4];
#pragma unroll
            for (int r = 0; r < 2; ++r)
#pragma unroll
                for (int j = 0; j < 4; ++j) { x[r][j] = xn[r][j]; const v2u w = mn[r][j]; m[r][j].x = bflo(w.x); m[r][j].y = bfhi(w.x); m[r][j].z = bflo(w.y); m[r][j].w = bfhi(w.y); }
            { const int rp = r0 + 2 < seg_end ? r0 + 2 : r0;
#pragma unroll
                for (int r = 0; r < 2; ++r)
#pragma unroll
                    for (int j = 0; j < 4; ++j) { xn[r][j] = *((const f32x4*)(p.x + (size_t)(rp + r) * D) + lane + 64 * j); mn[r][j] = *((const v2u*)(mixed + (size_t)(rp + r) * D) + lane + 64 * j); }
            }
            float s1[2], s2[2];
#pragma unroll
            for (int r = 0; r < 2; ++r) s1[r] = hsum4((m[r][0] * m[r][0] + m[r][1] * m[r][1]) + (m[r][2] * m[r][2] + m[r][3] * m[r][3]));
#pragma unroll
            for (int r = 0; r < 2; ++r) s1[r] = wave_sum_v(s1[r]);
#pragma unroll
            for (int r = 0; r < 2; ++r) { const float rinv = rsqrtf(s1[r] * (1.f / D) + EPS); f32x4 sq = (f32x4){0.f, 0.f, 0.f, 0.f};
#pragma unroll
                for (int j = 0; j < 4; ++j) { x[r][j] = x[r][j] + gta[j] * (m[r][j] * rinv); sq += x[r][j] * x[r][j];
                    v2u o; o.x = pk2(x[r][j].x, x[r][j].y); o.y = pk2(x[r][j].z, x[r][j].w); *(v2u*)(X1 + (size_t)(r0 + r) * D + 4 * lane + 256 * j) = o; }
                s2[r] = hsum4(sq); }
#pragma unroll
            for (int r = 0; r < 2; ++r) s2[r] = wave_sum_v(s2[r]);
#pragma unroll
            for (int r = 0; r < 2; ++r) { const float rinv = rsqrtf(s2[r] * (1.f / D) + EPS);
#pragma unroll
                for (int j = 0; j < 4; ++j) { x[r][j] = x[r][j] * rinv * gf[j] + shf[j];
                    *(unsigned*)(H8 + (size_t)(r0 + r) * D + 4 * lane + 256 * j) = pk4_i8(x[r][j].x, x[r][j].y, x[r][j].z, x[r][j].w, Q8_ACT); } }
            float gl[8];
#pragma unroll
            for (int q = 0; q < 4; ++q) { f32x4 a0 = (f32x4){0.f, 0.f, 0.f, 0.f}, a1 = a0;
#pragma unroll
                for (int j = 0; j < 4; ++j) { const f32x4 w = *(const f32x4*)(wg + q * 1024 + 4 * lane + 256 * j); a0 += x[0][j] * w; a1 += x[1][j] * w; }
                gl[q] = hsum4(a0); gl[4 + q] = hsum4(a1); if (q & 1) asm volatile("" ::: "memory"); }
            wave_reduce_multi<8>(gl, lane);
            const float glv = gl[0] + bgl;
            float v4[4];
#pragma unroll
            for (int q = 0; q < 4; ++q) v4[q] = __shfl(glv, (lane & 32) + q * 8);
            int bi = 0; float bm = v4[0];
#pragma unroll
            for (int q = 1; q < 4; ++q) if (v4[q] > bm) { bm = v4[q]; bi = q; }
            float gsum = 0.f;
#pragma unroll
            for (int q = 0; q < 4; ++q) gsum += __expf(v4[q] - bm);
            const float gwtl = 1.f / gsum;
            int gi[2]; gi[0] = __builtin_amdgcn_readlane(bi, 0); gi[1] = __builtin_amdgcn_readlane(bi, 32);
            float el[16];
#pragma unroll
            for (int r = 0; r < 2; ++r) { const float* wb = wr + gi[r] * 8192 + 4 * lane;
#pragma unroll
                for (int q = 0; q < 8; ++q) { f32x4 a = (f32x4){0.f, 0.f, 0.f, 0.f};
#pragma unroll
                    for (int j = 0; j < 4; ++j) a += x[r][j] * *(const f32x4*)(wb + q * 1024 + 256 * j);
                    el[r * 8 + q] = hsum4(a); if (q & 1) asm volatile("" ::: "memory"); } }
            wave_reduce_multi<16>(el, lane);
            {
                const float elv = el[0] + __shfl(brt, bi * 8 + ((lane >> 2) & 7));
                float v[8];
#pragma unroll
                for (int q = 0; q < 8; ++q) v[q] = __shfl(elv, (lane & 32) + q * 4);
                int i1 = 0; float v1 = v[0];
#pragma unroll
                for (int q = 1; q < 8; ++q) if (v[q] > v1) { v1 = v[q]; i1 = q; }
                int i2 = -1; float v2 = -3.0e38f;
#pragma unroll
                for (int q = 0; q < 8; ++q) if (q != i1 && v[q] > v2) { v2 = v[q]; i2 = q; }
                const float e2 = __expf(v2 - v1); const float w1 = gwtl / (1.f + e2), w2 = gwtl * e2 / (1.f + e2);
                if ((lane & 31) < 2) { const int r = lane >> 5, sl = lane & 1; const int e = bi * 8 + (sl ? i2 : i1); const float w = sl ? w2 : w1; const int slot = (r0 + r) * 2 + sl;
                    tokw[slot] = w; const int lpos = atomicAdd(lcnt + e, 1); lassign[slot - blk_slot0] = e | (lpos << 8); }
            }
        }
        seg = seg_end;
    }
    __syncthreads();
    if (tid < 32) lbase[tid] = lcnt[tid] ? (int)atomicAdd(cnt + tid * CNT_STRIDE, (unsigned)lcnt[tid]) : 0;
    __syncthreads();
    for (int i = tid; i < blk_nassign; i += 512) { const int v = lassign[i], e = v & 255; list[e * T + lbase[e] + (v >> 8)] = blk_slot0 + i; }
}

typedef float f32x2 __attribute__((ext_vector_type(2)));
__device__ __forceinline__ f32x4 fp8x4_to_f32(unsigned w) { const f32x2 lo = __builtin_amdgcn_cvt_pk_f32_fp8((int)w, false), hi = __builtin_amdgcn_cvt_pk_f32_fp8((int)w, true); return (f32x4){lo.x, lo.y, hi.x, hi.y}; }
__device__ __forceinline__ void final_phase(const P& p, int c, int G) {
    const int tid = tid_fresh(), lane = tid & 63, gw = c * 8 + (tid >> 6), ngw = G * 8;
    const float* mod = (const float*)(p.ws + WS_MOD); const unsigned char* YS = p.ws + WS_R; const bf16* X1 = (const bf16*)(p.ws + WS_X1); const float* tokw = (const float*)(p.ws + WS_TOKW);
    const int rpw = (((T + ngw - 1) / ngw) + 1) & ~1, r_begin = gw * rpw, r_end = min(T, r_begin + rpw);
    for (int seg = r_begin; seg < r_end;) {
        const int b = seg >> 12, seg_end = min(r_end, (b + 1) << 12);
        f32x4 gtf[4]; v2u xn[2][4]; unsigned yn[2][2][4];
#pragma unroll
        for (int j = 0; j < 4; ++j) { const int col = 4 * lane + 256 * j; gtf[j] = *(const f32x4*)(p.g_post_ffn + col) * *(const f32x4*)(mod + b * 6144 + 5120 + col); }
#pragma unroll
        for (int r = 0; r < 2; ++r)
#pragma unroll
            for (int j = 0; j < 4; ++j) { xn[r][j] = *((const v2u*)(X1 + (size_t)(seg + r) * D) + lane + 64 * j);
                yn[r][0][j] = *((const unsigned*)(YS + (size_t)((seg + r) * 2) * D) + lane + 64 * j); yn[r][1][j] = *((const unsigned*)(YS + (size_t)((seg + r) * 2 + 1) * D) + lane + 64 * j); }
        __builtin_amdgcn_s_waitcnt(0x0f70);
        for (int r0 = seg; r0 < seg_end; r0 += 2) {
            f32x4 x[2][4], y[2][4];
#pragma unroll
            for (int r = 0; r < 2; ++r) { const float w0 = tokw[(r0 + r) * 2] * 0.0625f, w1 = tokw[(r0 + r) * 2 + 1] * 0.0625f;
#pragma unroll
                for (int j = 0; j < 4; ++j) { const v2u xv = xn[r][j]; x[r][j].x = bflo(xv.x); x[r][j].y = bfhi(xv.x); x[r][j].z = bflo(xv.y); x[r][j].w = bfhi(xv.y);
                    y[r][j] = fp8x4_to_f32(yn[r][0][j]) * w0 + fp8x4_to_f32(yn[r][1][j]) * w1; } }
            { const int rp = r0 + 2 < seg_end ? r0 + 2 : r0;
#pragma unroll
                for (int r = 0; r < 2; ++r)
#pragma unroll
                    for (int j = 0; j < 4; ++j) { xn[r][j] = *((const v2u*)(X1 + (size_t)(rp + r) * D) + lane + 64 * j);
                        yn[r][0][j] = *((const unsigned*)(YS + (size_t)((rp + r) * 2) * D) + lane + 64 * j); yn[r][1][j] = *((const unsigned*)(YS + (size_t)((rp + r) * 2 + 1) * D) + lane + 64 * j); }
            }
            float ss[2];
#pragma unroll
            for (int r = 0; r < 2; ++r) ss[r] = hsum4((y[r][0] * y[r][0] + y[r][1] * y[r][1]) + (y[r][2] * y[r][2] + y[r][3] * y[r][3]));
#pragma unroll
            for (int r = 0; r < 2; ++r) ss[r] = wave_sum_v(ss[r]);
#pragma unroll
            for (int r = 0; r < 2; ++r) { const float rinv = rsqrtf(ss[r] * (1.f / D) + EPS);
#pragma unroll
                for (int j = 0; j < 4; ++j) *((f32x4*)(p.out + (size_t)(r0 + r) * D) + lane + 64 * j) = x[r][j] + gtf[j] * (y[r][j] * rinv); }
        }
        seg = seg_end;
    }
}

namespace pg8 {
#define PG8_LAS __attribute__((address_space(3)))
typedef unsigned short bf16_t;
typedef short bf16x8 __attribute__((ext_vector_type(8)));
typedef float f32x4 __attribute__((ext_vector_type(4)));
typedef unsigned u32x4 __attribute__((ext_vector_type(4)));
constexpr int BM = 256, BK = 64, HALF = 128, HTB = HALF * BK * 2  , STAGE_BYTES = 8 * HTB, NXCD = 8, WGM = 4;

__host__ __device__ __forceinline__ int lds_byte(int r, int c) { const int st = (r >> 4) * 2 + (c >> 5), rr = r & 15, cc = c & 31, ob = rr * 64 + cc * 2; return st * 1024 + (ob ^ (((ob >> 9) & 1) << 5)); }
__host__ __device__ __forceinline__ void stage_rc(int b, int& R, int& C) { const int st = b / 1024, sb = b % 1024, swz = sb ^ (((sb >> 9) & 1) << 5); R = (st >> 1) * 16 + swz / 64; C = (st & 1) * 32 + (swz % 64) / 2; }
__host__ __device__ __forceinline__ int perm32(int rho) { const int n = rho >> 4, i = rho & 15; return 8 * (i >> 2) + 4 * n + (i & 3); }

struct Unit { int pm, pn, aux; };
struct Gemm { const bf16_t* A; const bf16_t* Bt; int M, N, K; };

struct StaticOrder {
    int nM, nN, nwg, G, c;
    __host__ __device__ void init(int M, int N, int G_, int c_) { nM = M / BM; nN = N / BM; nwg = nM * nN; G = G_; c = c_; }
    __host__ __device__ bool next(int i, Unit& u) const {
        const long L = (long)i * G + c; if (L >= nwg) return false;
        int wgid = (int)L; { const int q = nwg / NXCD, r = nwg % NXCD, xcd = wgid % NXCD, off = wgid / NXCD; wgid = (xcd < r ? xcd * (q + 1) : r * (q + 1) + (xcd - r) * q) + off; }
        const int nig = WGM * nN, gid = wgid / nig, fm = gid * WGM, gsz = (nM - fm) < WGM ? (nM - fm) : WGM;
        u.pm = fm + ((wgid % nig) % gsz); u.pn = (wgid % nig) / gsz; return true;
    }
    __device__ __forceinline__ void a_ready(const Unit&) const {}
    __device__ __forceinline__ void done(const Unit&) const {}
};

__device__ __forceinline__ unsigned cvt_pk_bf16(float lo, float hi) { unsigned r; asm volatile("v_cvt_pk_bf16_f32 %0, %1, %2" : "=v"(r) : "v"(lo), "v"(hi)); return r; }
typedef float f32x2 __attribute__((ext_vector_type(2)));

typedef int i32x4 __attribute__((ext_vector_type(4)));
template <class Epi, class Sched, bool ALIGN_EPI = false, bool SP2 = true, bool GATHER = false, bool I8 = false, bool ACOH = false>
__device__ __forceinline__ void gemm_phase(PG8_LAS unsigned char* lds, const Gemm g, const Sched& S, const Epi& E) {
    const int tid = tid_fresh(), wid = __builtin_amdgcn_readfirstlane(tid >> 6), lane = tid & 63, wr = wid >> 2, wc = wid & 3, fr = lane & 15, fq = lane >> 4;
    constexpr int ES = I8 ? 1 : 2;
    const int K = g.K, nt = K * ES / (BK * 2);
    unsigned voffA[2], voffB[2];
#pragma unroll
    for (int i = 0; i < 2; ++i) { int R, C; stage_rc(tid * 16 + i * 8192, R, C); const int Rb = Epi::PERM ? ((R & ~31) + perm32(R & 31)) : R;
        voffA[i] = (unsigned)(R * K * ES + C * 2); voffB[i] = (unsigned)(Rb * K * ES + C * 2); }
    unsigned offC[2][2], offN[2][2]; int gR[2], gC[2];
#pragma unroll
    for (int i = 0; i < 2; ++i) { int R, C; stage_rc(tid * 16 + i * 8192, R, C); gR[i] = R; gC[i] = C * 2; }
#pragma unroll
    for (int h = 0; h < 2; ++h)
#pragma unroll
        for (int i = 0; i < 2; ++i) { offC[h][i] = 0u; offN[h][i] = 0u; }
    const char* gA = (const char*)g.A;
    const size_t kstep = (size_t)(BK * 2);
    const size_t hstep = (size_t)HALF * K * ES;
    const size_t tstep = 2 * hstep;
    const unsigned ldsw = (unsigned)wid * 1024u;
    const int aoff = lds_byte(wr * 64 + fr, fq * 8), boff = lds_byte(wc * 32 + fr, fq * 8);
#define PG8_SA(b, h) (((b) * 2 + (h)) * HTB)
#define PG8_SB(b, h) ((4 + (b) * 2 + (h)) * HTB)
#define PG8_STAGE(bufoff, gbase, voff) do { _Pragma("unroll") for (int _i = 0; _i < 2; ++_i) \
        __builtin_amdgcn_global_load_lds((const unsigned*)((const char*)(gbase) + (voff)[_i]), (PG8_LAS unsigned*)(lds + (bufoff) + ldsw + _i * 8192), 16, 0, 0); } while (0)
#define PG8_STAGE_C(bufoff, gbase, voff) do { _Pragma("unroll") for (int _i = 0; _i < 2; ++_i) \
        __builtin_amdgcn_global_load_lds((const unsigned*)((const char*)(gbase) + (voff)[_i]), (PG8_LAS unsigned*)(lds + (bufoff) + ldsw + _i * 8192), 16, 0, 17); } while (0)
#define PG8_STA(b, h, nb, gb, off) do { if constexpr (GATHER) PG8_STAGE(PG8_SA(b, h), gb, off[h]); else if constexpr (ACOH) PG8_STAGE_C(PG8_SA(b, h), (nb) + (h) * hstep, voffA); else PG8_STAGE(PG8_SA(b, h), (nb) + (h) * hstep, voffA); } while (0)
#define PG8_LDA(dst, b, h) do { _Pragma("unroll") for (int m = 0; m < 4; ++m) _Pragma("unroll") for (int k = 0; k < 2; ++k) dst[m][k] = *(const PG8_LAS bf16x8*)(lds + PG8_SA(b, h) + aoff + m * 2048 + k * 1024); } while (0)
#define PG8_LDB(dst, b, h) do { _Pragma("unroll") for (int n = 0; n < 2; ++n) _Pragma("unroll") for (int k = 0; k < 2; ++k) dst[n][k] = *(const PG8_LAS bf16x8*)(lds + PG8_SB(b, h) + boff + n * 2048 + k * 1024); } while (0)
#define PG8_MMA(ai, bj, At, Bt) do { __builtin_amdgcn_s_setprio(1); _Pragma("unroll") for (int m = 0; m < 4; ++m) _Pragma("unroll") for (int n = 0; n < 2; ++n) _Pragma("unroll") for (int k = 0; k < 2; ++k) { \
        if constexpr (I8) acc[ai][bj][m][n] = __builtin_bit_cast(f32x4, __builtin_amdgcn_mfma_i32_16x16x64_i8(__builtin_bit_cast(i32x4, Bt[n][k]), __builtin_bit_cast(i32x4, At[m][k]), __builtin_bit_cast(i32x4, acc[ai][bj][m][n]), 0, 0, 0)); \
        else acc[ai][bj][m][n] = __builtin_amdgcn_mfma_f32_16x16x32_bf16(Bt[n][k], At[m][k], acc[ai][bj][m][n], 0, 0, 0); } __builtin_amdgcn_s_setprio(0); } while (0)
#define PG8_WAIT_V(n) asm volatile("s_waitcnt vmcnt(" #n ")" ::: "memory")
#define PG8_WAIT_L(n) asm volatile("s_waitcnt lgkmcnt(" #n ")" ::: "memory")
#define PG8_BAR __builtin_amdgcn_s_barrier()
#define PG8_SCHED __builtin_amdgcn_sched_barrier(0)
    Unit cur, nxt; int ui = 0;
    if (!S.next(0, cur)) return;
    f32x4 acc[2][2][4][2];
#pragma unroll
    for (int a = 0; a < 2; ++a)
#pragma unroll
        for (int b = 0; b < 2; ++b)
#pragma unroll
            for (int m = 0; m < 4; ++m)
#pragma unroll
                for (int n = 0; n < 2; ++n) acc[a][b][m][n] = (f32x4){0.f, 0.f, 0.f, 0.f};
    bf16x8 At[4][2], B0[2][2], B1[2][2];
    const char* cA = (const char*)g.A + (size_t)cur.pm * tstep; const char* cB = (const char*)g.Bt + (size_t)cur.pn * tstep;
    S.a_ready(cur);
    static_assert(!GATHER || SP2, "GATHER needs the SP2 loop");
    if constexpr (GATHER) {
#pragma unroll
        for (int h = 0; h < 2; ++h)
#pragma unroll
            for (int i = 0; i < 2; ++i) { offC[h][i] = S.arow(0, 128 * h + gR[i]) + (unsigned)gC[i]; offN[h][i] = offC[h][i]; } }
    if constexpr (SP2) {
        PG8_STAGE(PG8_SB(0, 0), cB, voffB); PG8_STAGE(PG8_SB(0, 1), cB + hstep, voffB); PG8_STA(0, 0, cA, gA, offC); PG8_STA(0, 1, cA, gA, offC);
        if (wr == 1) PG8_BAR;
        PG8_WAIT_V(2); PG8_BAR;
        PG8_STAGE(PG8_SB(1, 0), cB + kstep, voffB); PG8_STA(1, 0, cA + kstep, gA + kstep, offC); PG8_STAGE(PG8_SB(1, 1), cB + hstep + kstep, voffB);
        PG8_WAIT_V(6); PG8_BAR;
    } else {
        PG8_STAGE(PG8_SB(0, 0), cB, voffB); PG8_STAGE(PG8_SA(0, 0), cA, voffA); PG8_STAGE(PG8_SB(0, 1), cB + hstep, voffB); PG8_STAGE(PG8_SA(0, 1), cA + hstep, voffA);
        if (wr == 1) PG8_BAR;
        PG8_WAIT_V(4); PG8_BAR;
        PG8_STAGE(PG8_SB(1, 0), cB + kstep, voffB); PG8_STAGE(PG8_SA(1, 0), cA + kstep, voffA); PG8_STAGE(PG8_SB(1, 1), cB + hstep + kstep, voffB);
        PG8_WAIT_V(6); PG8_BAR;
    }
    for (;;) {
        const bool has_next = S.next(ui + 1, nxt);
        if (has_next) S.a_ready(nxt);
        if constexpr (GATHER) { if (has_next) {
#pragma unroll
            for (int h = 0; h < 2; ++h)
#pragma unroll
                for (int i = 0; i < 2; ++i) offN[h][i] = S.arow(ui + 1, 128 * h + gR[i]) + (unsigned)gC[i]; } }
        const char* nA = has_next ? (const char*)g.A + (size_t)nxt.pm * tstep : cA; const char* nB = has_next ? (const char*)g.Bt + (size_t)nxt.pn * tstep : cB;
        for (int t = 0; t < nt; t += 2) {
            const bool last = (t == nt - 2);
            const char* a1 = cA + (size_t)(t + 1) * kstep;
            const char* a2 = last ? nA : cA + (size_t)(t + 2) * kstep; const char* b2 = last ? nB : cB + (size_t)(t + 2) * kstep;
            const char* a3 = a2 + kstep; const char* b3 = b2 + kstep;
            const char* g2 = gA + (last ? (size_t)0 : (size_t)(t + 2) * kstep); unsigned offS[2][2];
#pragma unroll
            for (int h = 0; h < 2; ++h)
#pragma unroll
                for (int i = 0; i < 2; ++i) offS[h][i] = last ? offN[h][i] : offC[h][i];
            (void)g2; (void)offS;
            if constexpr (SP2) {
            PG8_LDB(B0, 0, 0); PG8_LDB(B1, 0, 1); PG8_SCHED; PG8_LDA(At, 0, 0); PG8_STA(1, 1, a1, gA + (size_t)(t + 1) * kstep, offC);
            PG8_WAIT_V(8); PG8_WAIT_L(0); PG8_BAR; PG8_MMA(0, 0, At, B0); PG8_MMA(0, 1, At, B1); PG8_BAR; PG8_SCHED;
            PG8_LDA(At, 0, 1); PG8_STAGE(PG8_SB(0, 0), b2, voffB); PG8_STAGE(PG8_SB(0, 1), b2 + hstep, voffB); PG8_STA(0, 0, a2, g2, offS);
            PG8_WAIT_V(8); PG8_WAIT_L(0); PG8_BAR; PG8_MMA(1, 0, At, B0); PG8_MMA(1, 1, At, B1); PG8_BAR; PG8_SCHED;
            PG8_LDB(B0, 1, 0); PG8_LDB(B1, 1, 1); PG8_SCHED; PG8_LDA(At, 1, 0); PG8_STA(0, 1, a2, g2, offS);
            PG8_WAIT_V(8); PG8_WAIT_L(0); PG8_BAR; PG8_MMA(0, 0, At, B0); PG8_MMA(0, 1, At, B1); PG8_BAR; PG8_SCHED;
            PG8_LDA(At, 1, 1); PG8_STAGE(PG8_SB(1, 0), b3, voffB); PG8_STAGE(PG8_SB(1, 1), b3 + hstep, voffB); PG8_STA(1, 0, a3, g2 + kstep, offS);
            PG8_WAIT_V(8); PG8_WAIT_L(0); PG8_BAR; PG8_MMA(1, 0, At, B0); PG8_MMA(1, 1, At, B1); PG8_BAR; PG8_SCHED;
            } else {
            PG8_LDB(B0, 0, 0); PG8_SCHED; PG8_LDA(At, 0, 0); PG8_STAGE(PG8_SA(1, 1), a1 + hstep, voffA);
            PG8_WAIT_L(8); PG8_BAR; PG8_WAIT_L(0); PG8_MMA(0, 0, At, B0); PG8_BAR; PG8_SCHED;
            PG8_LDB(B1, 0, 1); PG8_STAGE(PG8_SB(0, 0), b2, voffB);
            PG8_BAR; PG8_WAIT_L(0); PG8_MMA(0, 1, At, B1); PG8_BAR;
            PG8_LDA(At, 0, 1); PG8_STAGE(PG8_SA(0, 0), a2, voffA);
            PG8_BAR; PG8_WAIT_L(0); PG8_MMA(1, 0, At, B0); PG8_BAR; PG8_SCHED;
            PG8_STAGE(PG8_SB(0, 1), b2 + hstep, voffB);
            PG8_WAIT_V(6); PG8_BAR; PG8_MMA(1, 1, At, B1); PG8_BAR;
            PG8_LDB(B0, 1, 0); PG8_SCHED; PG8_LDA(At, 1, 0); PG8_STAGE(PG8_SA(0, 1), a2 + hstep, voffA);
            PG8_WAIT_L(8); PG8_BAR; PG8_WAIT_L(0); PG8_MMA(0, 0, At, B0); PG8_BAR; PG8_SCHED;
            PG8_LDB(B1, 1, 1); PG8_STAGE(PG8_SB(1, 0), b3, voffB);
            PG8_BAR; PG8_WAIT_L(0); PG8_MMA(0, 1, At, B1); PG8_BAR;
            PG8_LDA(At, 1, 1); PG8_STAGE(PG8_SA(1, 0), a3, voffA);
            PG8_BAR; PG8_WAIT_L(0); PG8_MMA(1, 0, At, B0); PG8_BAR; PG8_SCHED;
            PG8_STAGE(PG8_SB(1, 1), b3 + hstep, voffB);
            PG8_WAIT_V(6); PG8_BAR; PG8_MMA(1, 1, At, B1); PG8_BAR;
            }
        }
        if constexpr (ALIGN_EPI) { if (wr == 0) PG8_BAR; }
        if constexpr (!Epi::AFTER_DRAIN) { E(acc, cur, wr, wc, fr, fq); S.done(cur); }
        if (!has_next) break;
#pragma unroll
        for (int a = 0; a < 2; ++a)
#pragma unroll
            for (int b = 0; b < 2; ++b)
#pragma unroll
                for (int m = 0; m < 4; ++m)
#pragma unroll
                    for (int n = 0; n < 2; ++n) acc[a][b][m][n] = (f32x4){0.f, 0.f, 0.f, 0.f};
        cur = nxt; cA = nA; cB = nB; ++ui;
#pragma unroll
        for (int h = 0; h < 2; ++h)
#pragma unroll
            for (int i = 0; i < 2; ++i) offC[h][i] = offN[h][i];
        if constexpr (ALIGN_EPI) { if (wr == 1) PG8_BAR; }
    }
    PG8_WAIT_V(0);
    if constexpr (!ALIGN_EPI) { if (wr == 0) PG8_BAR; }
    PG8_BAR;
    if constexpr (Epi::AFTER_DRAIN) { E.fused(acc, cur, wr, wc, fr, fq, lds, wid, lane); S.done(cur); }
#undef PG8_SA
#undef PG8_SB
#undef PG8_STAGE
#undef PG8_STAGE_C
#undef PG8_STA
#undef PG8_LDA
#undef PG8_LDB
#undef PG8_MMA
#undef PG8_WAIT_V
#undef PG8_WAIT_L
#undef PG8_BAR
#undef PG8_SCHED
}

typedef unsigned u32x4e __attribute__((ext_vector_type(4)));
__device__ __forceinline__ f32x4 i2f4(const f32x4 r, float s) { const float a = r.x, b = r.y, c = r.z, d = r.w; return (f32x4){(float)__float_as_int(a) * s, (float)__float_as_int(b) * s, (float)__float_as_int(c) * s, (float)__float_as_int(d) * s}; }
typedef unsigned u32x2e __attribute__((ext_vector_type(2)));
struct EpiInProj {
    static constexpr bool PERM = true, AFTER_DRAIN = false;
    bf16_t* O; const float* cosT; const float* sinT; float qscale, dq;
    unsigned* smn;
    unsigned* nrm;
    __device__ __forceinline__ void operator()(const f32x4 (&acc)[2][2][4][2], const Unit& u, int wr, int wc, int fr, int fq) const {
        const int row0 = u.pm * BM + wr * 64 + fr;
        if (u.pn < 4) {
            const float sc = u.pn < 2 ? qscale : 1.f; const int colb = (u.pn * 4 + wc) * 64 + 8 * fq;
#pragma unroll
            for (int ai = 0; ai < 2; ++ai)
#pragma unroll
                for (int m = 0; m < 4; ++m) { const int row = row0 + ai * HALF + m * 16, pos = row & 4095;
                    const f32x4 c0 = *(const f32x4*)(cosT + pos * 32 + 8 * fq), c1 = *(const f32x4*)(cosT + pos * 32 + 8 * fq + 4), s0 = *(const f32x4*)(sinT + pos * 32 + 8 * fq), s1 = *(const f32x4*)(sinT + pos * 32 + 8 * fq + 4);
                    const f32x4 a0 = i2f4(acc[ai][0][m][0], dq), a1 = i2f4(acc[ai][0][m][1], dq), b0 = i2f4(acc[ai][1][m][0], dq), b1 = i2f4(acc[ai][1][m][1], dq);
                    const f32x4 p0 = (a0 * c0 - b0 * s0) * sc, p1 = (a1 * c1 - b1 * s1) * sc, q0 = (b0 * c0 + a0 * s0) * sc, q1 = (b1 * c1 + a1 * s1) * sc;
                    u32x4e w; w.x = cvt_pk_bf16(p0[0], p0[1]); w.y = cvt_pk_bf16(p0[2], p0[3]); w.z = cvt_pk_bf16(p1[0], p1[1]); w.w = cvt_pk_bf16(p1[2], p1[3]);
                    bf16_t* rp = O + (size_t)row * 3072 + colb; *(u32x4e*)rp = w;
                    w.x = cvt_pk_bf16(q0[0], q0[1]); w.y = cvt_pk_bf16(q0[2], q0[3]); w.z = cvt_pk_bf16(q1[0], q1[1]); w.w = cvt_pk_bf16(q1[2], q1[3]); *(u32x4e*)(rp + 32) = w; }
        } else {
            if (u.pn >= 6 && u.pn <= 9) {
                const int hp = u.pn - 6, colq = 1536 + hp * 128 + wc * 32 + 8 * fq; const float sq_ = qscale * dq;
                float nq = 0.f, nk = 0.f, smin = 3.0e38f;
#pragma unroll
                for (int ai = 0; ai < 2; ++ai)
#pragma unroll
                    for (int m = 0; m < 4; ++m) { bf16_t* rp = O + (size_t)(row0 + ai * HALF + m * 16) * 3072 + colq;
                        const f32x4 q0 = i2f4(acc[ai][0][m][0], sq_), q1 = i2f4(acc[ai][0][m][1], sq_), k0 = i2f4(acc[ai][1][m][0], dq), k1 = i2f4(acc[ai][1][m][1], dq);
                        u32x4e w; w.x = cvt_pk_bf16(q0[0], q0[1]); w.y = cvt_pk_bf16(q0[2], q0[3]); w.z = cvt_pk_bf16(q1[0], q1[1]); w.w = cvt_pk_bf16(q1[2], q1[3]); *(u32x4e*)rp = w;
                        w.x = cvt_pk_bf16(k0[0], k0[1]); w.y = cvt_pk_bf16(k0[2], k0[3]); w.z = cvt_pk_bf16(k1[0], k1[1]); w.w = cvt_pk_bf16(k1[2], k1[3]); *(u32x4e*)(rp + 512) = w;
                        float a = hsum4(q0 * q0 + q1 * q1), b_ = hsum4(k0 * k0 + k1 * k1), d = hsum4(q0 * k0 + q1 * k1);
                        a = swap16_add(a, a); a = swap32_add(a, a); b_ = swap16_add(b_, b_); b_ = swap32_add(b_, b_); d = swap16_add(d, d); d = swap32_add(d, d);
                        nq = fmaxf(nq, a); nk = fmaxf(nk, b_); smin = fminf(smin, d); }
                nq = fmaxf(nq, dppf<0xB1>(nq)); nq = fmaxf(nq, dppf<0x4E>(nq)); nq = fmaxf(nq, dppf<0x141>(nq)); nq = fmaxf(nq, dppf<0x128>(nq));
                nk = fmaxf(nk, dppf<0xB1>(nk)); nk = fmaxf(nk, dppf<0x4E>(nk)); nk = fmaxf(nk, dppf<0x141>(nk)); nk = fmaxf(nk, dppf<0x128>(nk));
                smin = fminf(smin, dppf<0xB1>(smin)); smin = fminf(smin, dppf<0x4E>(smin)); smin = fminf(smin, dppf<0x141>(smin)); smin = fminf(smin, dppf<0x128>(smin));
                if (fr == 0 && fq == 0) { const int b = (u.pm * BM) >> 12, qb = u.pm & 15, h = hp * 2 + (wc >> 1);
                    atomicMax(nrm + ((b * 8 + h) * 2 + 0) * 2 + (wc & 1), __float_as_uint(nq)); atomicMax(nrm + ((b * 8 + h) * 2 + 1) * 2 + (wc & 1), __float_as_uint(nk));
                    const int si = __float_as_int(smin); atomicMin((int*)smn + (((b * 8 + h) * 16 + qb) * 2 + (wc & 1)), si >= 0 ? si : si ^ 0x7fffffff); }
            } else {
            const float sc = dq; const int col0 = u.pn * BM + wc * 32 + 8 * fq;
#pragma unroll
            for (int ai = 0; ai < 2; ++ai)
#pragma unroll
                for (int m = 0; m < 4; ++m) { bf16_t* rp = O + (size_t)(row0 + ai * HALF + m * 16) * 3072 + col0;
#pragma unroll
                    for (int bj = 0; bj < 2; ++bj) { const f32x4 v0 = i2f4(acc[ai][bj][m][0], sc), v1 = i2f4(acc[ai][bj][m][1], sc);
                        u32x4e w; w.x = cvt_pk_bf16(v0[0], v0[1]); w.y = cvt_pk_bf16(v0[2], v0[3]); w.z = cvt_pk_bf16(v1[0], v1[1]); w.w = cvt_pk_bf16(v1[2], v1[3]); *(u32x4e*)(rp + bj * HALF) = w; } }
            }
        }
    }
};
struct EpiBf16P {
    static constexpr bool PERM = true, AFTER_DRAIN = false;
    bf16_t* C; int ldc; float dq;
    __device__ __forceinline__ void operator()(const f32x4 (&acc)[2][2][4][2], const Unit& u, int wr, int wc, int fr, int fq) const {
        const int row0 = u.pm * BM + wr * 64 + fr, col0 = u.pn * BM + wc * 32 + 8 * fq;
#pragma unroll
        for (int ai = 0; ai < 2; ++ai)
#pragma unroll
            for (int m = 0; m < 4; ++m) { bf16_t* rp = C + (size_t)(row0 + ai * HALF + m * 16) * ldc + col0;
#pragma unroll
                for (int bj = 0; bj < 2; ++bj) { const f32x4 v0 = i2f4(acc[ai][bj][m][0], dq), v1 = i2f4(acc[ai][bj][m][1], dq);
                    u32x4e w; w.x = cvt_pk_bf16(v0[0], v0[1]); w.y = cvt_pk_bf16(v0[2], v0[3]); w.z = cvt_pk_bf16(v1[0], v1[1]); w.w = cvt_pk_bf16(v1[2], v1[3]); *(u32x4e*)(rp + bj * HALF) = w; } }
    }
};
struct EpiF32 {
    static constexpr bool PERM = false, AFTER_DRAIN = false;
    float* C; int ldc;
    __device__ __forceinline__ void operator()(const f32x4 (&acc)[2][2][4][2], const Unit& u, int wr, int wc, int fr, int fq) const {
        const int row0 = u.pm * BM + wr * 64 + fr, col0 = u.pn * BM + wc * 32 + 4 * fq;
#pragma unroll
        for (int ai = 0; ai < 2; ++ai)
#pragma unroll
            for (int m = 0; m < 4; ++m) { float* rp = C + (size_t)(row0 + ai * HALF + m * 16) * ldc + col0;
#pragma unroll
                for (int bj = 0; bj < 2; ++bj)
#pragma unroll
                    for (int n = 0; n < 2; ++n) *(f32x4*)(rp + bj * HALF + n * 16) = acc[ai][bj][m][n]; }
    }
};

__device__ __forceinline__ unsigned qpk4(float a, float b, float c, float d, float s) {
    unsigned w = __builtin_amdgcn_cvt_pk_u8_f32(__builtin_fmaf(a, s, 128.f), 0, 0u); w = __builtin_amdgcn_cvt_pk_u8_f32(__builtin_fmaf(b, s, 128.f), 1, w);
    w = __builtin_amdgcn_cvt_pk_u8_f32(__builtin_fmaf(c, s, 128.f), 2, w); w = __builtin_amdgcn_cvt_pk_u8_f32(__builtin_fmaf(d, s, 128.f), 3, w); return w ^ 0x80808080u; }
struct EpiSwiGLU {
    static constexpr bool PERM = true, AFTER_DRAIN = false;
    bf16_t* ACT; float dq, qa;
    __device__ __forceinline__ void operator()(const f32x4 (&acc)[2][2][4][2], const Unit& u, int wr, int wc, int fr, int fq) const {
        const int row0 = u.pm * BM + wr * 64 + fr, col0 = (u.pn & 3) * 128 + wc * 32 + 8 * fq;
#pragma unroll
        for (int ai = 0; ai < 2; ++ai)
#pragma unroll
            for (int m = 0; m < 4; ++m) { float a[8];
#pragma unroll
                for (int n = 0; n < 2; ++n)
#pragma unroll
                    for (int e = 0; e < 4; ++e) { const float gb = acc[ai][0][m][n][e], ub = acc[ai][1][m][n][e];
                        const float gv = (float)__float_as_int(gb) * dq, uv = (float)__float_as_int(ub) * dq;
                        a[4 * n + e] = gv * __builtin_amdgcn_rcpf(1.f + __expf(-gv)) * uv; }
                u32x2e w; w.x = qpk4(a[0], a[1], a[2], a[3], qa); w.y = qpk4(a[4], a[5], a[6], a[7], qa);
                asm volatile("global_store_dwordx2 %0, %1, off sc0 sc1" :: "v"((unsigned char*)ACT + (size_t)(row0 + ai * HALF + m * 16) * 512 + col0), "v"(w) : "memory"); }
    }
};
struct EpiScatter {
    static constexpr bool PERM = true, AFTER_DRAIN = false;
    bf16_t* YS; const PG8_LAS int* stab; float dq;
    __device__ __forceinline__ void operator()(const f32x4 (&acc)[2][2][4][2], const Unit& u, int wr, int wc, int fr, int fq) const {
        const int col0 = (u.pn & 3) * BM + wc * 32 + 8 * fq;
#pragma unroll
        for (int ai = 0; ai < 2; ++ai)
#pragma unroll
            for (int m = 0; m < 4; ++m) { const int slot = stab[u.aux * 256 + ai * HALF + wr * 64 + m * 16 + fr];
                if (slot >= 0) { unsigned char* rp = (unsigned char*)YS + (size_t)slot * 1024 + col0;
#pragma unroll
                    for (int bj = 0; bj < 2; ++bj) { const f32x4 r0 = acc[ai][bj][m][0], r1 = acc[ai][bj][m][1];
                        const f32x4 v0 = (f32x4){(float)__float_as_int(r0.x), (float)__float_as_int(r0.y), (float)__float_as_int(r0.z), (float)__float_as_int(r0.w)} * dq, v1 = (f32x4){(float)__float_as_int(r1.x), (float)__float_as_int(r1.y), (float)__float_as_int(r1.z), (float)__float_as_int(r1.w)} * dq;
                        u32x2e w; w.x = (unsigned)__builtin_amdgcn_cvt_pk_fp8_f32(v0[2], v0[3], __builtin_amdgcn_cvt_pk_fp8_f32(v0[0], v0[1], 0, false), true);
                        w.y = (unsigned)__builtin_amdgcn_cvt_pk_fp8_f32(v1[2], v1[3], __builtin_amdgcn_cvt_pk_fp8_f32(v1[0], v1[1], 0, false), true); *(u32x2e*)(rp + bj * HALF) = w; } } }
    }
};
struct MoeSched {
    const PG8_LAS int* ut;
    const PG8_LAS unsigned* tab;
    __device__ __forceinline__ bool next(int i, Unit& u) const { if (i >= 8) return false; const int pm = __builtin_amdgcn_readfirstlane(ut[2 * i]); if (pm < 0) return false;
        u.pm = pm; u.pn = __builtin_amdgcn_readfirstlane(ut[2 * i + 1]); u.aux = i; return true; }
    unsigned* tc; int mode;
    __device__ __forceinline__ unsigned arow(int ui, int r) const { return tab[ui * 256 + r]; }
    __device__ __forceinline__ void a_ready(const Unit& u) const { if (mode == 2) { unsigned* q = tc + u.pm * 16;
        while (__hip_atomic_load(q, __ATOMIC_RELAXED, __HIP_MEMORY_SCOPE_AGENT) < 32u) __builtin_amdgcn_s_sleep(2);
        asm volatile("" ::: "memory"); } }
    __device__ __forceinline__ void done(const Unit& u) const { if (mode == 1) { asm volatile("s_waitcnt vmcnt(0)" ::: "memory");
        if ((threadIdx.x & 63) == 0) __hip_atomic_fetch_add(tc + u.pm * 16, 1u, __ATOMIC_RELAXED, __HIP_MEMORY_SCOPE_AGENT); } }
};
}

constexpr int LDS_BYTES = 151552;
constexpr int MOE_LDS = 131072;
constexpr int MISC_OFF = 147712;
constexpr int CW_BAR = 4096;
#define GAS __attribute__((address_space(1)))
#define LAS __attribute__((address_space(3)))
typedef GAS unsigned gu32;
typedef GAS unsigned long long gu64;
#define RLX_AGENT __ATOMIC_RELAXED, __HIP_MEMORY_SCOPE_AGENT
#define LDS_WAIT() asm volatile("s_waitcnt lgkmcnt(0)" ::: "memory")
#define VM_WAIT() asm volatile("s_waitcnt vmcnt(0)" ::: "memory")
#define XB_TMO      128
#define XB_XCNT(j)  (256  + 64 * (j))
#define XB_XSUB(j)  (1280 + 64 * (j))
#define XB_XGEN(j)  (2304 + 64 * (j))
#define XB_TOP      3328
#define XB_TOPGEN   3392
#define XCD_BAR_WORDS 3456
#define XB_SPIN_CAP (1u << 22)

__device__ __forceinline__ unsigned xb_ld(unsigned* p)              { return __hip_atomic_load(p, __ATOMIC_RELAXED, __HIP_MEMORY_SCOPE_AGENT); }
__device__ __forceinline__ unsigned xb_add(unsigned* p, unsigned v) { return __hip_atomic_fetch_add(p, v, __ATOMIC_RELAXED, __HIP_MEMORY_SCOPE_AGENT); }
__device__ __forceinline__ unsigned xb_xcc_id() { return (unsigned)__builtin_amdgcn_s_getreg((3 << 11) | 20) & 0xFu; }
#define XB_SPIN(cond, bar) do { unsigned _sp = 0; while (cond) { __builtin_amdgcn_s_sleep(1); \
    if ((++_sp & 255u) == 0u) { if (xb_ld(&(bar)[XB_TMO])) break; if (_sp > XB_SPIN_CAP) { atomicAdd(&(bar)[XB_TMO], 1u); break; } } } } while (0)

struct XcdBarrier {
    unsigned* bar; unsigned x;
    volatile LAS unsigned* st;
};

__device__ __forceinline__ XcdBarrier xcd_barrier_post(unsigned* bar, volatile LAS unsigned* st) {
    XcdBarrier b; b.bar = bar; b.x = xb_xcc_id(); b.st = st;
    if (threadIdx.x == 0) (void)xb_add(&bar[XB_XCNT(b.x)], 1u);
    return b;
}
__device__ __forceinline__ void xcd_barrier_complete(unsigned* bar, unsigned x, unsigned& nloc, unsigned& nx) {
    const unsigned G = gridDim.x * gridDim.y * gridDim.z;
    unsigned sum, cnt, mine, sp = 0u;
    for (;;) {
        sum = 0u; cnt = 0u; mine = 0u;
#pragma unroll
        for (unsigned j = 0; j < 16; ++j) { const unsigned c = xb_ld(&bar[XB_XCNT(j)]); sum += c; cnt += (c > 0u) ? 1u : 0u; mine = (j == x) ? c : mine; }
        if (sum == G) break;
        __builtin_amdgcn_s_sleep(1);
        if ((++sp & 255u) == 0u) { if (xb_ld(&bar[XB_TMO])) break; if (sp > XB_SPIN_CAP) { atomicAdd(&bar[XB_TMO], 1u); break; } }
    }
    nloc = mine > 0u ? mine : 1u; nx = cnt > 0u ? cnt : 1u;
}

__device__ __forceinline__ void xcd_barrier(const XcdBarrier& b) {
    asm volatile("s_waitcnt vmcnt(0)" ::: "memory");
    __syncthreads();
    if (threadIdx.x == 0) {
        unsigned* bar = b.bar;
        __builtin_amdgcn_s_waitcnt(0);
        unsigned nloc = b.st[0], nx = b.st[1];
        if (nloc == 0u) { xcd_barrier_complete(bar, b.x, nloc, nx); b.st[0] = nloc; b.st[1] = nx; }
        const unsigned old = xb_add(&bar[XB_XSUB(b.x)], 1u);
        const unsigned gen = old / nloc;
        if (old + 1u == (gen + 1u) * nloc) {
            __builtin_amdgcn_fence(__ATOMIC_RELEASE, "agent");
            asm volatile("s_waitcnt vmcnt(0)" ::: "memory");
            const unsigned og = xb_add(&bar[XB_TOP], 1u);
            const unsigned tg = og / nx;
            if (og + 1u == (tg + 1u) * nx) xb_add(&bar[XB_TOPGEN], 1u);
            else XB_SPIN(xb_ld(&bar[XB_TOPGEN]) == tg, bar);
            __builtin_amdgcn_fence(__ATOMIC_ACQUIRE, "agent");
            xb_add(&bar[XB_XGEN(b.x)], 1u);
            asm volatile("s_waitcnt vmcnt(0)" ::: "memory");
        } else {
            XB_SPIN(xb_ld(&bar[XB_XGEN(b.x)]) == gen, bar);
            __builtin_amdgcn_fence(__ATOMIC_ACQUIRE, "agent");
            asm volatile("s_waitcnt vmcnt(0)" ::: "memory");
        }
    }
    __syncthreads();
}

__device__ __forceinline__ void inproj_phase(const P& p, PG8_LAS unsigned char* l3, int c, int G) {
    pg8::Gemm g{(const bf16*)(p.ws + WS_H), (const bf16*)(p.ws + WS_WIN), T, NQKV, D};
    pg8::StaticOrder S; S.init(T, NQKV, G, c);
    const float* cosT = (const float*)(p.ws + WS_ROPE);
    pg8::EpiInProj E{(bf16*)(p.ws + WS_R), cosT, cosT + SEQ * 32, 0.125f * 1.4426950408889634f, 1.f / (Q8_ACT * Q8_W), (unsigned*)(p.ws + WS_CTL) + CW_SMIN, (unsigned*)(p.ws + WS_CTL) + CW_NORM};
    pg8::gemm_phase<pg8::EpiInProj, pg8::StaticOrder, true, true, false, true>(l3, g, S, E);
}
__device__ __forceinline__ void outproj_phase(const P& p, PG8_LAS unsigned char* l3, int c, int G) {
    pg8::Gemm g{(const bf16*)(p.ws + WS_H), (const bf16*)(p.ws + WS_WOUT), T, D, D};
    pg8::StaticOrder S; S.init(T, D, G, c);
    pg8::EpiBf16P E{(bf16*)(p.ws + WS_R), D, 1.f / (Q8_MIX * Q8_W)};
    pg8::gemm_phase<pg8::EpiBf16P, pg8::StaticOrder, true, true, false, true>(l3, g, S, E);
}
__device__ __forceinline__ void moe_setup(const P& p, PG8_LAS unsigned char* ldsx, int c, int G, bool down) {
    const int tid = tid_fresh();
    PG8_LAS int* ts = (PG8_LAS int*)ldsx; PG8_LAS int* ut = (PG8_LAS int*)(ldsx + 256); PG8_LAS int* tab = (PG8_LAS int*)(ldsx + 512);
    const unsigned* cnt = (const unsigned*)(p.ws + WS_CTL); const int* list = (const int*)(p.ws + WS_LIST);
    if (tid == 0) { int s = 0; for (int e = 0; e < NE; ++e) { ts[e] = s; s += ((int)cnt[e * CNT_STRIDE] + 255) >> 8; } ts[NE] = s; }
    __syncthreads();
    if (tid < 8) { const int NU = ts[NE] * 4, cv = down ? (c + G - NU % G) % G : c, L = tid * G + cv;
        if (L < NU) { const int t = L >> 2; int e = 0; for (int q = 1; q < NE; ++q) if (ts[q] <= t) e = q; ut[2 * tid] = t; ut[2 * tid + 1] = e * 4 + (L & 3); } else { ut[2 * tid] = -1; ut[2 * tid + 1] = 0; } }
    __syncthreads();
    for (int idx = tid; idx < 8 * 256; idx += 512) { const int i = idx >> 8, r = idx & 255, pm = ut[2 * i]; int v = down ? -1 : 0;
        if (pm >= 0) { const int e = ut[2 * i + 1] >> 2, k = (pm - ts[e]) * 256 + r; if (k < (int)cnt[e * CNT_STRIDE]) { const int slot = list[e * T + k]; v = down ? slot : (slot >> 1) * D; } }
        tab[idx] = v; }
    __syncthreads();
}
__device__ __forceinline__ void moe1_phase(const P& p, PG8_LAS unsigned char* l3, int c, int G) {
    moe_setup(p, l3 + MOE_LDS, c, G, false);
    pg8::Gemm g{(const bf16*)(p.ws + WS_H), (const bf16*)(p.ws + WS_WGU), 0, 0, D};
    pg8::MoeSched S{(const PG8_LAS int*)(l3 + MOE_LDS + 256), (const PG8_LAS unsigned*)(l3 + MOE_LDS + 512), (unsigned*)(p.ws + WS_CTL) + CW_TILE, 1};
    pg8::EpiSwiGLU E{(bf16*)(p.ws + WS_ACT), 1.f / (Q8_ACT * Q8_W), Q8_ACT2};
    pg8::gemm_phase<pg8::EpiSwiGLU, pg8::MoeSched, true, true, true, true>(l3, g, S, E);
}
__device__ __forceinline__ void moe2_phase(const P& p, PG8_LAS unsigned char* l3, int c, int G) {
    moe_setup(p, l3 + MOE_LDS, c, G, true);
    pg8::Gemm g{(const bf16*)(p.ws + WS_ACT), (const bf16*)(p.ws + WS_WD), 0, 0, DE};
    pg8::MoeSched S{(const PG8_LAS int*)(l3 + MOE_LDS + 256), (const PG8_LAS unsigned*)(l3 + MOE_LDS + 512), (unsigned*)(p.ws + WS_CTL) + CW_TILE, 2};
    pg8::EpiScatter E{(bf16*)(p.ws + WS_R), (const PG8_LAS int*)(l3 + MOE_LDS + 512), 16.f / (Q8_ACT2 * Q8_WD)};
    pg8::gemm_phase<pg8::EpiScatter, pg8::MoeSched, true, true, false, true, true>(l3, g, S, E);
}

namespace attn_body {
using bf16=__hip_bfloat16;
using bf16x8=__attribute__((ext_vector_type(8)))short;
using s16x4=__attribute__((ext_vector_type(4)))short;
using f32x16=__attribute__((ext_vector_type(16)))float;
using u32x4=__attribute__((ext_vector_type(4)))unsigned;
using f32x4v=__attribute__((ext_vector_type(4)))float;
constexpr int SEQ=4096,D=64,QP=3072,OP=1024;
constexpr int NW=8,QBLK=32,QB=QBLK*NW,KVBLK=64,NQB=SEQ/QB;
__device__ __forceinline__ int crow(int r,int hi){return (r&3)+8*(r>>2)+4*hi;}
#define SBAR() __builtin_amdgcn_sched_barrier(0)
__device__ __forceinline__ void cmask(f32x16&p0,f32x16&p1,int jb,int qrel,int hi){
  const float NEG=-INFINITY; int kb=64*jb+4*hi;
  #pragma unroll
  for(int r=0;r<16;++r){int kv=kb+(r&3)+8*(r>>2); if(kv>qrel)p0[r]=NEG; if(kv+32>qrel)p1[r]=NEG;}
}

__device__ __forceinline__ void chmask(f32x16&p0,f32x16&p1,int jb,int wid){
  const float NEG=-INFINITY;
  if(jb>(wid>>1)){
  #pragma unroll
  for(int r=0;r<16;++r){p0[r]=NEG;p1[r]=NEG;}}
}
constexpr int NSLOT=3, SLOTB=8192;
constexpr int LDS_K=0, LDS_V=NSLOT*SLOTB, LDS_WS=LDS_V+2*NSLOT*SLOTB, LDS_OST=LDS_WS+NW*64*4, LDS_BYTES=LDS_OST+NW*4096, LDS_FB=LDS_BYTES, LDS_Y=LDS_OST;
static_assert(LDS_Y+NW*8192<=147456 && LDS_FB+16384<=147456, "attention LDS map");
constexpr float C2=0.125f*1.4426950408889634f;
__device__ __forceinline__ void glds16(const void*gsrc,unsigned lds_dst){unsigned keep;
  asm volatile("s_mov_b32 %0, m0\n\ts_mov_b32 m0, %2\n\ts_nop 0\n\tglobal_load_lds_dwordx4 %1, off\n\ts_mov_b32 m0, %0":"=&s"(keep):"v"(gsrc),"s"(lds_dst):"memory");}
__device__ __forceinline__ void glds16s(const void*sbase0,unsigned voff,unsigned lds_dst){unsigned keep;
  const unsigned long long sb_=(unsigned long long)(uintptr_t)sbase0; const void*sbase=(const void*)(uintptr_t)(((unsigned long long)(unsigned)__builtin_amdgcn_readfirstlane((int)(sb_>>32))<<32)|(unsigned)__builtin_amdgcn_readfirstlane((int)sb_));
  asm volatile("s_mov_b32 %0, m0\n\ts_mov_b32 m0, %2\n\ts_nop 0\n\tglobal_load_lds_dwordx4 %1, %3\n\ts_mov_b32 m0, %0":"=&s"(keep):"v"(voff),"s"(lds_dst),"s"(sbase):"memory");}
__device__ __forceinline__ float max3f(float a,float b,float c){float r;asm("v_max3_f32 %0, %1, %2, %3":"=v"(r):"v"(a),"v"(b),"v"(c));return r;}
__device__ __forceinline__ float max2f(float a,float b){float r;asm("v_max_f32_e32 %0, %1, %2":"=v"(r):"v"(a),"v"(b));return r;}
__device__ __forceinline__ float fadd_s(float a,float b){float r;asm("v_add_f32_e32 %0, %1, %2":"=v"(r):"v"(a),"v"(b));return r;}
__device__ __forceinline__ float fsub_s(float a,float b){float r;asm("v_sub_f32_e32 %0, %1, %2":"=v"(r):"v"(a),"v"(b));return r;}
typedef float f32x2_t __attribute__((ext_vector_type(2))); typedef __bf16 bf16x2_t __attribute__((ext_vector_type(2)));
__device__ __forceinline__ unsigned cvtpk_s(float lo,float hi){f32x2_t v={lo,hi};bf16x2_t b=__builtin_convertvector(v,bf16x2_t);return __builtin_bit_cast(unsigned,b);}
#define WAIT_BAR(N) asm volatile("s_waitcnt vmcnt(" #N ") lgkmcnt(0)\n\ts_barrier":::"memory")

__device__ __forceinline__ void qkt(f32x16&p0,f32x16&p1,const char*Kslot,const bf16x8*qr,const f32x16&negm,int r32,int hi){
  const char*kb=Kslot+hi*1024+r32*16;
  #pragma unroll
  for(int d0=0;d0<4;++d0){
    const bf16x8 b0=*reinterpret_cast<const bf16x8*>(kb+d0*2048);
    const bf16x8 b1=*reinterpret_cast<const bf16x8*>(kb+d0*2048+512);
    if(d0==0){p0=__builtin_amdgcn_mfma_f32_32x32x16_bf16(b0,qr[0],negm,0,0,0);p1=__builtin_amdgcn_mfma_f32_32x32x16_bf16(b1,qr[0],negm,0,0,0);}
    else{p0=__builtin_amdgcn_mfma_f32_32x32x16_bf16(b0,qr[d0],p0,0,0,0);p1=__builtin_amdgcn_mfma_f32_32x32x16_bf16(b1,qr[d0],p1,0,0,0);}}
}
__device__ __forceinline__ void qkt_acc(f32x16&p0,f32x16&p1,const char*Kslot,const bf16x8*qr,int r32,int hi){
  const char*kb=Kslot+hi*1024+r32*16;
  #pragma unroll
  for(int d0=0;d0<4;++d0){
    const bf16x8 b0=*reinterpret_cast<const bf16x8*>(kb+d0*2048);
    const bf16x8 b1=*reinterpret_cast<const bf16x8*>(kb+d0*2048+512);
    p0=__builtin_amdgcn_mfma_f32_32x32x16_bf16(b0,qr[d0],p0,0,0,0);p1=__builtin_amdgcn_mfma_f32_32x32x16_bf16(b1,qr[d0],p1,0,0,0);}
}
typedef __attribute__((address_space(3))) const float* lds_fptr;
__device__ __forceinline__ void bias4(f32x16&p,lds_fptr fb,int g){ const f32x4v v=*(const __attribute__((address_space(3))) f32x4v*)(fb+8*g); p[4*g]=v[0];p[4*g+1]=v[1];p[4*g+2]=v[2];p[4*g+3]=v[3]; }
__device__ __forceinline__ void sub4(f32x16&p,int g,float mh){ p[4*g]-=mh;p[4*g+1]-=mh;p[4*g+2]-=mh;p[4*g+3]-=mh; }
typedef __attribute__((address_space(3))) const char* lds_cptr;
typedef short v4i16_t __attribute__((ext_vector_type(4)));
__device__ __forceinline__ void kload8(bf16x8*kf,lds_cptr kp){
  kf[0]=*(const __attribute__((address_space(3))) bf16x8*)(kp);      kf[1]=*(const __attribute__((address_space(3))) bf16x8*)(kp+512);
  kf[2]=*(const __attribute__((address_space(3))) bf16x8*)(kp+2048); kf[3]=*(const __attribute__((address_space(3))) bf16x8*)(kp+2560);
  kf[4]=*(const __attribute__((address_space(3))) bf16x8*)(kp+4096); kf[5]=*(const __attribute__((address_space(3))) bf16x8*)(kp+4608);
  kf[6]=*(const __attribute__((address_space(3))) bf16x8*)(kp+6144); kf[7]=*(const __attribute__((address_space(3))) bf16x8*)(kp+6656);
}
__device__ __forceinline__ void kload2(bf16x8*kf,lds_cptr kp,int j){ kf[2*j]=*(const __attribute__((address_space(3))) bf16x8*)(kp+j*2048); kf[2*j+1]=*(const __attribute__((address_space(3))) bf16x8*)(kp+j*2048+512); }
__device__ __forceinline__ s16x4 vtr(lds_cptr p){ return __builtin_bit_cast(s16x4,__builtin_amdgcn_ds_read_tr16_b64_v4i16((__attribute__((address_space(3))) v4i16_t*)p)); }
__device__ __forceinline__ float rowmax(const f32x16&p0,const f32x16&p1){
  float a=max3f(p0[0],p0[1],p1[0]),b=max3f(p0[2],p0[3],p1[1]);a=max3f(a,p1[2],p1[3]);
  #pragma unroll
  for(int r=4;r<16;r+=4){a=max3f(a,p0[r],p0[r+1]);b=max3f(b,p0[r+2],p0[r+3]);a=max3f(a,p1[r],p1[r+1]);b=max3f(b,p1[r+2],p1[r+3]);}
  const float m=max2f(a,b);
  auto rr=__builtin_amdgcn_permlane32_swap(__float_as_uint(m),__float_as_uint(m),false,false);
  return max2f(__uint_as_float(rr[0]),__uint_as_float(rr[1]));
}
template<int ND> __device__ __forceinline__ void pv(f32x16*o,int vb,bf16x8 pa0,bf16x8 pa1,bf16x8 pa2,bf16x8 pa3){
  #pragma unroll
  for(int d0=0;d0<ND;++d0){s16x4 lo[4],hi[4];
    #pragma unroll
    for(int ks=0;ks<4;++ks){
      asm volatile("ds_read_b64_tr_b16 %0,%1 offset:%c2":"=&v"(lo[ks]):"v"(vb),"i"(d0*4096+ks*1024):"memory");
      asm volatile("ds_read_b64_tr_b16 %0,%1 offset:%c2":"=&v"(hi[ks]):"v"(vb),"i"(d0*4096+ks*1024+512):"memory");}
    asm volatile("s_waitcnt lgkmcnt(0)":::"memory");SBAR();
    #define PK(k) (bf16x8){lo[k][0],lo[k][1],lo[k][2],lo[k][3],hi[k][0],hi[k][1],hi[k][2],hi[k][3]}
    o[d0]=__builtin_amdgcn_mfma_f32_32x32x16_bf16(pa0,PK(0),o[d0],0,0,0);
    o[d0]=__builtin_amdgcn_mfma_f32_32x32x16_bf16(pa1,PK(1),o[d0],0,0,0);
    o[d0]=__builtin_amdgcn_mfma_f32_32x32x16_bf16(pa2,PK(2),o[d0],0,0,0);
    o[d0]=__builtin_amdgcn_mfma_f32_32x32x16_bf16(pa3,PK(3),o[d0],0,0,0);
    #undef PK
  }
}

#ifndef ATTN_STORE16
#define ATTN_STORE16(p,v) (*(u32x4*)(p)=(v))
#endif
template<int THRL,int MODE,class Epi,bool UREF=false> __device__ __forceinline__ void attn_unit(int qb,int t0,const bf16*Q,const bf16*__restrict__ K,const bf16*__restrict__ V,char*shm,const Epi&epi){
  const int tid=tid_fresh(),lane=tid&63,r32=lane&31,hi=lane>>5; const int wid=__builtin_amdgcn_readfirstlane(tid>>6);
  constexpr int VM=(MODE==1)?2:1, ND=(MODE==1)?4:2;
  const int q0=qb*QB;
  const bf16*Qw=Q+(long)(q0+wid*QBLK)*QP;
  const bf16*Kh=K+(long)t0*KVBLK*QP,*Vh=V+(long)t0*KVBLK*QP;
  const unsigned lds0=(unsigned)(uintptr_t)shm;
  float*wsf=(float*)(shm+LDS_WS)+wid*64;
  const unsigned koff=(unsigned)((lane*QP+wid*8)*2), voff=(unsigned)(((16*(wid&3)+(lane>>2))*QP+(wid>>2)*32+(lane&3)*8)*2);
  const unsigned kdst=lds0+LDS_K+wid*1024, vdst=lds0+LDS_V+wid*1024;
  #define DMA_K(t,slot) glds16s(Kh+(long)(t)*KVBLK*QP,koff,(unsigned)__builtin_amdgcn_readfirstlane(kdst+(slot)))
  #define DMA_V(t,slot) do{ glds16s(Vh+(long)(t)*KVBLK*QP,voff,(unsigned)__builtin_amdgcn_readfirstlane(vdst+VM*(slot))); if constexpr(MODE==1) glds16s(Vh+64+(long)(t)*KVBLK*QP,voff,(unsigned)__builtin_amdgcn_readfirstlane(vdst+VM*(slot)+8192)); }while(0)
  const int vb0=(int)(lds0+LDS_V)+((lane>>4)&1)*32+(lane&3)*8+(4*hi+((lane&15)>>2))*64;
  const char*Kbase=shm+LDS_K; bf16x8 kf[8];
  const lds_cptr shm3=(lds_cptr)shm; const lds_fptr fb0=(lds_fptr)(shm3+LDS_FB)+4*hi; const lds_cptr kp0=shm3+LDS_K+hi*1024+r32*16; const lds_cptr vp0=shm3+LDS_V+((lane>>4)&1)*32+(lane&3)*8+(4*hi+((lane&15)>>2))*64;
  const int NT=(q0+QB)/KVBLK-t0;
  DMA_K(0,0);DMA_V(0,0);DMA_K(1,SLOTB);
  bf16x8 qr[4];
  #pragma unroll
  for(int d0=0;d0<4;++d0)qr[d0]=*reinterpret_cast<const bf16x8*>(&Qw[(long)r32*QP+d0*16+hi*8]);
  const f32x16 zero16=f32x16{}; float mhat=0.f,l_reg=0.f;f32x16 o[ND];
  #pragma unroll
  for(int d_=0;d_<ND;++d_)o[d_]=f32x16{};
  const int qrel=wid*QBLK+r32;
  #define CMASK(P0,P1,t) do{int jb_=(t)-(NT-4); if(jb_>=0){ if constexpr(MODE==0)cmask(P0,P1,jb_,qrel,hi); else chmask(P0,P1,jb_,wid);} }while(0)
  bool resc=false;
  #define START(P0,P1) do{ resc=false; \
    _Pragma("unroll") for(int r=0;r<16;++r)P0[r]=__builtin_amdgcn_exp2f(P0[r]); }while(0)
  #define RESC() do{ if(resc){ asm volatile("s_waitcnt lgkmcnt(0)":::"memory"); \
      _Pragma("unroll") for(int d_=0;d_<ND;++d_) _Pragma("unroll") for(int r=0;r<16;++r)o[d_][r]*=wsf[crow(r,hi)]; } }while(0)
  f32x16 pA0,pA1,pB0,pB1;
  int sl_prev=0,sl_cur=0,sl_next=SLOTB;
  #define ROT() do{sl_prev=sl_cur;sl_cur=sl_next;sl_next=(sl_next==(NSLOT-1)*SLOTB)?0:sl_next+SLOTB;}while(0)
  DMA_K(2,2*SLOTB);
  #define WB(n0,n1) do{ if constexpr(MODE==1){WAIT_BAR(n1);} else {WAIT_BAR(n0);} }while(0)
  WB(3,4);
  if constexpr(MODE==0){ if constexpr(!UREF) mhat=((lds_fptr)(shm3+LDS_FB))[q0-t0*KVBLK+wid*QBLK+r32]+8.0f;
    _Pragma("unroll") for(int g=0;g<4;++g){bias4(pA0,fb0,g);if constexpr(!UREF)sub4(pA0,g,mhat);bias4(pA1,fb0+32,g);if constexpr(!UREF)sub4(pA1,g,mhat);} }
  else { pA0=f32x16{}; pA1=f32x16{}; }
  qkt_acc(pA0,pA1,Kbase,qr,r32,hi);
  asm volatile("s_nop 15\n\ts_nop 7":"+v"(pA0),"+v"(pA1));CMASK(pA0,pA1,0);
  START(pA0,pA1);
  if constexpr(MODE==0){ _Pragma("unroll") for(int g=0;g<4;++g){bias4(pB0,fb0+64,g);if constexpr(!UREF)sub4(pB0,g,mhat);bias4(pB1,fb0+96,g);if constexpr(!UREF)sub4(pB1,g,mhat);} }

  _Pragma("unroll") for(int r=0;r<16;++r)pA1[r]=__builtin_amdgcn_exp2f(pA1[r]);
  WAIT_BAR(0);
  DMA_K(3,0);DMA_V(1,SLOTB);
  ROT();
  kload8(kf,kp0+sl_cur);
  WB(2,3);
  s16x4 vlo[8],vhi[8]; u32x4 pw0,pw1,pw2,pw3;
  #define PKW(P,B) cvtpk_s(P[B],P[B+1])
  #define PAF(k) __builtin_bit_cast(bf16x8,pw##k)
  #define VFR(i) (bf16x8){vlo[i][0],vlo[i][1],vlo[i][2],vlo[i][3],vhi[i][0],vhi[i][1],vhi[i][2],vhi[i][3]}
  #define PIN(x) asm volatile("":"+v"(x))
  #define MX3(a,b,c) __builtin_fmaxf(__builtin_fmaxf((a),(b)),(c))
  #define GAPA(MF,A0,A1,A2,A3,W0,W1,PW) do{ MF; sacc+=A0; sacc+=A1; sacc+=A2; sacc+=A3; PIN(sacc); W0; W1; PIN(PW); SBAR(); }while(0)
  #define EX(v) __builtin_amdgcn_exp2f(v)
  #define GAPB(MF,X,B) do{ MF; X[B]=EX(X[B]); X[B+1]=EX(X[B+1]); X[B+2]=EX(X[B+2]); X[B+3]=EX(X[B+3]); PIN(X); SBAR(); }while(0)
  #define VRD(i) do{ vlo[i]=vtr(vp_+(((i)>>2)*4096+((i)&3)*1024)); vhi[i]=vtr(vp_+(((i)>>2)*4096+((i)&3)*1024+512)); }while(0)
  #define KRD(G,j) do{ if(G){ kload2(kf,kp0+sl_next,j); SBAR(); } }while(0)
  #define CIN(X) (MODE==1?zero16:X)
  #define GAPB2(MF,RD,X,B) do{ MF; RD; X[B]=EX(X[B]); X[B+1]=EX(X[B+1]); PIN(X); SBAR(); }while(0)
  #define VF(k) do{ vlo[(k)&3]=vtr(vp_+(((k)>>3)*8192+((k)&1)*4096+(((k)&7)>>1)*1024)); vhi[(k)&3]=vtr(vp_+(((k)>>3)*8192+((k)&1)*4096+(((k)&7)>>1)*1024+512)); }while(0)
  #define VRDA(i) do{ if constexpr(MODE==0){ VRD(i); } else { if((i)==2){VF(0);} else if((i)==6){VF(1);} else if((i)==3){VF(2);} else if((i)==7){VF(3);} } }while(0)
  #define VFQ(q) (bf16x8){vlo[q][0],vlo[q][1],vlo[q][2],vlo[q][3],vhi[q][0],vhi[q][1],vhi[q][2],vhi[q][3]}
  #define PFM(G,P,g) do{ (void)nm_; }while(0)
  #define PFR(G,P,i,t) do{ if constexpr(MODE==0){ if(G){ bias4(P,fb0+64*((t)+1)+32*((i)>>2),(i)&3); } } }while(0)
  #define PFS(G,P,i) do{ if constexpr(MODE==0&&!UREF){ if(G){ sub4(P,(i)&3,mhat); PIN(P); } } }while(0)
  #define STEP(C0,C1,P0,P1,t,GK,GV,GL) do{ SBAR(); \
    const lds_cptr vp_=vp0+VM*sl_prev; \
    VRDA(0); SBAR(); float sacc=(P0[0]+P0[1]); \
    GAPA(C0=__builtin_amdgcn_mfma_f32_32x32x16_bf16(kf[0],qr[0],CIN(C0),0,0,0), P0[2],P0[3],P0[4],P0[5],     pw0[0]=PKW(P0,0), pw0[1]=PKW(P0,2), pw0); \
    VRDA(4); SBAR(); GAPA(C1=__builtin_amdgcn_mfma_f32_32x32x16_bf16(kf[1],qr[0],CIN(C1),0,0,0), P0[6],P0[7],P0[8],P0[9],     pw0[2]=PKW(P0,4), pw0[3]=PKW(P0,6), pw0); \
    PFR(GL,P0,0,t); VRDA(1); SBAR(); GAPA(C0=__builtin_amdgcn_mfma_f32_32x32x16_bf16(kf[2],qr[1],C0,0,0,0),   P0[10],P0[11],P0[12],P0[13], pw1[0]=PKW(P0,8), pw1[1]=PKW(P0,10), pw1); \
    PFR(GL,P0,1,t); VRDA(5); SBAR(); GAPA(C1=__builtin_amdgcn_mfma_f32_32x32x16_bf16(kf[3],qr[1],C1,0,0,0),   P0[14],P0[15],P1[0],P1[1],   pw1[2]=PKW(P0,12),pw1[3]=PKW(P0,14), pw1); \
    PFR(GL,P0,2,t); VRDA(2); SBAR(); GAPA(C0=__builtin_amdgcn_mfma_f32_32x32x16_bf16(kf[4],qr[2],C0,0,0,0),   P1[2],P1[3],P1[4],P1[5],     pw2[0]=PKW(P1,0), pw2[1]=PKW(P1,2), pw2); \
    PFR(GL,P0,3,t); VRDA(6); SBAR(); GAPA(C1=__builtin_amdgcn_mfma_f32_32x32x16_bf16(kf[5],qr[2],C1,0,0,0),   P1[6],P1[7],P1[8],P1[9],     pw2[2]=PKW(P1,4), pw2[3]=PKW(P1,6), pw2); \
    PFR(GL,P1,4,t); VRDA(3); SBAR(); GAPA(C0=__builtin_amdgcn_mfma_f32_32x32x16_bf16(kf[6],qr[3],C0,0,0,0),   P1[10],P1[11],P1[12],P1[13], pw3[0]=PKW(P1,8), pw3[1]=PKW(P1,10), pw3); \
    PFR(GL,P1,5,t); VRDA(7); SBAR(); GAPA(C1=__builtin_amdgcn_mfma_f32_32x32x16_bf16(kf[7],qr[3],C1,0,0,0),   P1[14],P1[15],0.f,0.f,       pw3[2]=PKW(P1,12),pw3[3]=PKW(P1,14), pw3); \
    l_reg+=sacc; \
    if(GK){DMA_K((t)+3,sl_cur);} if(GV){DMA_V((t)+1,sl_next);} \
    CMASK(C0,C1,t); \
    resc=false; \
    if constexpr(false)   \
    { float a=MX3(C0[0],C0[1],C1[0]),b=MX3(C0[2],C0[3],C1[1]); a=MX3(a,C1[2],C1[3]); \
      _Pragma("unroll") for(int r=4;r<16;r+=4){a=MX3(a,C0[r],C0[r+1]);b=MX3(b,C0[r+2],C0[r+3]);a=MX3(a,C1[r],C1[r+1]);b=MX3(b,C1[r+2],C1[r+3]);} \
      float rm=__builtin_fmaxf(a,b); { auto rr=__builtin_amdgcn_permlane32_swap(__float_as_uint(rm),__float_as_uint(rm),false,false); rm=__builtin_fmaxf(__uint_as_float(rr[0]),__uint_as_float(rr[1])); } \
      resc=false; \
      if(__builtin_expect(__any(rm>(float)THRL),0)){ const float dl=__builtin_fmaxf(rm,0.f); mhat+=dl; \
        _Pragma("unroll") for(int r=0;r<16;++r){C0[r]-=dl;C1[r]-=dl;} \
        const float f=__builtin_amdgcn_exp2f(-dl); l_reg*=f; if(hi==0)wsf[r32]=f; resc=true; } } \
    SBAR(); \
    if constexpr(MODE==0){ \
    PFR(GL,P1,6,t); PFS(GL,P0,0); PFS(GL,P0,1); GAPB(o[0]=__builtin_amdgcn_mfma_f32_32x32x16_bf16(PAF(0),VFR(0),o[0],0,0,0), C0,0); \
    PFR(GL,P1,7,t); PFS(GL,P0,2); PFS(GL,P0,3); GAPB(o[1]=__builtin_amdgcn_mfma_f32_32x32x16_bf16(PAF(0),VFR(4),o[1],0,0,0), C0,4); \
    PFS(GL,P1,4); KRD(GL,0); GAPB(o[0]=__builtin_amdgcn_mfma_f32_32x32x16_bf16(PAF(1),VFR(1),o[0],0,0,0), C0,8); \
    PFS(GL,P1,5); KRD(GL,1); GAPB(o[1]=__builtin_amdgcn_mfma_f32_32x32x16_bf16(PAF(1),VFR(5),o[1],0,0,0), C0,12); \
    PFS(GL,P1,6); KRD(GL,2); GAPB(o[0]=__builtin_amdgcn_mfma_f32_32x32x16_bf16(PAF(2),VFR(2),o[0],0,0,0), C1,0); \
    PFS(GL,P1,7); KRD(GL,3); GAPB(o[1]=__builtin_amdgcn_mfma_f32_32x32x16_bf16(PAF(2),VFR(6),o[1],0,0,0), C1,4); \
    GAPB(o[0]=__builtin_amdgcn_mfma_f32_32x32x16_bf16(PAF(3),VFR(3),o[0],0,0,0), C1,8); \
    GAPB(o[1]=__builtin_amdgcn_mfma_f32_32x32x16_bf16(PAF(3),VFR(7),o[1],0,0,0), C1,12); \
    } else { \
    const float nm_=-mhat; \
    GAPB2(o[0]=__builtin_amdgcn_mfma_f32_32x32x16_bf16(PAF(0),VFQ(0),o[0],0,0,0), VF(4), C0,0); \
    GAPB2(o[1]=__builtin_amdgcn_mfma_f32_32x32x16_bf16(PAF(0),VFQ(1),o[1],0,0,0), VF(5), C0,2); \
    KRD(GL,0); GAPB2(o[0]=__builtin_amdgcn_mfma_f32_32x32x16_bf16(PAF(1),VFQ(2),o[0],0,0,0), VF(6), C0,4); \
    KRD(GL,1); GAPB2(o[1]=__builtin_amdgcn_mfma_f32_32x32x16_bf16(PAF(1),VFQ(3),o[1],0,0,0), VF(7), C0,6); \
    KRD(GL,2); GAPB2(o[0]=__builtin_amdgcn_mfma_f32_32x32x16_bf16(PAF(2),VFQ(0),o[0],0,0,0), VF(8), C0,8); \
    KRD(GL,3); GAPB2(o[1]=__builtin_amdgcn_mfma_f32_32x32x16_bf16(PAF(2),VFQ(1),o[1],0,0,0), VF(9), C0,10); \
    GAPB2(o[0]=__builtin_amdgcn_mfma_f32_32x32x16_bf16(PAF(3),VFQ(2),o[0],0,0,0), VF(10), C0,12); \
    GAPB2(o[1]=__builtin_amdgcn_mfma_f32_32x32x16_bf16(PAF(3),VFQ(3),o[1],0,0,0), VF(11), C0,14); \
    GAPB2(o[2]=__builtin_amdgcn_mfma_f32_32x32x16_bf16(PAF(0),VFQ(0),o[2],0,0,0), VF(12); PFM(GL,P0,0), C1,0); \
    GAPB2(o[3]=__builtin_amdgcn_mfma_f32_32x32x16_bf16(PAF(0),VFQ(1),o[3],0,0,0), VF(13); PFM(GL,P0,1), C1,2); \
    GAPB2(o[2]=__builtin_amdgcn_mfma_f32_32x32x16_bf16(PAF(1),VFQ(2),o[2],0,0,0), VF(14); PFM(GL,P0,2), C1,4); \
    GAPB2(o[3]=__builtin_amdgcn_mfma_f32_32x32x16_bf16(PAF(1),VFQ(3),o[3],0,0,0), VF(15); PFM(GL,P0,3), C1,6); \
    GAPB2(o[2]=__builtin_amdgcn_mfma_f32_32x32x16_bf16(PAF(2),VFQ(0),o[2],0,0,0), (void)0; PFM(GL,P1,0), C1,8); \
    GAPB2(o[3]=__builtin_amdgcn_mfma_f32_32x32x16_bf16(PAF(2),VFQ(1),o[3],0,0,0), (void)0; PFM(GL,P1,1), C1,10); \
    GAPB2(o[2]=__builtin_amdgcn_mfma_f32_32x32x16_bf16(PAF(3),VFQ(2),o[2],0,0,0), (void)0; PFM(GL,P1,2), C1,12); \
    GAPB2(o[3]=__builtin_amdgcn_mfma_f32_32x32x16_bf16(PAF(3),VFQ(3),o[3],0,0,0), (void)0; PFM(GL,P1,3), C1,14); \
    } \
    }while(0)
  int t=1;
  #undef CMASK
  #define CMASK(P0,P1,t) do{}while(0)
  for(;t+5<NT;t+=2){
    STEP(pB0,pB1,pA0,pA1,t,true,true,true);     WB(2,3); RESC(); ROT();
    STEP(pA0,pA1,pB0,pB1,t+1,true,true,true);   WB(2,3); RESC(); ROT();
  }
  #undef CMASK
  #define CMASK(P0,P1,t) do{int jb_=(t)-(NT-4); if(jb_>=0){ if constexpr(MODE==0)cmask(P0,P1,jb_,qrel,hi); else chmask(P0,P1,jb_,wid);} }while(0)
  #define ENDW(tt) do{ if((tt)+3<NT){WB(2,3);} else if((tt)+2<NT){WB(1,2);} else {WAIT_BAR(0);} }while(0)
  for(;t+1<NT;t+=2){
    STEP(pB0,pB1,pA0,pA1,t,(t+3<NT),(t+1<NT),(t+1<NT));       ENDW(t);   RESC(); ROT();
    STEP(pA0,pA1,pB0,pB1,t+1,(t+4<NT),(t+2<NT),(t+2<NT));     ENDW(t+1); RESC(); ROT();
  }
  STEP(pB0,pB1,pA0,pA1,NT-1,false,false,false); RESC();
  { float sacc=pB0[0]+pB0[1]; _Pragma("unroll") for(int r=2;r<16;++r)sacc+=pB0[r]; _Pragma("unroll") for(int r=0;r<16;++r)sacc+=pB1[r]; l_reg+=sacc;
    pw0=(u32x4){PKW(pB0,0),PKW(pB0,2),PKW(pB0,4),PKW(pB0,6)};pw1=(u32x4){PKW(pB0,8),PKW(pB0,10),PKW(pB0,12),PKW(pB0,14)};pw2=(u32x4){PKW(pB1,0),PKW(pB1,2),PKW(pB1,4),PKW(pB1,6)};pw3=(u32x4){PKW(pB1,8),PKW(pB1,10),PKW(pB1,12),PKW(pB1,14)};
    SBAR(); pv<ND>(o,vb0+VM*sl_cur,PAF(0),PAF(1),PAF(2),PAF(3)); }
  #undef PKW
  #undef PAF
  #undef VFR
  #undef PIN
  #undef MX3
  #undef GAPA
  #undef GAPB
  #undef EX
  #undef VRD
  #undef KRD
  #undef STEP
  #undef CIN
  #undef PFR
  #undef PFS
  #undef GAPB2
  #undef VF
  #undef VRDA
  #undef VFQ
  #undef PFM
  #undef WB
  #undef ENDW
  {auto rr=__builtin_amdgcn_permlane32_swap(__float_as_uint(l_reg),__float_as_uint(l_reg),false,false);l_reg=__uint_as_float(rr[0])+__uint_as_float(rr[1]);}
  if(hi==0)wsf[32+r32]=l_reg;asm volatile("s_waitcnt lgkmcnt(0)":::"memory");
  float rli[16];
  #pragma unroll
  for(int r=0;r<16;++r)rli[r]=__builtin_amdgcn_rcpf(wsf[32+crow(r,hi)]);
  epi(o,rli,shm,q0,wid,lane,r32,hi);
  asm volatile("s_waitcnt lgkmcnt(0)\n\ts_barrier":::"memory");
  #undef DMA_K
  #undef DMA_V
  #undef CMASK
  #undef START
  #undef RESC
  #undef ROT
}

typedef unsigned u32x2q __attribute__((ext_vector_type(2)));
__device__ __forceinline__ unsigned q4i8(float a,float b,float c,float d){ unsigned w=__builtin_amdgcn_cvt_pk_u8_f32((a+128.f),0,0u); w=__builtin_amdgcn_cvt_pk_u8_f32((b+128.f),1,w); w=__builtin_amdgcn_cvt_pk_u8_f32((c+128.f),2,w); w=__builtin_amdgcn_cvt_pk_u8_f32((d+128.f),3,w); return w^0x80808080u; }
constexpr float QMIX=127.f/4.f;
struct EpiFox {
  bf16*O;
  __device__ __forceinline__ void operator()(const f32x16(&o)[2],const float(&rli)[16],char*shm,int q0,int wid,int lane,int r32,int hi)const{
    signed char*Ow=(signed char*)O+(long)(q0+wid*QBLK)*OP; signed char*stg=(signed char*)(shm+LDS_OST)+wid*2048;
    #pragma unroll
    for(int r=0;r<16;++r){const int orow=crow(r,hi);
      #pragma unroll
      for(int d0=0;d0<2;++d0)stg[orow*64+d0*32+r32]=(signed char)__float2int_rn(fminf(fmaxf(o[d0][r]*rli[r]*QMIX,-127.f),127.f));}
    asm volatile("s_waitcnt lgkmcnt(0)":::"memory");
    #pragma unroll
    for(int i=0;i<4;++i){const int row=i*8+(lane>>3),ch=lane&7; const u32x2q v=*(const u32x2q*)(stg+row*64+ch*8); *(u32x2q*)(Ow+(long)row*OP+ch*8)=v;} }
};
struct EpiDiff {
  bf16*O; const float*gsub; float lam; int map;
  __device__ __forceinline__ void operator()(const f32x16(&o)[4],const float(&rli)[16],char*shm,int q0,int wid,int lane,int r32,int hi)const{
    bf16*Y=(bf16*)(shm+LDS_Y)+wid*4096;
    if(map==0){
      #pragma unroll
      for(int r=0;r<16;++r){const int orow=crow(r,hi);
        #pragma unroll
        for(int d0=0;d0<4;++d0)Y[orow*128+d0*32+r32]=__float2bfloat16(o[d0][r]*rli[r]);}
    } else {
      #pragma unroll
      for(int r=0;r<16;++r){const int orow=crow(r,hi);
        #pragma unroll
        for(int d0=0;d0<4;++d0){const int idx=orow*128+d0*32+r32; Y[idx]=__float2bfloat16(__bfloat162float(Y[idx])-lam*(o[d0][r]*rli[r]));}}
      asm volatile("s_waitcnt lgkmcnt(0)":::"memory");
      signed char*Ow=(signed char*)O+(long)(q0+wid*QBLK)*OP;
      #pragma unroll
      for(int i=0;i<8;++i){const int row=i*4+(lane>>4),ch=lane&15; const u32x4 v=*(const u32x4*)(Y+row*128+ch*8);
        float f[8];
        #pragma unroll
        for(int e=0;e<4;++e){f[2*e]=__builtin_bit_cast(float,v[e]<<16);f[2*e+1]=__builtin_bit_cast(float,v[e]&0xffff0000u);}
        float ss=0.f;
        #pragma unroll
        for(int e=0;e<8;++e)ss+=f[e]*f[e];
        ss+=__shfl_xor(ss,1);ss+=__shfl_xor(ss,2);ss+=__shfl_xor(ss,4);ss+=__shfl_xor(ss,8);
        const float rinv=rsqrtf(ss*(1.f/128.f)+1e-6f)*0.8f;
        const f32x4v g0=*(const f32x4v*)(gsub+ch*8),g1=*(const f32x4v*)(gsub+ch*8+4);
        const float rq=rinv*QMIX; u32x2q w; w[0]=q4i8(f[0]*rq*g0[0],f[1]*rq*g0[1],f[2]*rq*g0[2],f[3]*rq*g0[3]); w[1]=q4i8(f[4]*rq*g1[0],f[5]*rq*g1[1],f[6]*rq*g1[2],f[7]*rq*g1[3]);
        *(u32x2q*)(Ow+(long)row*OP+ch*8)=w; }
    }
  }
};
#undef SBAR
#undef WAIT_BAR
}

__device__ __forceinline__ void attn_phase(const P& p, char* lds, int c, int G) {
    using attn_body::QP; using attn_body::OP; using attn_body::LDS_FB; using attn_body::EpiDiff; using attn_body::EpiFox; using attn_body::attn_unit;
    const int tid = tid_fresh(), lane = tid & 63;
    const int vcu = (G % 8 == 0) ? (c % 8) * (G / 8) + c / 8 : c;
    const attn_body::bf16* QKV = (const attn_body::bf16*)(p.ws + WS_R); attn_body::bf16* MIX = (attn_body::bf16*)(p.ws + WS_H);
    const float lam = ((const float*)(p.ws + WS_SCAL))[0];
    const float* FB = (const float*)(p.ws + WS_F);
    for (int item = vcu; item < 256; item += G) {
        const int bh = item >> 3, s = item & 7, b = bh >> 2, h = bh & 3;
        const attn_body::bf16* base = QKV + (size_t)b * SEQ * QP;
        for (int qi = 0; qi < 2; ++qi) { const int qb = qi ? s : 15 - s;
            for (int map = 0; map < 2; ++map) {
                const EpiDiff E{(attn_body::bf16*)((signed char*)MIX + (size_t)b * SEQ * OP + h * 128), p.g_subln, lam, map};
                attn_unit<8, 1>(qb, 0, base + (2 * h + map) * 64, base + 512 + (2 * h + map) * 64, base + 1024 + h * 128, lds, E);
                if (qi == 0) { const int nr = (CV_ITEMS - CV_IN + G * 8 - 1) / (G * 8), hr = (nr + 1) / 2;
                    convert_items(p, (unsigned char*)lds, c, G, CV_IN, CV_ITEMS, map ? hr : 0, map ? nr : hr); } } }
    }
    {
        unsigned* ctl = (unsigned*)(p.ws + WS_CTL); volatile int* ubox = (volatile int*)(lds + LDS_FB + 16384);
        const int nb_q = (G % 8 == 0) ? 1 : 8;
        for (int bi = 0; bi < nb_q; ++bi) { const int b = (G % 8 == 0) ? (c % 8) : bi;
            for (;;) {
                if (tid == 0) *ubox = (int)atomicAdd(ctl + CW_FOXQ + 64 * b, 1u);
                __syncthreads();
                const int u = __builtin_amdgcn_readfirstlane(*ubox);
                __syncthreads();
                if (u >= 128) break;
                const int qb = 15 - (u >> 3), h = u & 7;
                const float* Fg = FB + (size_t)(b * 8 + h) * SEQ; const unsigned* nr = ctl + CW_NORM + (b * 8 + h) * 4;
                const float qn = sqrtf(__uint_as_float(nr[0]) + __uint_as_float(nr[1])), kn = sqrtf(__uint_as_float(nr[2]) + __uint_as_float(nr[3]));
                const int* sm = (const int*)ctl + CW_SMIN + ((b * 8 + h) * 16 + qb) * 2; const int s0 = sm[0], s1 = sm[1];
                const float sself = __int_as_float(s0 >= 0 ? s0 : s0 ^ 0x7fffffff) + __int_as_float(s1 >= 0 ? s1 : s1 ^ 0x7fffffff);
                const float bound = 1.03f * qn * kn - sself;
                float drop = lane < 4 * qb ? 64.f * __builtin_amdgcn_exp2f(bound + (Fg[64 * lane + 63] - Fg[256 * qb])) : 0.f;
#pragma unroll
                for (int o = 1; o < 64; o <<= 1) { const float t = __shfl_up(drop, o); if (lane >= o) drop += t; }
                const bool skip = lane < 4 * qb && drop < 5.9604645e-8f;
                const int t0 = __builtin_amdgcn_readfirstlane(__builtin_popcountll(__ballot(skip)) & ~1);
                const attn_body::bf16* base = QKV + (size_t)b * SEQ * QP;
                float* fb = (float*)(lds + LDS_FB); const int nk = (qb + 1) * 256 - 64 * t0;
                const EpiFox E{(attn_body::bf16*)((signed char*)MIX + (size_t)b * SEQ * OP + 512 + h * 64)};
                const float fend = Fg[256 * qb + 255], fbeg = Fg[256 * qb];
                if (__builtin_amdgcn_readfirstlane((int)(fend - fbeg < 64.f))) {
                    const float ref = fend + 8.f;
                    for (int i = tid; i < nk; i += 512) fb[i] = Fg[64 * t0 + i] - ref;
                    attn_unit<16, 0, EpiFox, true>(qb, t0, base + 1536 + h * 64, base + 2048 + h * 64, base + 2560 + h * 64, lds, E);
                } else {
                    for (int i = tid; i < nk; i += 512) fb[i] = Fg[64 * t0 + i];
                    attn_unit<16, 0, EpiFox, false>(qb, t0, base + 1536 + h * 64, base + 2048 + h * 64, base + 2560 + h * 64, lds, E);
                }
            }
        }
    }
}

#ifndef MK_N_LAUNCHES
#define MK_N_LAUNCHES 1
#endif
constexpr int N_PHASES = 9;
#define REP_PRO 1
#define REP_NORM1 1
#define REP_INPROJ 1
#define REP_ATTN 1
#define REP_OUTPROJ 1
#define REP_MOE1 1
#define REP_MOE2 1
#define REPEAT(n) _Pragma("nounroll") for (int r_ = 0; r_ < (n); ++r_)
struct Args { P p; int ph_lo, ph_hi; };
__global__ void __launch_bounds__(512, 2) mega(Args a) {
    extern __shared__ __attribute__((aligned(16))) unsigned char lds[];
    const P& p = a.p;
    PG8_LAS unsigned char* l3 = (PG8_LAS unsigned char*)lds;
    const int G = (int)gridDim.x, c = (int)blockIdx.x;
    volatile LAS unsigned* MISC = (volatile LAS unsigned*)(l3 + MISC_OFF);
    if (threadIdx.x < 32) MISC[threadIdx.x] = 0u;
    __syncthreads();
    XcdBarrier bar; bar.bar = (unsigned*)(p.ws + WS_CTL) + CW_BAR; bar.x = 0; bar.st = nullptr;
    if (MK_N_LAUNCHES == 1) bar = xcd_barrier_post((unsigned*)(p.ws + WS_CTL) + CW_BAR, MISC + 8);
    const int lo = a.ph_lo, hi = a.ph_hi;
#define IN(k) (lo <= (k) && (k) < hi)
#define SEAM(k) do { if (IN(k) && IN((k) + 1)) xcd_barrier(bar); } while (0)
    if (IN(0)) { REPEAT(REP_PRO) { prologue_phase(p, lds, c, G); __syncthreads(); } } SEAM(0);
    if (IN(1)) { REPEAT(REP_NORM1) { norm1_phase(p, lds, c, G); __syncthreads(); } } SEAM(1);
    if (IN(2)) { scan_phase(p, (float*)(lds + 1024), c, G); __syncthreads(); REPEAT(REP_INPROJ) inproj_phase(p, l3, c, G); } SEAM(2);
    if (IN(3)) { REPEAT(REP_ATTN) attn_phase(p, (char*)lds, c, G); } SEAM(3);
    if (IN(4)) { REPEAT(REP_OUTPROJ) outproj_phase(p, l3, c, G); } SEAM(4);
    if (IN(5)) { router_phase(p, lds, c, G); } SEAM(5);
    if (IN(6)) { moe1_phase(p, l3, c, G); moe2_phase(p, l3, c, G); }
    SEAM(7);
    if (IN(8)) { final_phase(p, c, G); }
#undef IN
#undef SEAM
}
}

extern "C" void kernel_launch(void* const* d_in, const int* in_sizes, int n_in, void* d_out, int out_size, void* d_ws, size_t ws_size, hipStream_t stream) {
    if (n_in != 23 || out_size != T * D || ws_size < WS_END) { fprintf(stderr, "kernel_launch: unexpected shapes (n_in %d, out %d, ws %zu)\n", n_in, out_size, ws_size); return; }
    static int grid = 0;
    if (grid == 0) {
        int dev = 0, cus = 0, per_cu = 0;
        if (hipGetDevice(&dev) != hipSuccess || hipDeviceGetAttribute(&cus, hipDeviceAttributeMultiprocessorCount, dev) != hipSuccess) { fprintf(stderr, "kernel_launch: device query failed\n"); grid = -1; return; }
        if (hipFuncSetAttribute((const void*)mega, hipFuncAttributeMaxDynamicSharedMemorySize, LDS_BYTES) != hipSuccess) { fprintf(stderr, "kernel_launch: hipFuncSetAttribute failed\n"); grid = -1; return; }
        if (hipOccupancyMaxActiveBlocksPerMultiprocessor(&per_cu, (const void*)mega, 512, LDS_BYTES) != hipSuccess || per_cu < 1) fprintf(stderr, "kernel_launch: note: occupancy query reports %d workgroups per CU\n", per_cu);
        (void)hipGetLastError();
        grid = cus;
    }
    if (grid < 0) return;
    (void)hipMemsetAsync((char*)d_ws + WS_CTL, 0, CTL_BYTES, stream);
    Args a{};
    const float** f = (const float**)&a.p;
    for (int i = 0; i < 23; ++i) f[i] = (const float*)d_in[i];
    a.p.out = (float*)d_out; a.p.ws = (unsigned char*)d_ws;
    if (MK_N_LAUNCHES == 1) { a.ph_lo = 0; a.ph_hi = N_PHASES; hipLaunchKernelGGL(mega, dim3(grid), dim3(512), LDS_BYTES, stream, a); }
    else for (int k = 0; k < N_PHASES; ++k) { a.ph_lo = k; a.ph_hi = k + 1; hipLaunchKernelGGL(mega, dim3(grid), dim3(512), LDS_BYTES, stream, a); }
}
```

```cpp
#include <hip/hip_runtime.h>
#include <hip/hip_bf16.h>
#include <cstdio>
#include <cstdint>
#include <cmath>

namespace {
constexpr int NB = 8, SEQ = 4096, T = NB * SEQ, D = 1024, NQKV = 3072, INC = 3080, NE = 32, DE = 512;
constexpr float EPS = 1e-6f;
constexpr size_t MiB = 1u << 20;
constexpr size_t WS_CTL = 0, CTL_BYTES = 65536;
constexpr size_t WS_MOD = 1 * MiB;
constexpr size_t WS_SCAL = WS_MOD + 256 * 1024;
constexpr size_t WS_WF = WS_MOD + 512 * 1024;
constexpr size_t WS_ROPE = 2 * MiB;
constexpr size_t WS_LOGF = 3 * MiB;
constexpr size_t WS_F = 4 * MiB;
constexpr size_t WS_TOKE = 5 * MiB;
constexpr size_t WS_TOKW = WS_TOKE + 256 * 1024;
constexpr size_t WS_LIST = 6 * MiB;
constexpr size_t WS_WIN = 10 * MiB;
constexpr size_t WS_WOUT = 16 * MiB;
constexpr size_t WS_WGU = 18 * MiB;
constexpr size_t WS_WD = 82 * MiB;
constexpr size_t WS_H = 114 * MiB;
constexpr size_t WS_R = 178 * MiB;
constexpr size_t WS_ACT = WS_R + 192 * MiB;
constexpr size_t WS_X1 = WS_ACT + 72 * MiB;
constexpr size_t WS_END = WS_X1 + 64 * MiB;

typedef unsigned short bf16;
typedef unsigned v4u __attribute__((ext_vector_type(4)));
typedef unsigned v2u __attribute__((ext_vector_type(2)));
typedef float f32x4 __attribute__((ext_vector_type(4)));

__device__ __forceinline__ unsigned f2bf(float f) { unsigned u = __builtin_bit_cast(unsigned, f); return (u + 0x7fffu + ((u >> 16) & 1u)) >> 16; }
typedef float pk2f_t __attribute__((ext_vector_type(2))); typedef __bf16 pk2b_t __attribute__((ext_vector_type(2)));
__device__ __forceinline__ unsigned pk2(float lo, float hi) { const pk2f_t v = {lo, hi}; return __builtin_bit_cast(unsigned, __builtin_convertvector(v, pk2b_t)); }
__device__ __forceinline__ float bf2f(unsigned short b) { return __builtin_bit_cast(float, (unsigned)b << 16); }
__device__ __forceinline__ float bflo(unsigned w) { return __builtin_bit_cast(float, w << 16); }
__device__ __forceinline__ float bfhi(unsigned w) { return __builtin_bit_cast(float, w & 0xffff0000u); }
__device__ __forceinline__ float wave_sum(float v) {
#pragma unroll
    for (int o = 1; o < 64; o <<= 1) v += __shfl_xor(v, o);
    return v;
}
__device__ __forceinline__ float wave_max(float v) {
#pragma unroll
    for (int o = 1; o < 64; o <<= 1) v = fmaxf(v, __shfl_xor(v, o));
    return v;
}
__device__ __forceinline__ int tid_fresh() { int t = threadIdx.x; asm volatile("" : "+v"(t)); return t; }
__device__ __forceinline__ float siluf(float v) { return v / (1.f + __expf(-v)); }

struct P {
    const float *x, *c, *w_ada, *b_ada, *g_pre_attn, *g_post_attn, *w_in, *b_forget, *lq1, *lk1, *lq2, *lk2, *g_subln, *w_out, *g_pre_ffn, *g_post_ffn,
        *w_group, *b_group, *w_router, *b_router, *w_gate, *w_up, *w_down;
    float* out; unsigned char* ws;
};

__device__ __forceinline__ void transpose_item(const float* W, int ldw, int K, bf16* WT, int k0, int n0, int dst_row0, float* scr, int lane) {
#pragma unroll 8
    for (int i = 0; i < 32; ++i) { const int kk = 2 * i + (lane >> 5); scr[kk * 33 + (lane & 31)] = __builtin_nontemporal_load(W + (size_t)(k0 + kk) * ldw + n0 + (lane & 31)); }
    __builtin_amdgcn_s_waitcnt(0xc07f); asm volatile("" ::: "memory");
    const int c = lane & 7;
#pragma unroll
    for (int j = 0; j < 4; ++j) { const int n = (lane >> 3) + 8 * j; const float* s = scr + (8 * c) * 33 + n;
        v4u o; o.x = pk2(s[0 * 33], s[1 * 33]); o.y = pk2(s[2 * 33], s[3 * 33]); o.z = pk2(s[4 * 33], s[5 * 33]); o.w = pk2(s[6 * 33], s[7 * 33]);
        *(v4u*)(WT + (size_t)(dst_row0 + n) * K + k0 + 8 * c) = o; }
    __builtin_amdgcn_s_waitcnt(0xc07f); asm volatile("" ::: "memory");
}

constexpr float Q8_ACT = 127.f / 6.f, Q8_W = 127.f / 0.14f;
constexpr float Q8_ACT2 = 127.f / 8.f, Q8_WD = 127.f / 0.2f;
constexpr float Q8_MIX = 127.f / 4.f;
__device__ __forceinline__ unsigned pk4_i8(float a, float b, float c, float d, float s) {
    unsigned w = __builtin_amdgcn_cvt_pk_u8_f32(__builtin_fmaf(a, s, 128.f), 0, 0u); w = __builtin_amdgcn_cvt_pk_u8_f32(__builtin_fmaf(b, s, 128.f), 1, w);
    w = __builtin_amdgcn_cvt_pk_u8_f32(__builtin_fmaf(c, s, 128.f), 2, w); w = __builtin_amdgcn_cvt_pk_u8_f32(__builtin_fmaf(d, s, 128.f), 3, w); return w ^ 0x80808080u; }
__device__ __forceinline__ void transpose_item_i8(const float* W, int ldw, int Kp, unsigned char* WT8, int k0, int n0, int dst_row0, float* scr, int lane, float qs) {
#pragma unroll 8
    for (int i = 0; i < 32; ++i) { const int kk = 2 * i + (lane >> 5); scr[kk * 33 + (lane & 31)] = __builtin_nontemporal_load(W + (size_t)(k0 + kk) * ldw + n0 + (lane & 31)); }
    __builtin_amdgcn_s_waitcnt(0xc07f); asm volatile("" ::: "memory");
    const int c = lane & 7;
#pragma unroll
    for (int j = 0; j < 4; ++j) { const int n = (lane >> 3) + 8 * j; const float* s = scr + (8 * c) * 33 + n;
        v2u o; o.x = pk4_i8(s[0 * 33], s[1 * 33], s[2 * 33], s[3 * 33], qs); o.y = pk4_i8(s[4 * 33], s[5 * 33], s[6 * 33], s[7 * 33], qs);
        *(v2u*)(WT8 + (size_t)(dst_row0 + n) * Kp + k0 + 8 * c) = o; }
    __builtin_amdgcn_s_waitcnt(0xc07f); asm volatile("" ::: "memory");
}
constexpr int CV_IN = 16 * 96, CV_OUT = 16 * 32, CV_G = 16 * 16, CV_D = 8 * 32, CV_E = 2 * CV_G + CV_D, CV_ITEMS = CV_IN + CV_OUT + NE * CV_E;
__device__ __forceinline__ void convert_items(const P& p, unsigned char* lds, int bid, int nblk, int it0, int it1, int k0, int k1) {
    const int tid = tid_fresh(), lane = tid & 63, wv = __builtin_amdgcn_readfirstlane(tid >> 6);
    unsigned char* WinT = p.ws + WS_WIN; unsigned char* WoutT = p.ws + WS_WOUT; unsigned char* WguT = p.ws + WS_WGU; unsigned char* WdT = p.ws + WS_WD;
    float* scr = (float*)(lds + wv * 8448);
    const int gw = bid * 8 + wv, ngw = nblk * 8;
    struct TrItem { const float* W; unsigned char* WT8; int ldw, Kp, k0, n0, dst_row0; float qs; };
    auto decode = [&](int r) __attribute__((always_inline)) -> TrItem {
        TrItem t;
        if (r < CV_IN) { const int kb = r / 96, nb = r % 96, n0 = 32 * nb, hh = n0 >> 6, hf = (n0 >> 5) & 1;
            const int fo = n0 - 1536 - (n0 >= 2048 ? 512 : 0);
            t.W = p.w_in; t.WT8 = WinT; t.ldw = INC; t.Kp = D; t.k0 = 64 * kb; t.n0 = n0; t.qs = Q8_W;
            t.dst_row0 = n0 < 1024 ? (hh >> 2) * 256 + hf * 128 + (hh & 3) * 32 : (n0 >= 1536 && n0 < 2560) ? (6 + (fo >> 7)) * 256 + (n0 >= 2048 ? 128 : 0) + (fo & 127) : n0; return t; }
        r -= CV_IN;
        if (r < CV_OUT) { const int kb = r / 32, nb = r % 32; t.W = p.w_out; t.WT8 = WoutT; t.ldw = D; t.Kp = D; t.k0 = 64 * kb; t.n0 = 32 * nb; t.dst_row0 = 32 * nb; t.qs = Q8_W; return t; }
        r -= CV_OUT;
        const int e = r / CV_E; r -= e * CV_E;
        if (r < 2 * CV_G) { const int half = r / CV_G; r -= half * CV_G; const int kb = r / 16, nb = r % 16, j0 = 32 * nb;
            t.W = (half ? p.w_up : p.w_gate) + (size_t)e * D * DE; t.WT8 = WguT + (size_t)e * D * D; t.ldw = DE; t.Kp = D; t.k0 = 64 * kb; t.n0 = j0; t.dst_row0 = (j0 >> 7) * 256 + half * 128 + (j0 & 127); t.qs = Q8_W; return t; }
        r -= 2 * CV_G;
        { const int kb = r / 32, nb = r % 32; t.W = p.w_down + (size_t)e * DE * D; t.WT8 = WdT + (size_t)e * D * DE; t.ldw = D; t.Kp = DE; t.k0 = 64 * kb; t.n0 = 32 * nb; t.dst_row0 = 32 * nb; t.qs = Q8_WD; return t; }
    };
    int it = it0 + gw + k0 * ngw;
    if (k0 < k1 && it < it1) {
        float v[32];
        TrItem cur = decode(it);
#pragma unroll
        for (int i = 0; i < 32; ++i) v[i] = __builtin_nontemporal_load(cur.W + (size_t)(cur.k0 + 2 * i + (lane >> 5)) * cur.ldw + cur.n0 + (lane & 31));
        for (int k = k0; k < k1 && it < it1; ++k, it += ngw) {
#pragma unroll
            for (int i = 0; i < 32; ++i) scr[(2 * i + (lane >> 5)) * 33 + (lane & 31)] = v[i];
            const bool more = k + 1 < k1 && it + ngw < it1;
            const TrItem nxt = decode(more ? it + ngw : it);
#pragma unroll
            for (int i = 0; i < 32; ++i) v[i] = __builtin_nontemporal_load(nxt.W + (size_t)(nxt.k0 + 2 * i + (lane >> 5)) * nxt.ldw + nxt.n0 + (lane & 31));
            __builtin_amdgcn_s_waitcnt(0xc07f); asm volatile("" ::: "memory");
            const int c = lane & 7;
#pragma unroll
            for (int j = 0; j < 4; ++j) { const int n = (lane >> 3) + 8 * j; const float* sp = scr + (8 * c) * 33 + n;
                v2u o; o.x = pk4_i8(sp[0 * 33], sp[1 * 33], sp[2 * 33], sp[3 * 33], cur.qs); o.y = pk4_i8(sp[4 * 33], sp[5 * 33], sp[6 * 33], sp[7 * 33], cur.qs);
                *(v2u*)(cur.WT8 + (size_t)(cur.dst_row0 + n) * cur.Kp + cur.k0 + 8 * c) = o; }
            __builtin_amdgcn_s_waitcnt(0xc07f); asm volatile("" ::: "memory");
            cur = nxt;
        }
    }
    __syncthreads();
}
__device__ __forceinline__ void prologue_phase(const P& p, unsigned char* lds, int bid, int nblk) {
    const int tid = tid_fresh(), lane = tid & 63, wave = tid >> 6;
    unsigned char* WinT = p.ws + WS_WIN; unsigned char* WoutT = p.ws + WS_WOUT; unsigned char* WguT = p.ws + WS_WGU; unsigned char* WdT = p.ws + WS_WD;
    float* mod = (float*)(p.ws + WS_MOD);
    {
        float* sc = (float*)lds;
        float* part = (float*)(lds + 32768);
        bool loaded = false;
        for (int it = bid; it < 192; it += nblk) {
            if (!loaded) { for (int i = tid; i < 8192; i += 512) { const int b = i >> 10, k = i & 1023; sc[k * 8 + b] = siluf(p.c[i]); } loaded = true; __syncthreads(); }
            const int kr = lane >> 3, cq = lane & 7, kb = wave * 128 + kr;
            const float* wp = p.w_ada + (size_t)kb * 6144 + it * 32 + 4 * cq;
            f32x4 w[16];
#pragma unroll
            for (int i = 0; i < 16; ++i) w[i] = __builtin_nontemporal_load((const f32x4*)(wp + (size_t)(8 * i) * 6144));
            f32x4 acc[8];
#pragma unroll
            for (int b = 0; b < 8; ++b) acc[b] = (f32x4){0.f, 0.f, 0.f, 0.f};
#pragma unroll
            for (int i = 0; i < 16; ++i) { const f32x4 s0 = *(const f32x4*)(sc + (kb + 8 * i) * 8), s1 = *(const f32x4*)(sc + (kb + 8 * i) * 8 + 4);
                acc[0] += w[i] * s0.x; acc[1] += w[i] * s0.y; acc[2] += w[i] * s0.z; acc[3] += w[i] * s0.w; acc[4] += w[i] * s1.x; acc[5] += w[i] * s1.y; acc[6] += w[i] * s1.z; acc[7] += w[i] * s1.w; }
#pragma unroll
            for (int b = 0; b < 8; ++b) *(f32x4*)(part + (((wave * 8 + kr) * 8 + b) * 32) + 4 * cq) = acc[b];
            __syncthreads();
            if (tid < 256) { const int b = tid >> 5, cc = tid & 31; float s = p.b_ada[it * 32 + cc];
#pragma unroll 8
                for (int g = 0; g < 64; ++g) s += part[(g * 8 + b) * 32 + cc];
                mod[b * 6144 + it * 32 + cc] = s; }
            __syncthreads();
        }
        __syncthreads();
    }
    if (nblk > 192) { if (bid >= 192) convert_items(p, lds, bid - 192, nblk - 192, 0, CV_IN, 0, 1 << 20); }
    else convert_items(p, lds, bid, nblk, 0, CV_IN, 0, 1 << 20);
    {
        const int gt = bid * 512 + tid, ngt = nblk * 512;
        float* cosT = (float*)(p.ws + WS_ROPE); float* sinT = cosT + SEQ * 32;
        for (int i = gt; i < SEQ * 32; i += ngt) { const int pos = i >> 5, f = i & 31;
            const float inv = exp2f((float)f * (-13.287712379549449f / 32.f)); const float ang = (float)pos * inv;
            float sn, cs; sincosf(ang, &sn, &cs); cosT[i] = cs; sinT[i] = sn; }
        if (gt == 0) { float a = 0.f, b = 0.f; for (int i = 0; i < 64; ++i) { a += p.lq1[i] * p.lk1[i]; b += p.lq2[i] * p.lk2[i]; }
            ((float*)(p.ws + WS_SCAL))[0] = expf(a) - expf(b) + 0.2f; }
    }
}

template <int CTRL> __device__ __forceinline__ float dppf(float x) { return __builtin_bit_cast(float, __builtin_amdgcn_mov_dpp(__builtin_bit_cast(int, x), CTRL, 0xf, 0xf, true)); }
template <int M> struct DppCtl { static constexpr int v = M == 1 ? 0xB1 : M == 2 ? 0x4E : M == 4 ? 0x141 : 0x128; };
__device__ __forceinline__ float swap32_add(float a, float b) { auto r = __builtin_amdgcn_permlane32_swap(__float_as_uint(a), __float_as_uint(b), false, false); return __uint_as_float(r[0]) + __uint_as_float(r[1]); }
__device__ __forceinline__ float swap16_add(float a, float b) { auto r = __builtin_amdgcn_permlane16_swap(__float_as_uint(a), __float_as_uint(b), false, false); return __uint_as_float(r[0]) + __uint_as_float(r[1]); }
__device__ __forceinline__ float wave_sum_v(float v) { v += dppf<0xB1>(v); v += dppf<0x4E>(v); v += dppf<0x141>(v); v += dppf<0x128>(v); v = swap16_add(v, v); return swap32_add(v, v); }
template <int N, int TOT, int M> struct WRM {
    static __device__ __forceinline__ void run(float (&v)[TOT], int lane) {
        if constexpr (M == 32) {
#pragma unroll
            for (int i = 0; i < N / 2; ++i) v[i] = swap32_add(v[i], v[i + N / 2]);
        } else if constexpr (M == 16) {
#pragma unroll
            for (int i = 0; i < N / 2; ++i) v[i] = swap16_add(v[i], v[i + N / 2]);
        } else {
            const bool up = (lane & M) != 0;
#pragma unroll
            for (int i = 0; i < N / 2; ++i) { const float send = up ? v[i] : v[i + N / 2]; const float keep = up ? v[i + N / 2] : v[i]; v[i] = keep + dppf<DppCtl<M>::v>(send); }
        }
        WRM<N / 2, TOT, M / 2>::run(v, lane);
    }
};
template <int TOT, int M> struct WRM<1, TOT, M> { static __device__ __forceinline__ void run(float (&v)[TOT], int lane) {
    if constexpr (M == 32) v[0] = swap32_add(v[0], v[0]); else if constexpr (M == 16) v[0] = swap16_add(v[0], v[0]); else v[0] += dppf<DppCtl<M>::v>(v[0]);
    WRM<1, TOT, M / 2>::run(v, lane); } };
template <int TOT> struct WRM<1, TOT, 0> { static __device__ __forceinline__ void run(float (&)[TOT], int) {} };
template <int N> __device__ __forceinline__ void wave_reduce_multi(float (&v)[N], int lane) { WRM<N, N, 32>::run(v, lane); }
__device__ __forceinline__ float dot4(const f32x4 a, const f32x4 b) { return (a.x * b.x + a.y * b.y) + (a.z * b.z + a.w * b.w); }
__device__ __forceinline__ float hsum4(const f32x4 a) { const pk2f_t t = (pk2f_t){a.x, a.y} + (pk2f_t){a.z, a.w}; return t.x + t.y; }
__device__ __forceinline__ float sumsq4(const f32x4 a) { return (a.x * a.x + a.y * a.y) + (a.z * a.z + a.w * a.w); }

__device__ __forceinline__ void norm1_phase(const P& p, unsigned char* lds, int c, int G) {
    const int tid = tid_fresh(), lane = tid & 63, gw = c * 8 + (tid >> 6), ngw = G * 8;
    const float* mod = (const float*)(p.ws + WS_MOD);
    unsigned char* H8 = p.ws + WS_H; float* logf_ = (float*)(p.ws + WS_LOGF);
    signed char* wq8 = (signed char*)lds;
    for (int i = tid; i < 8192; i += 512) { const int col = i >> 3, q = i & 7; const float w = p.w_in[(size_t)col * INC + NQKV + q];
        const int l_ = (col & 255) >> 2, j_ = col >> 8, e_ = col & 3;
        wq8[q * 1024 + l_ * 16 + j_ * 4 + e_] = (signed char)__float2int_rn(fminf(fmaxf(w * Q8_W, -127.f), 127.f)); }
    __syncthreads();
    const int rpw = (((T + ngw - 1) / ngw) + 1) & ~1, r_begin = gw * rpw, r_end = min(T, r_begin + rpw);
    const float bfg = lane < 8 ? p.b_forget[lane] : 0.f;
    for (int seg = r_begin; seg < r_end;) {
        const int b = seg >> 12, seg_end = min(r_end, (b + 1) << 12);
        f32x4 xn[2][4], gs[4], sh[4];
#pragma unroll
        for (int j = 0; j < 4; ++j) { const int col = 4 * lane + 256 * j; const f32x4 g = *(const f32x4*)(p.g_pre_attn + col), sc = *(const f32x4*)(mod + b * 6144 + 1024 + col);
            sh[j] = *(const f32x4*)(mod + b * 6144 + col); gs[j] = g * (1.f + sc); }
#pragma unroll
        for (int r = 0; r < 2; ++r)
#pragma unroll
            for (int j = 0; j < 4; ++j) xn[r][j] = *((const f32x4*)(p.x + (size_t)(seg + r) * D) + lane + 64 * j);
        __builtin_amdgcn_s_waitcnt(0x0f70);
        for (int r0 = seg; r0 < seg_end; r0 += 2) {
            f32x4 x[2][4];
#pragma unroll
            for (int r = 0; r < 2; ++r)
#pragma unroll
                for (int j = 0; j < 4; ++j) x[r][j] = xn[r][j];
            { const int rp = r0 + 2 < seg_end ? r0 + 2 : r0;
#pragma unroll
                for (int r = 0; r < 2; ++r)
#pragma unroll
                    for (int j = 0; j < 4; ++j) xn[r][j] = *((const f32x4*)(p.x + (size_t)(rp + r) * D) + lane + 64 * j);
            }
            float ss[2]; unsigned hq[2][4];
#pragma unroll
            for (int r = 0; r < 2; ++r) ss[r] = hsum4((x[r][0] * x[r][0] + x[r][1] * x[r][1]) + (x[r][2] * x[r][2] + x[r][3] * x[r][3]));
#pragma unroll
            for (int r = 0; r < 2; ++r) ss[r] = wave_sum_v(ss[r]);
#pragma unroll
            for (int r = 0; r < 2; ++r) { const float rinv = rsqrtf(ss[r] * (1.f / D) + EPS);
#pragma unroll
                for (int j = 0; j < 4; ++j) { x[r][j] = x[r][j] * rinv * gs[j] + sh[j];
                    hq[r][j] = pk4_i8(x[r][j].x, x[r][j].y, x[r][j].z, x[r][j].w, Q8_ACT);
                    *(unsigned*)(H8 + (size_t)(r0 + r) * D + 4 * lane + 256 * j) = hq[r][j]; } }
            float fl[16];
#pragma unroll
            for (int q = 0; q < 8; ++q) { const v4u w = *(const v4u*)(wq8 + q * 1024 + lane * 16); int a0 = 0, a1 = 0;
                a0 = __builtin_amdgcn_sdot4((int)hq[0][0], (int)w.x, a0, false); a0 = __builtin_amdgcn_sdot4((int)hq[0][1], (int)w.y, a0, false); a0 = __builtin_amdgcn_sdot4((int)hq[0][2], (int)w.z, a0, false); a0 = __builtin_amdgcn_sdot4((int)hq[0][3], (int)w.w, a0, false);
                a1 = __builtin_amdgcn_sdot4((int)hq[1][0], (int)w.x, a1, false); a1 = __builtin_amdgcn_sdot4((int)hq[1][1], (int)w.y, a1, false); a1 = __builtin_amdgcn_sdot4((int)hq[1][2], (int)w.z, a1, false); a1 = __builtin_amdgcn_sdot4((int)hq[1][3], (int)w.w, a1, false);
                fl[q] = (float)a0; fl[8 + q] = (float)a1; }
            wave_reduce_multi<16>(fl, lane);
            const float bq = __shfl(bfg, (lane >> 2) & 7);
            if ((lane & 3) == 0) { const int r = lane >> 5, q = (lane >> 2) & 7; const float z = fl[0] * (1.f / (Q8_ACT * Q8_W)) + bq;
                logf_[(size_t)(r0 + r) * 8 + q] = fminf(z, 0.f) - log1pf(expf(-fabsf(z))); }
        }
        seg = seg_end;
    }
}

__device__ __forceinline__ void scan_phase(const P& p, float* red  , int bid, int nblk) {
    const int tid = tid_fresh(), lane = tid & 63, wave = tid >> 6;
    const float* logf_ = (const float*)(p.ws + WS_LOGF); float* F = (float*)(p.ws + WS_F);
    for (int it = bid; it < 64; it += nblk) {
        const int b = it >> 3, h = it & 7;
        float v[8]; float s = 0.f;
#pragma unroll
        for (int i = 0; i < 8; ++i) { v[i] = logf_[((size_t)b * SEQ + tid * 8 + i) * 8 + h]; s += v[i]; v[i] = s; }
        float incl = s;
#pragma unroll
        for (int o = 1; o < 64; o <<= 1) { const float t = __shfl_up(incl, o); if (lane >= o) incl += t; }
        if (lane == 63) red[wave] = incl;
        __syncthreads();
        float base = incl - s;
        for (int w = 0; w < wave; ++w) base += red[w];
#pragma unroll
        for (int i = 0; i < 8; ++i) F[((size_t)b * 8 + h) * SEQ + tid * 8 + i] = -(base + v[i]) * 1.4426950408889634f;
        __syncthreads();
    }
}

constexpr int RT_WG = 131072, RT_CTL = 148480;
constexpr int CW_NORM = 2048, CW_FOXQ = 2304;
constexpr int CW_TILE = 10240;
constexpr int CW_SMIN = 8192;
constexpr int CNT_STRIDE = 64;
__device__ __forceinline__ void router_phase(const P& p, unsigned char* lds, int c, int G) {
    const int tid = tid_fresh(), lane = tid & 63, gw = c * 8 + (tid >> 6), ngw = G * 8;
    const float* mod = (const float*)(p.ws + WS_MOD); const bf16* mixed = (const bf16*)(p.ws + WS_R);
    unsigned char* H8 = p.ws + WS_H; bf16* X1 = (bf16*)(p.ws + WS_X1); unsigned* cnt = (unsigned*)(p.ws + WS_CTL);
    float* tokw = (float*)(p.ws + WS_TOKW); int* list = (int*)(p.ws + WS_LIST);
    float* wr = (float*)lds; float* wg = (float*)(lds + RT_WG);
    int* lcnt = (int*)(lds + RT_CTL); int* lbase = lcnt + 32; int* lassign = lcnt + 64;
    if (tid < 32) lcnt[tid] = 0;
    for (int i = tid; i < 8192; i += 512) { const int col = i >> 3, e0 = (i & 7) * 4; const f32x4 w = *(const f32x4*)(p.w_router + col * 32 + e0);
        wr[(e0 + 0) * 1024 + col] = w.x; wr[(e0 + 1) * 1024 + col] = w.y; wr[(e0 + 2) * 1024 + col] = w.z; wr[(e0 + 3) * 1024 + col] = w.w; }
    for (int col = tid; col < 1024; col += 512) { const f32x4 w = *(const f32x4*)(p.w_group + col * 4); wg[col] = w.x; wg[1024 + col] = w.y; wg[2048 + col] = w.z; wg[3072 + col] = w.w; }
    __syncthreads();
    const int rpw = (((T + ngw - 1) / ngw) + 1) & ~1, r_begin = gw * rpw, r_end = min(T, r_begin + rpw);
    const int blk_row0 = c * 8 * rpw, blk_slot0 = blk_row0 * 2, blk_nassign = max(0, min(T, blk_row0 + 8 * rpw) - blk_row0) * 2;
    const float bgl = p.b_group[(lane >> 3) & 3]; const float brt = lane < 32 ? p.b_router[lane] : 0.f;
    for (int seg = r_begin; seg < r_end;) {
        const int b = seg >> 12, seg_end = min(r_end, (b + 1) << 12);
        f32x4 xn[2][4], gta[4], gf[4], shf[4]; v2u mn[2][4];
#pragma unroll
        for (int j = 0; j < 4; ++j) { const int col = 4 * lane + 256 * j;
            gta[j] = *(const f32x4*)(p.g_post_attn + col) * *(const f32x4*)(mod + b * 6144 + 2048 + col);
            gf[j] = *(const f32x4*)(p.g_pre_ffn + col) * (1.f + *(const f32x4*)(mod + b * 6144 + 4096 + col)); shf[j] = *(const f32x4*)(mod + b * 6144 + 3072 + col); }
#pragma unroll
        for (int r = 0; r < 2; ++r)
#pragma unroll
            for (int j = 0; j < 4; ++j) { xn[r][j] = *((const f32x4*)(p.x + (size_t)(seg + r) * D) + lane + 64 * j); mn[r][j] = *((const v2u*)(mixed + (size_t)(seg + r) * D) + lane + 64 * j); }
        __builtin_amdgcn_s_waitcnt(0x0f70);
        for (int r0 = seg; r0 < seg_end; r0 += 2) {
            f32x4 x[2][4], m[2][4];
#pragma unroll
            for (int r = 0; r < 2; ++r)
#pragma unroll
                for (int j = 0; j < 4; ++j) { x[r][j] = xn[r][j]; const v2u w = mn[r][j]; m[r][j].x = bflo(w.x); m[r][j].y = bfhi(w.x); m[r][j].z = bflo(w.y); m[r][j].w = bfhi(w.y); }
            { const int rp = r0 + 2 < seg_end ? r0 + 2 : r0;
#pragma unroll
                for (int r = 0; r < 2; ++r)
#pragma unroll
                    for (int j = 0; j < 4; ++j) { xn[r][j] = *((const f32x4*)(p.x + (size_t)(rp + r) * D) + lane + 64 * j); mn[r][j] = *((const v2u*)(mixed + (size_t)(rp + r) * D) + lane + 64 * j); }
            }
            float s1[2], s2[2];
#pragma unroll
            for (int r = 0; r < 2; ++r) s1[r] = hsum4((m[r][0] * m[r][0] + m[r][1] * m[r][1]) + (m[r][2] * m[r][2] + m[r][3] * m[r][3]));
#pragma unroll
            for (int r = 0; r < 2; ++r) s1[r] = wave_sum_v(s1[r]);
#pragma unroll
            for (int r = 0; r < 2; ++r) { const float rinv = rsqrtf(s1[r] * (1.f / D) + EPS); f32x4 sq = (f32x4){0.f, 0.f, 0.f, 0.f};
#pragma unroll
                for (int j = 0; j < 4; ++j) { x[r][j] = x[r][j] + gta[j] * (m[r][j] * rinv); sq += x[r][j] * x[r][j];
                    v2u o; o.x = pk2(x[r][j].x, x[r][j].y); o.y = pk2(x[r][j].z, x[r][j].w); *(v2u*)(X1 + (size_t)(r0 + r) * D + 4 * lane + 256 * j) = o; }
                s2[r] = hsum4(sq); }
#pragma unroll
            for (int r = 0; r < 2; ++r) s2[r] = wave_sum_v(s2[r]);
#pragma unroll
            for (int r = 0; r < 2; ++r) { const float rinv = rsqrtf(s2[r] * (1.f / D) + EPS);
#pragma unroll
                for (int j = 0; j < 4; ++j) { x[r][j] = x[r][j] * rinv * gf[j] + shf[j];
                    *(unsigned*)(H8 + (size_t)(r0 + r) * D + 4 * lane + 256 * j) = pk4_i8(x[r][j].x, x[r][j].y, x[r][j].z, x[r][j].w, Q8_ACT); } }
            float gl[8];
#pragma unroll
            for (int q = 0; q < 4; ++q) { f32x4 a0 = (f32x4){0.f, 0.f, 0.f, 0.f}, a1 = a0;
#pragma unroll
                for (int j = 0; j < 4; ++j) { const f32x4 w = *(const f32x4*)(wg + q * 1024 + 4 * lane + 256 * j); a0 += x[0][j] * w; a1 += x[1][j] * w; }
                gl[q] = hsum4(a0); gl[4 + q] = hsum4(a1); if (q & 1) asm volatile("" ::: "memory"); }
            wave_reduce_multi<8>(gl, lane);
            const float glv = gl[0] + bgl;
            float v4[4];
#pragma unroll
            for (int q = 0; q < 4; ++q) v4[q] = __shfl(glv, (lane & 32) + q * 8);
            int bi = 0; float bm = v4[0];
#pragma unroll
            for (int q = 1; q < 4; ++q) if (v4[q] > bm) { bm = v4[q]; bi = q; }
            float gsum = 0.f;
#pragma unroll
            for (int q = 0; q < 4; ++q) gsum += __expf(v4[q] - bm);
            const float gwtl = 1.f / gsum;
            int gi[2]; gi[0] = __builtin_amdgcn_readlane(bi, 0); gi[1] = __builtin_amdgcn_readlane(bi, 32);
            float el[16];
#pragma unroll
            for (int r = 0; r < 2; ++r) { const float* wb = wr + gi[r] * 8192 + 4 * lane;
#pragma unroll
                for (int q = 0; q < 8; ++q) { f32x4 a = (f32x4){0.f, 0.f, 0.f, 0.f};
#pragma unroll
                    for (int j = 0; j < 4; ++j) a += x[r][j] * *(const f32x4*)(wb + q * 1024 + 256 * j);
                    el[r * 8 + q] = hsum4(a); if (q & 1) asm volatile("" ::: "memory"); } }
            wave_reduce_multi<16>(el, lane);
            {
                const float elv = el[0] + __shfl(brt, bi * 8 + ((lane >> 2) & 7));
                float v[8];
#pragma unroll
                for (int q = 0; q < 8; ++q) v[q] = __shfl(elv, (lane & 32) + q * 4);
                int i1 = 0; float v1 = v[0];
#pragma unroll
                for (int q = 1; q < 8; ++q) if (v[q] > v1) { v1 = v[q]; i1 = q; }
                int i2 = -1; float v2 = -3.0e38f;
#pragma unroll
                for (int q = 0; q < 8; ++q) if (q != i1 && v[q] > v2) { v2 = v[q]; i2 = q; }
                const float e2 = __expf(v2 - v1); const float w1 = gwtl / (1.f + e2), w2 = gwtl * e2 / (1.f + e2);
                if ((lane & 31) < 2) { const int r = lane >> 5, sl = lane & 1; const int e = bi * 8 + (sl ? i2 : i1); const float w = sl ? w2 : w1; const int slot = (r0 + r) * 2 + sl;
                    tokw[slot] = w; const int lpos = atomicAdd(lcnt + e, 1); lassign[slot - blk_slot0] = e | (lpos << 8); }
            }
        }
        seg = seg_end;
    }
    __syncthreads();
    if (tid < 32) lbase[tid] = lcnt[tid] ? (int)atomicAdd(cnt + tid * CNT_STRIDE, (unsigned)lcnt[tid]) : 0;
    __syncthreads();
    for (int i = tid; i < blk_nassign; i += 512) { const int v = lassign[i], e = v & 255; list[e * T + lbase[e] + (v >> 8)] = blk_slot0 + i; }
}

typedef float f32x2 __attribute__((ext_vector_type(2)));
__device__ __forceinline__ f32x4 fp8x4_to_f32(unsigned w) { const f32x2 lo = __builtin_amdgcn_cvt_pk_f32_fp8((int)w, false), hi = __builtin_amdgcn_cvt_pk_f32_fp8((int)w, true); return (f32x4){lo.x, lo.y, hi.x, hi.y}; }
__device__ __forceinline__ void final_phase(const P& p, int c, int G) {
    const int tid = tid_fresh(), lane = tid & 63, gw = c * 8 + (tid >> 6), ngw = G * 8;
    const float* mod = (const float*)(p.ws + WS_MOD); const unsigned char* YS = p.ws + WS_R; const bf16* X1 = (const bf16*)(p.ws + WS_X1); const float* tokw = (const float*)(p.ws + WS_TOKW);
    const int rpw = (((T + ngw - 1) / ngw) + 1) & ~1, r_begin = gw * rpw, r_end = min(T, r_begin + rpw);
    for (int seg = r_begin; seg < r_end;) {
        const int b = seg >> 12, seg_end = min(r_end, (b + 1) << 12);
        f32x4 gtf[4]; v2u xn[2][4]; unsigned yn[2][2][4];
#pragma unroll
        for (int j = 0; j < 4; ++j) { const int col = 4 * lane + 256 * j; gtf[j] = *(const f32x4*)(p.g_post_ffn + col) * *(const f32x4*)(mod + b * 6144 + 5120 + col); }
#pragma unroll
        for (int r = 0; r < 2; ++r)
#pragma unroll
            for (int j = 0; j < 4; ++j) { xn[r][j] = *((const v2u*)(X1 + (size_t)(seg + r) * D) + lane + 64 * j);
                yn[r][0][j] = *((const unsigned*)(YS + (size_t)((seg + r) * 2) * D) + lane + 64 * j); yn[r][1][j] = *((const unsigned*)(YS + (size_t)((seg + r) * 2 + 1) * D) + lane + 64 * j); }
        __builtin_amdgcn_s_waitcnt(0x0f70);
        for (int r0 = seg; r0 < seg_end; r0 += 2) {
            f32x4 x[2][4], y[2][4];
#pragma unroll
            for (int r = 0; r < 2; ++r) { const float w0 = tokw[(r0 + r) * 2] * 0.0625f, w1 = tokw[(r0 + r) * 2 + 1] * 0.0625f;
#pragma unroll
                for (int j = 0; j < 4; ++j) { const v2u xv = xn[r][j]; x[r][j].x = bflo(xv.x); x[r][j].y = bfhi(xv.x); x[r][j].z = bflo(xv.y); x[r][j].w = bfhi(xv.y);
                    y[r][j] = fp8x4_to_f32(yn[r][0][j]) * w0 + fp8x4_to_f32(yn[r][1][j]) * w1; } }
            { const int rp = r0 + 2 < seg_end ? r0 + 2 : r0;
#pragma unroll
                for (int r = 0; r < 2; ++r)
#pragma unroll
                    for (int j = 0; j < 4; ++j) { xn[r][j] = *((const v2u*)(X1 + (size_t)(rp + r) * D) + lane + 64 * j);
                        yn[r][0][j] = *((const unsigned*)(YS + (size_t)((rp + r) * 2) * D) + lane + 64 * j); yn[r][1][j] = *((const unsigned*)(YS + (size_t)((rp + r) * 2 + 1) * D) + lane + 64 * j); }
            }
            float ss[2];
#pragma unroll
            for (int r = 0; r < 2; ++r) ss[r] = hsum4((y[r][0] * y[r][0] + y[r][1] * y[r][1]) + (y[r][2] * y[r][2] + y[r][3] * y[r][3]));
#pragma unroll
            for (int r = 0; r < 2; ++r) ss[r] = wave_sum_v(ss[r]);
#pragma unroll
            for (int r = 0; r < 2; ++r) { const float rinv = rsqrtf(ss[r] * (1.f / D) + EPS);
#pragma unroll
                for (int j = 0; j < 4; ++j) *((f32x4*)(p.out + (size_t)(r0 + r) * D) + lane + 64 * j) = x[r][j] + gtf[j] * (y[r][j] * rinv); }
        }
        seg = seg_end;
    }
}

namespace pg8 {
#define PG8_LAS __attribute__((address_space(3)))
typedef unsigned short bf16_t;
typedef short bf16x8 __attribute__((ext_vector_type(8)));
typedef float f32x4 __attribute__((ext_vector_type(4)));
typedef unsigned u32x4 __attribute__((ext_vector_type(4)));
constexpr int BM = 256, BK = 64, HALF = 128, HTB = HALF * BK * 2  , STAGE_BYTES = 8 * HTB, NXCD = 8, WGM = 4;

__host__ __device__ __forceinline__ int lds_byte(int r, int c) { const int st = (r >> 4) * 2 + (c >> 5), rr = r & 15, cc = c & 31, ob = rr * 64 + cc * 2; return st * 1024 + (ob ^ (((ob >> 9) & 1) << 5)); }
__host__ __device__ __forceinline__ void stage_rc(int b, int& R, int& C) { const int st = b / 1024, sb = b % 1024, swz = sb ^ (((sb >> 9) & 1) << 5); R = (st >> 1) * 16 + swz / 64; C = (st & 1) * 32 + (swz % 64) / 2; }
__host__ __device__ __forceinline__ int perm32(int rho) { const int n = rho >> 4, i = rho & 15; return 8 * (i >> 2) + 4 * n + (i & 3); }

struct Unit { int pm, pn, aux; };
struct Gemm { const bf16_t* A; const bf16_t* Bt; int M, N, K; };

struct StaticOrder {
    int nM, nN, nwg, G, c;
    __host__ __device__ void init(int M, int N, int G_, int c_) { nM = M / BM; nN = N / BM; nwg = nM * nN; G = G_; c = c_; }
    __host__ __device__ bool next(int i, Unit& u) const {
        const long L = (long)i * G + c; if (L >= nwg) return false;
        int wgid = (int)L; { const int q = nwg / NXCD, r = nwg % NXCD, xcd = wgid % NXCD, off = wgid / NXCD; wgid = (xcd < r ? xcd * (q + 1) : r * (q + 1) + (xcd - r) * q) + off; }
        const int nig = WGM * nN, gid = wgid / nig, fm = gid * WGM, gsz = (nM - fm) < WGM ? (nM - fm) : WGM;
        u.pm = fm + ((wgid % nig) % gsz); u.pn = (wgid % nig) / gsz; return true;
    }
    __device__ __forceinline__ void a_ready(const Unit&) const {}
    __device__ __forceinline__ void done(const Unit&) const {}
};

__device__ __forceinline__ unsigned cvt_pk_bf16(float lo, float hi) { unsigned r; asm volatile("v_cvt_pk_bf16_f32 %0, %1, %2" : "=v"(r) : "v"(lo), "v"(hi)); return r; }
typedef float f32x2 __attribute__((ext_vector_type(2)));

typedef int i32x4 __attribute__((ext_vector_type(4)));
template <class Epi, class Sched, bool ALIGN_EPI = false, bool SP2 = true, bool GATHER = false, bool I8 = false, bool ACOH = false>
__device__ __forceinline__ void gemm_phase(PG8_LAS unsigned char* lds, const Gemm g, const Sched& S, const Epi& E) {
    const int tid = tid_fresh(), wid = __builtin_amdgcn_readfirstlane(tid >> 6), lane = tid & 63, wr = wid >> 2, wc = wid & 3, fr = lane & 15, fq = lane >> 4;
    constexpr int ES = I8 ? 1 : 2;
    const int K = g.K, nt = K * ES / (BK * 2);
    unsigned voffA[2], voffB[2];
#pragma unroll
    for (int i = 0; i < 2; ++i) { int R, C; stage_rc(tid * 16 + i * 8192, R, C); const int Rb = Epi::PERM ? ((R & ~31) + perm32(R & 31)) : R;
        voffA[i] = (unsigned)(R * K * ES + C * 2); voffB[i] = (unsigned)(Rb * K * ES + C * 2); }
    unsigned offC[2][2], offN[2][2]; int gR[2], gC[2];
#pragma unroll
    for (int i = 0; i < 2; ++i) { int R, C; stage_rc(tid * 16 + i * 8192, R, C); gR[i] = R; gC[i] = C * 2; }
#pragma unroll
    for (int h = 0; h < 2; ++h)
#pragma unroll
        for (int i = 0; i < 2; ++i) { offC[h][i] = 0u; offN[h][i] = 0u; }
    const char* gA = (const char*)g.A;
    const size_t kstep = (size_t)(BK * 2);
    const size_t hstep = (size_t)HALF * K * ES;
    const size_t tstep = 2 * hstep;
    const unsigned ldsw = (unsigned)wid * 1024u;
    const int aoff = lds_byte(wr * 64 + fr, fq * 8), boff = lds_byte(wc * 32 + fr, fq * 8);
#define PG8_SA(b, h) (((b) * 2 + (h)) * HTB)
#define PG8_SB(b, h) ((4 + (b) * 2 + (h)) * HTB)
#define PG8_STAGE(bufoff, gbase, voff) do { _Pragma("unroll") for (int _i = 0; _i < 2; ++_i) \
        __builtin_amdgcn_global_load_lds((const unsigned*)((const char*)(gbase) + (voff)[_i]), (PG8_LAS unsigned*)(lds + (bufoff) + ldsw + _i * 8192), 16, 0, 0); } while (0)
#define PG8_STAGE_C(bufoff, gbase, voff) do { _Pragma("unroll") for (int _i = 0; _i < 2; ++_i) \
        __builtin_amdgcn_global_load_lds((const unsigned*)((const char*)(gbase) + (voff)[_i]), (PG8_LAS unsigned*)(lds + (bufoff) + ldsw + _i * 8192), 16, 0, 17); } while (0)
#define PG8_STA(b, h, nb, gb, off) do { if constexpr (GATHER) PG8_STAGE(PG8_SA(b, h), gb, off[h]); else if constexpr (ACOH) PG8_STAGE_C(PG8_SA(b, h), (nb) + (h) * hstep, voffA); else PG8_STAGE(PG8_SA(b, h), (nb) + (h) * hstep, voffA); } while (0)
#define PG8_LDA(dst, b, h) do { _Pragma("unroll") for (int m = 0; m < 4; ++m) _Pragma("unroll") for (int k = 0; k < 2; ++k) dst[m][k] = *(const PG8_LAS bf16x8*)(lds + PG8_SA(b, h) + aoff + m * 2048 + k * 1024); } while (0)
#define PG8_LDB(dst, b, h) do { _Pragma("unroll") for (int n = 0; n < 2; ++n) _Pragma("unroll") for (int k = 0; k < 2; ++k) dst[n][k] = *(const PG8_LAS bf16x8*)(lds + PG8_SB(b, h) + boff + n * 2048 + k * 1024); } while (0)
#define PG8_MMA(ai, bj, At, Bt) do { __builtin_amdgcn_s_setprio(1); _Pragma("unroll") for (int m = 0; m < 4; ++m) _Pragma("unroll") for (int n = 0; n < 2; ++n) _Pragma("unroll") for (int k = 0; k < 2; ++k) { \
        if constexpr (I8) acc[ai][bj][m][n] = __builtin_bit_cast(f32x4, __builtin_amdgcn_mfma_i32_16x16x64_i8(__builtin_bit_cast(i32x4, Bt[n][k]), __builtin_bit_cast(i32x4, At[m][k]), __builtin_bit_cast(i32x4, acc[ai][bj][m][n]), 0, 0, 0)); \
        else acc[ai][bj][m][n] = __builtin_amdgcn_mfma_f32_16x16x32_bf16(Bt[n][k], At[m][k], acc[ai][bj][m][n], 0, 0, 0); } __builtin_amdgcn_s_setprio(0); } while (0)
#define PG8_WAIT_V(n) asm volatile("s_waitcnt vmcnt(" #n ")" ::: "memory")
#define PG8_WAIT_L(n) asm volatile("s_waitcnt lgkmcnt(" #n ")" ::: "memory")
#define PG8_BAR __builtin_amdgcn_s_barrier()
#define PG8_SCHED __builtin_amdgcn_sched_barrier(0)
    Unit cur, nxt; int ui = 0;
    if (!S.next(0, cur)) return;
    f32x4 acc[2][2][4][2];
#pragma unroll
    for (int a = 0; a < 2; ++a)
#pragma unroll
        for (int b = 0; b < 2; ++b)
#pragma unroll
            for (int m = 0; m < 4; ++m)
#pragma unroll
                for (int n = 0; n < 2; ++n) acc[a][b][m][n] = (f32x4){0.f, 0.f, 0.f, 0.f};
    bf16x8 At[4][2], B0[2][2], B1[2][2];
    const char* cA = (const char*)g.A + (size_t)cur.pm * tstep; const char* cB = (const char*)g.Bt + (size_t)cur.pn * tstep;
    S.a_ready(cur);
    static_assert(!GATHER || SP2, "GATHER needs the SP2 loop");
    if constexpr (GATHER) {
#pragma unroll
        for (int h = 0; h < 2; ++h)
#pragma unroll
            for (int i = 0; i < 2; ++i) { offC[h][i] = S.arow(0, 128 * h + gR[i]) + (unsigned)gC[i]; offN[h][i] = offC[h][i]; } }
    if constexpr (SP2) {
        PG8_STAGE(PG8_SB(0, 0), cB, voffB); PG8_STAGE(PG8_SB(0, 1), cB + hstep, voffB); PG8_STA(0, 0, cA, gA, offC); PG8_STA(0, 1, cA, gA, offC);
        if (wr == 1) PG8_BAR;
        PG8_WAIT_V(2); PG8_BAR;
        PG8_STAGE(PG8_SB(1, 0), cB + kstep, voffB); PG8_STA(1, 0, cA + kstep, gA + kstep, offC); PG8_STAGE(PG8_SB(1, 1), cB + hstep + kstep, voffB);
        PG8_WAIT_V(6); PG8_BAR;
    } else {
        PG8_STAGE(PG8_SB(0, 0), cB, voffB); PG8_STAGE(PG8_SA(0, 0), cA, voffA); PG8_STAGE(PG8_SB(0, 1), cB + hstep, voffB); PG8_STAGE(PG8_SA(0, 1), cA + hstep, voffA);
        if (wr == 1) PG8_BAR;
        PG8_WAIT_V(4); PG8_BAR;
        PG8_STAGE(PG8_SB(1, 0), cB + kstep, voffB); PG8_STAGE(PG8_SA(1, 0), cA + kstep, voffA); PG8_STAGE(PG8_SB(1, 1), cB + hstep + kstep, voffB);
        PG8_WAIT_V(6); PG8_BAR;
    }
    for (;;) {
        const bool has_next = S.next(ui + 1, nxt);
        if (has_next) S.a_ready(nxt);
        if constexpr (GATHER) { if (has_next) {
#pragma unroll
            for (int h = 0; h < 2; ++h)
#pragma unroll
                for (int i = 0; i < 2; ++i) offN[h][i] = S.arow(ui + 1, 128 * h + gR[i]) + (unsigned)gC[i]; } }
        const char* nA = has_next ? (const char*)g.A + (size_t)nxt.pm * tstep : cA; const char* nB = has_next ? (const char*)g.Bt + (size_t)nxt.pn * tstep : cB;
        for (int t = 0; t < nt; t += 2) {
            const bool last = (t == nt - 2);
            const char* a1 = cA + (size_t)(t + 1) * kstep;
            const char* a2 = last ? nA : cA + (size_t)(t + 2) * kstep; const char* b2 = last ? nB : cB + (size_t)(t + 2) * kstep;
            const char* a3 = a2 + kstep; const char* b3 = b2 + kstep;
            const char* g2 = gA + (last ? (size_t)0 : (size_t)(t + 2) * kstep); unsigned offS[2][2];
#pragma unroll
            for (int h = 0; h < 2; ++h)
#pragma unroll
                for (int i = 0; i < 2; ++i) offS[h][i] = last ? offN[h][i] : offC[h][i];
            (void)g2; (void)offS;
            if constexpr (SP2) {
            PG8_LDB(B0, 0, 0); PG8_LDB(B1, 0, 1); PG8_SCHED; PG8_LDA(At, 0, 0); PG8_STA(1, 1, a1, gA + (size_t)(t + 1) * kstep, offC);
            PG8_WAIT_V(8); PG8_WAIT_L(0); PG8_BAR; PG8_MMA(0, 0, At, B0); PG8_MMA(0, 1, At, B1); PG8_BAR; PG8_SCHED;
            PG8_LDA(At, 0, 1); PG8_STAGE(PG8_SB(0, 0), b2, voffB); PG8_STAGE(PG8_SB(0, 1), b2 + hstep, voffB); PG8_STA(0, 0, a2, g2, offS);
            PG8_WAIT_V(8); PG8_WAIT_L(0); PG8_BAR; PG8_MMA(1, 0, At, B0); PG8_MMA(1, 1, At, B1); PG8_BAR; PG8_SCHED;
            PG8_LDB(B0, 1, 0); PG8_LDB(B1, 1, 1); PG8_SCHED; PG8_LDA(At, 1, 0); PG8_STA(0, 1, a2, g2, offS);
            PG8_WAIT_V(8); PG8_WAIT_L(0); PG8_BAR; PG8_MMA(0, 0, At, B0); PG8_MMA(0, 1, At, B1); PG8_BAR; PG8_SCHED;
            PG8_LDA(At, 1, 1); PG8_STAGE(PG8_SB(1, 0), b3, voffB); PG8_STAGE(PG8_SB(1, 1), b3 + hstep, voffB); PG8_STA(1, 0, a3, g2 + kstep, offS);
            PG8_WAIT_V(8); PG8_WAIT_L(0); PG8_BAR; PG8_MMA(1, 0, At, B0); PG8_MMA(1, 1, At, B1); PG8_BAR; PG8_SCHED;
            } else {
            PG8_LDB(B0, 0, 0); PG8_SCHED; PG8_LDA(At, 0, 0); PG8_STAGE(PG8_SA(1, 1), a1 + hstep, voffA);
            PG8_WAIT_L(8); PG8_BAR; PG8_WAIT_L(0); PG8_MMA(0, 0, At, B0); PG8_BAR; PG8_SCHED;
            PG8_LDB(B1, 0, 1); PG8_STAGE(PG8_SB(0, 0), b2, voffB);
            PG8_BAR; PG8_WAIT_L(0); PG8_MMA(0, 1, At, B1); PG8_BAR;
            PG8_LDA(At, 0, 1); PG8_STAGE(PG8_SA(0, 0), a2, voffA);
            PG8_BAR; PG8_WAIT_L(0); PG8_MMA(1, 0, At, B0); PG8_BAR; PG8_SCHED;
            PG8_STAGE(PG8_SB(0, 1), b2 + hstep, voffB);
            PG8_WAIT_V(6); PG8_BAR; PG8_MMA(1, 1, At, B1); PG8_BAR;
            PG8_LDB(B0, 1, 0); PG8_SCHED; PG8_LDA(At, 1, 0); PG8_STAGE(PG8_SA(0, 1), a2 + hstep, voffA);
            PG8_WAIT_L(8); PG8_BAR; PG8_WAIT_L(0); PG8_MMA(0, 0, At, B0); PG8_BAR; PG8_SCHED;
            PG8_LDB(B1, 1, 1); PG8_STAGE(PG8_SB(1, 0), b3, voffB);
            PG8_BAR; PG8_WAIT_L(0); PG8_MMA(0, 1, At, B1); PG8_BAR;
            PG8_LDA(At, 1, 1); PG8_STAGE(PG8_SA(1, 0), a3, voffA);
            PG8_BAR; PG8_WAIT_L(0); PG8_MMA(1, 0, At, B0); PG8_BAR; PG8_SCHED;
            PG8_STAGE(PG8_SB(1, 1), b3 + hstep, voffB);
            PG8_WAIT_V(6); PG8_BAR; PG8_MMA(1, 1, At, B1); PG8_BAR;
            }
        }
        if constexpr (ALIGN_EPI) { if (wr == 0) PG8_BAR; }
        if constexpr (!Epi::AFTER_DRAIN) { E(acc, cur, wr, wc, fr, fq); S.done(cur); }
        if (!has_next) break;
#pragma unroll
        for (int a = 0; a < 2; ++a)
#pragma unroll
            for (int b = 0; b < 2; ++b)
#pragma unroll
                for (int m = 0; m < 4; ++m)
#pragma unroll
                    for (int n = 0; n < 2; ++n) acc[a][b][m][n] = (f32x4){0.f, 0.f, 0.f, 0.f};
        cur = nxt; cA = nA; cB = nB; ++ui;
#pragma unroll
        for (int h = 0; h < 2; ++h)
#pragma unroll
            for (int i = 0; i < 2; ++i) offC[h][i] = offN[h][i];
        if constexpr (ALIGN_EPI) { if (wr == 1) PG8_BAR; }
    }
    PG8_WAIT_V(0);
    if constexpr (!ALIGN_EPI) { if (wr == 0) PG8_BAR; }
    PG8_BAR;
    if constexpr (Epi::AFTER_DRAIN) { E.fused(acc, cur, wr, wc, fr, fq, lds, wid, lane); S.done(cur); }
#undef PG8_SA
#undef PG8_SB
#undef PG8_STAGE
#undef PG8_STAGE_C
#undef PG8_STA
#undef PG8_LDA
#undef PG8_LDB
#undef PG8_MMA
#undef PG8_WAIT_V
#undef PG8_WAIT_L
#undef PG8_BAR
#undef PG8_SCHED
}

typedef unsigned u32x4e __attribute__((ext_vector_type(4)));
__device__ __forceinline__ f32x4 i2f4(const f32x4 r, float s) { const float a = r.x, b = r.y, c = r.z, d = r.w; return (f32x4){(float)__float_as_int(a) * s, (float)__float_as_int(b) * s, (float)__float_as_int(c) * s, (float)__float_as_int(d) * s}; }
typedef unsigned u32x2e __attribute__((ext_vector_type(2)));
struct EpiInProj {
    static constexpr bool PERM = true, AFTER_DRAIN = false;
    bf16_t* O; const float* cosT; const float* sinT; float qscale, dq;
    unsigned* smn;
    unsigned* nrm;
    __device__ __forceinline__ void operator()(const f32x4 (&acc)[2][2][4][2], const Unit& u, int wr, int wc, int fr, int fq) const {
        const int row0 = u.pm * BM + wr * 64 + fr;
        if (u.pn < 4) {
            const float sc = u.pn < 2 ? qscale : 1.f; const int colb = (u.pn * 4 + wc) * 64 + 8 * fq;
#pragma unroll
            for (int ai = 0; ai < 2; ++ai)
#pragma unroll
                for (int m = 0; m < 4; ++m) { const int row = row0 + ai * HALF + m * 16, pos = row & 4095;
                    const f32x4 c0 = *(const f32x4*)(cosT + pos * 32 + 8 * fq), c1 = *(const f32x4*)(cosT + pos * 32 + 8 * fq + 4), s0 = *(const f32x4*)(sinT + pos * 32 + 8 * fq), s1 = *(const f32x4*)(sinT + pos * 32 + 8 * fq + 4);
                    const f32x4 a0 = i2f4(acc[ai][0][m][0], dq), a1 = i2f4(acc[ai][0][m][1], dq), b0 = i2f4(acc[ai][1][m][0], dq), b1 = i2f4(acc[ai][1][m][1], dq);
                    const f32x4 p0 = (a0 * c0 - b0 * s0) * sc, p1 = (a1 * c1 - b1 * s1) * sc, q0 = (b0 * c0 + a0 * s0) * sc, q1 = (b1 * c1 + a1 * s1) * sc;
                    u32x4e w; w.x = cvt_pk_bf16(p0[0], p0[1]); w.y = cvt_pk_bf16(p0[2], p0[3]); w.z = cvt_pk_bf16(p1[0], p1[1]); w.w = cvt_pk_bf16(p1[2], p1[3]);
                    bf16_t* rp = O + (size_t)row * 3072 + colb; *(u32x4e*)rp = w;
                    w.x = cvt_pk_bf16(q0[0], q0[1]); w.y = cvt_pk_bf16(q0[2], q0[3]); w.z = cvt_pk_bf16(q1[0], q1[1]); w.w = cvt_pk_bf16(q1[2], q1[3]); *(u32x4e*)(rp + 32) = w; }
        } else {
            if (u.pn >= 6 && u.pn <= 9) {
                const int hp = u.pn - 6, colq = 1536 + hp * 128 + wc * 32 + 8 * fq; const float sq_ = qscale * dq;
                float nq = 0.f, nk = 0.f, smin = 3.0e38f;
#pragma unroll
                for (int ai = 0; ai < 2; ++ai)
#pragma unroll
                    for (int m = 0; m < 4; ++m) { bf16_t* rp = O + (size_t)(row0 + ai * HALF + m * 16) * 3072 + colq;
                        const f32x4 q0 = i2f4(acc[ai][0][m][0], sq_), q1 = i2f4(acc[ai][0][m][1], sq_), k0 = i2f4(acc[ai][1][m][0], dq), k1 = i2f4(acc[ai][1][m][1], dq);
                        u32x4e w; w.x = cvt_pk_bf16(q0[0], q0[1]); w.y = cvt_pk_bf16(q0[2], q0[3]); w.z = cvt_pk_bf16(q1[0], q1[1]); w.w = cvt_pk_bf16(q1[2], q1[3]); *(u32x4e*)rp = w;
                        w.x = cvt_pk_bf16(k0[0], k0[1]); w.y = cvt_pk_bf16(k0[2], k0[3]); w.z = cvt_pk_bf16(k1[0], k1[1]); w.w = cvt_pk_bf16(k1[2], k1[3]); *(u32x4e*)(rp + 512) = w;
                        float a = hsum4(q0 * q0 + q1 * q1), b_ = hsum4(k0 * k0 + k1 * k1), d = hsum4(q0 * k0 + q1 * k1);
                        a = swap16_add(a, a); a = swap32_add(a, a); b_ = swap16_add(b_, b_); b_ = swap32_add(b_, b_); d = swap16_add(d, d); d = swap32_add(d, d);
                        nq = fmaxf(nq, a); nk = fmaxf(nk, b_); smin = fminf(smin, d); }
                nq = fmaxf(nq, dppf<0xB1>(nq)); nq = fmaxf(nq, dppf<0x4E>(nq)); nq = fmaxf(nq, dppf<0x141>(nq)); nq = fmaxf(nq, dppf<0x128>(nq));
                nk = fmaxf(nk, dppf<0xB1>(nk)); nk = fmaxf(nk, dppf<0x4E>(nk)); nk = fmaxf(nk, dppf<0x141>(nk)); nk = fmaxf(nk, dppf<0x128>(nk));
                smin = fminf(smin, dppf<0xB1>(smin)); smin = fminf(smin, dppf<0x4E>(smin)); smin = fminf(smin, dppf<0x141>(smin)); smin = fminf(smin, dppf<0x128>(smin));
                if (fr == 0 && fq == 0) { const int b = (u.pm * BM) >> 12, qb = u.pm & 15, h = hp * 2 + (wc >> 1);
                    atomicMax(nrm + ((b * 8 + h) * 2 + 0) * 2 + (wc & 1), __float_as_uint(nq)); atomicMax(nrm + ((b * 8 + h) * 2 + 1) * 2 + (wc & 1), __float_as_uint(nk));
                    const int si = __float_as_int(smin); atomicMin((int*)smn + (((b * 8 + h) * 16 + qb) * 2 + (wc & 1)), si >= 0 ? si : si ^ 0x7fffffff); }
            } else {
            const float sc = dq; const int col0 = u.pn * BM + wc * 32 + 8 * fq;
#pragma unroll
            for (int ai = 0; ai < 2; ++ai)
#pragma unroll
                for (int m = 0; m < 4; ++m) { bf16_t* rp = O + (size_t)(row0 + ai * HALF + m * 16) * 3072 + col0;
#pragma unroll
                    for (int bj = 0; bj < 2; ++bj) { const f32x4 v0 = i2f4(acc[ai][bj][m][0], sc), v1 = i2f4(acc[ai][bj][m][1], sc);
                        u32x4e w; w.x = cvt_pk_bf16(v0[0], v0[1]); w.y = cvt_pk_bf16(v0[2], v0[3]); w.z = cvt_pk_bf16(v1[0], v1[1]); w.w = cvt_pk_bf16(v1[2], v1[3]); *(u32x4e*)(rp + bj * HALF) = w; } }
            }
        }
    }
};
struct EpiBf16P {
    static constexpr bool PERM = true, AFTER_DRAIN = false;
    bf16_t* C; int ldc; float dq;
    __device__ __forceinline__ void operator()(const f32x4 (&acc)[2][2][4][2], const Unit& u, int wr, int wc, int fr, int fq) const {
        const int row0 = u.pm * BM + wr * 64 + fr, col0 = u.pn * BM + wc * 32 + 8 * fq;
#pragma unroll
        for (int ai = 0; ai < 2; ++ai)
#pragma unroll
            for (int m = 0; m < 4; ++m) { bf16_t* rp = C + (size_t)(row0 + ai * HALF + m * 16) * ldc + col0;
#pragma unroll
                for (int bj = 0; bj < 2; ++bj) { const f32x4 v0 = i2f4(acc[ai][bj][m][0], dq), v1 = i2f4(acc[ai][bj][m][1], dq);
                    u32x4e w; w.x = cvt_pk_bf16(v0[0], v0[1]); w.y = cvt_pk_bf16(v0[2], v0[3]); w.z = cvt_pk_bf16(v1[0], v1[1]); w.w = cvt_pk_bf16(v1[2], v1[3]); *(u32x4e*)(rp + bj * HALF) = w; } }
    }
};
struct EpiF32 {
    static constexpr bool PERM = false, AFTER_DRAIN = false;
    float* C; int ldc;
    __device__ __forceinline__ void operator()(const f32x4 (&acc)[2][2][4][2], const Unit& u, int wr, int wc, int fr, int fq) const {
        const int row0 = u.pm * BM + wr * 64 + fr, col0 = u.pn * BM + wc * 32 + 4 * fq;
#pragma unroll
        for (int ai = 0; ai < 2; ++ai)
#pragma unroll
            for (int m = 0; m < 4; ++m) { float* rp = C + (size_t)(row0 + ai * HALF + m * 16) * ldc + col0;
#pragma unroll
                for (int bj = 0; bj < 2; ++bj)
#pragma unroll
                    for (int n = 0; n < 2; ++n) *(f32x4*)(rp + bj * HALF + n * 16) = acc[ai][bj][m][n]; }
    }
};

__device__ __forceinline__ unsigned qpk4(float a, float b, float c, float d, float s) {
    unsigned w = __builtin_amdgcn_cvt_pk_u8_f32(__builtin_fmaf(a, s, 128.f), 0, 0u); w = __builtin_amdgcn_cvt_pk_u8_f32(__builtin_fmaf(b, s, 128.f), 1, w);
    w = __builtin_amdgcn_cvt_pk_u8_f32(__builtin_fmaf(c, s, 128.f), 2, w); w = __builtin_amdgcn_cvt_pk_u8_f32(__builtin_fmaf(d, s, 128.f), 3, w); return w ^ 0x80808080u; }
struct EpiSwiGLU {
    static constexpr bool PERM = true, AFTER_DRAIN = false;
    bf16_t* ACT; float dq, qa;
    __device__ __forceinline__ void operator()(const f32x4 (&acc)[2][2][4][2], const Unit& u, int wr, int wc, int fr, int fq) const {
        const int row0 = u.pm * BM + wr * 64 + fr, col0 = (u.pn & 3) * 128 + wc * 32 + 8 * fq;
#pragma unroll
        for (int ai = 0; ai < 2; ++ai)
#pragma unroll
            for (int m = 0; m < 4; ++m) { float a[8];
#pragma unroll
                for (int n = 0; n < 2; ++n)
#pragma unroll
                    for (int e = 0; e < 4; ++e) { const float gb = acc[ai][0][m][n][e], ub = acc[ai][1][m][n][e];
                        const float gv = (float)__float_as_int(gb) * dq, uv = (float)__float_as_int(ub) * dq;
                        a[4 * n + e] = gv * __builtin_amdgcn_rcpf(1.f + __expf(-gv)) * uv; }
                u32x2e w; w.x = qpk4(a[0], a[1], a[2], a[3], qa); w.y = qpk4(a[4], a[5], a[6], a[7], qa);
                asm volatile("global_store_dwordx2 %0, %1, off sc0 sc1" :: "v"((unsigned char*)ACT + (size_t)(row0 + ai * HALF + m * 16) * 512 + col0), "v"(w) : "memory"); }
    }
};
struct EpiScatter {
    static constexpr bool PERM = true, AFTER_DRAIN = false;
    bf16_t* YS; const PG8_LAS int* stab; float dq;
    __device__ __forceinline__ void operator()(const f32x4 (&acc)[2][2][4][2], const Unit& u, int wr, int wc, int fr, int fq) const {
        const int col0 = (u.pn & 3) * BM + wc * 32 + 8 * fq;
#pragma unroll
        for (int ai = 0; ai < 2; ++ai)
#pragma unroll
            for (int m = 0; m < 4; ++m) { const int slot = stab[u.aux * 256 + ai * HALF + wr * 64 + m * 16 + fr];
                if (slot >= 0) { unsigned char* rp = (unsigned char*)YS + (size_t)slot * 1024 + col0;
#pragma unroll
                    for (int bj = 0; bj < 2; ++bj) { const f32x4 r0 = acc[ai][bj][m][0], r1 = acc[ai][bj][m][1];
                        const f32x4 v0 = (f32x4){(float)__float_as_int(r0.x), (float)__float_as_int(r0.y), (float)__float_as_int(r0.z), (float)__float_as_int(r0.w)} * dq, v1 = (f32x4){(float)__float_as_int(r1.x), (float)__float_as_int(r1.y), (float)__float_as_int(r1.z), (float)__float_as_int(r1.w)} * dq;
                        u32x2e w; w.x = (unsigned)__builtin_amdgcn_cvt_pk_fp8_f32(v0[2], v0[3], __builtin_amdgcn_cvt_pk_fp8_f32(v0[0], v0[1], 0, false), true);
                        w.y = (unsigned)__builtin_amdgcn_cvt_pk_fp8_f32(v1[2], v1[3], __builtin_amdgcn_cvt_pk_fp8_f32(v1[0], v1[1], 0, false), true); *(u32x2e*)(rp + bj * HALF) = w; } } }
    }
};
struct MoeSched {
    const PG8_LAS int* ut;
    const PG8_LAS unsigned* tab;
    __device__ __forceinline__ bool next(int i, Unit& u) const { if (i >= 8) return false; const int pm = __builtin_amdgcn_readfirstlane(ut[2 * i]); if (pm < 0) return false;
        u.pm = pm; u.pn = __builtin_amdgcn_readfirstlane(ut[2 * i + 1]); u.aux = i; return true; }
    unsigned* tc; int mode;
    __device__ __forceinline__ unsigned arow(int ui, int r) const { return tab[ui * 256 + r]; }
    __device__ __forceinline__ void a_ready(const Unit& u) const { if (mode == 2) { unsigned* q = tc + u.pm * 16;
        while (__hip_atomic_load(q, __ATOMIC_RELAXED, __HIP_MEMORY_SCOPE_AGENT) < 32u) __builtin_amdgcn_s_sleep(2);
        asm volatile("" ::: "memory"); } }
    __device__ __forceinline__ void done(const Unit& u) const { if (mode == 1) { asm volatile("s_waitcnt vmcnt(0)" ::: "memory");
        if ((threadIdx.x & 63) == 0) __hip_atomic_fetch_add(tc + u.pm * 16, 1u, __ATOMIC_RELAXED, __HIP_MEMORY_SCOPE_AGENT); } }
};
}

constexpr int LDS_BYTES = 151552;
constexpr int MOE_LDS = 131072;
constexpr int MISC_OFF = 147712;
constexpr int CW_BAR = 4096;
#define GAS __attribute__((address_space(1)))
#define LAS __attribute__((address_space(3)))
typedef GAS unsigned gu32;
typedef GAS unsigned long long gu64;
#define RLX_AGENT __ATOMIC_RELAXED, __HIP_MEMORY_SCOPE_AGENT
#define LDS_WAIT() asm volatile("s_waitcnt lgkmcnt(0)" ::: "memory")
#define VM_WAIT() asm volatile("s_waitcnt vmcnt(0)" ::: "memory")
#define XB_TMO      128
#define XB_XCNT(j)  (256  + 64 * (j))
#define XB_XSUB(j)  (1280 + 64 * (j))
#define XB_XGEN(j)  (2304 + 64 * (j))
#define XB_TOP      3328
#define XB_TOPGEN   3392
#define XCD_BAR_WORDS 3456
#define XB_SPIN_CAP (1u << 22)

__device__ __forceinline__ unsigned xb_ld(unsigned* p)              { return __hip_atomic_load(p, __ATOMIC_RELAXED, __HIP_MEMORY_SCOPE_AGENT); }
__device__ __forceinline__ unsigned xb_add(unsigned* p, unsigned v) { return __hip_atomic_fetch_add(p, v, __ATOMIC_RELAXED, __HIP_MEMORY_SCOPE_AGENT); }
__device__ __forceinline__ unsigned xb_xcc_id() { return (unsigned)__builtin_amdgcn_s_getreg((3 << 11) | 20) & 0xFu; }
#define XB_SPIN(cond, bar) do { unsigned _sp = 0; while (cond) { __builtin_amdgcn_s_sleep(1); \
    if ((++_sp & 255u) == 0u) { if (xb_ld(&(bar)[XB_TMO])) break; if (_sp > XB_SPIN_CAP) { atomicAdd(&(bar)[XB_TMO], 1u); break; } } } } while (0)

struct XcdBarrier {
    unsigned* bar; unsigned x;
    volatile LAS unsigned* st;
};

__device__ __forceinline__ XcdBarrier xcd_barrier_post(unsigned* bar, volatile LAS unsigned* st) {
    XcdBarrier b; b.bar = bar; b.x = xb_xcc_id(); b.st = st;
    if (threadIdx.x == 0) (void)xb_add(&bar[XB_XCNT(b.x)], 1u);
    return b;
}
__device__ __forceinline__ void xcd_barrier_complete(unsigned* bar, unsigned x, unsigned& nloc, unsigned& nx) {
    const unsigned G = gridDim.x * gridDim.y * gridDim.z;
    unsigned sum, cnt, mine, sp = 0u;
    for (;;) {
        sum = 0u; cnt = 0u; mine = 0u;
#pragma unroll
        for (unsigned j = 0; j < 16; ++j) { const unsigned c = xb_ld(&bar[XB_XCNT(j)]); sum += c; cnt += (c > 0u) ? 1u : 0u; mine = (j == x) ? c : mine; }
        if (sum == G) break;
        __builtin_amdgcn_s_sleep(1);
        if ((++sp & 255u) == 0u) { if (xb_ld(&bar[XB_TMO])) break; if (sp > XB_SPIN_CAP) { atomicAdd(&bar[XB_TMO], 1u); break; } }
    }
    nloc = mine > 0u ? mine : 1u; nx = cnt > 0u ? cnt : 1u;
}

__device__ __forceinline__ void xcd_barrier(const XcdBarrier& b) {
    asm volatile("s_waitcnt vmcnt(0)" ::: "memory");
    __syncthreads();
    if (threadIdx.x == 0) {
        unsigned* bar = b.bar;
        __builtin_amdgcn_s_waitcnt(0);
        unsigned nloc = b.st[0], nx = b.st[1];
        if (nloc == 0u) { xcd_barrier_complete(bar, b.x, nloc, nx); b.st[0] = nloc; b.st[1] = nx; }
        const unsigned old = xb_add(&bar[XB_XSUB(b.x)], 1u);
        const unsigned gen = old / nloc;
        if (old + 1u == (gen + 1u) * nloc) {
            __builtin_amdgcn_fence(__ATOMIC_RELEASE, "agent");
            asm volatile("s_waitcnt vmcnt(0)" ::: "memory");
            const unsigned og = xb_add(&bar[XB_TOP], 1u);
            const unsigned tg = og / nx;
            if (og + 1u == (tg + 1u) * nx) xb_add(&bar[XB_TOPGEN], 1u);
            else XB_SPIN(xb_ld(&bar[XB_TOPGEN]) == tg, bar);
            __builtin_amdgcn_fence(__ATOMIC_ACQUIRE, "agent");
            xb_add(&bar[XB_XGEN(b.x)], 1u);
            asm volatile("s_waitcnt vmcnt(0)" ::: "memory");
        } else {
            XB_SPIN(xb_ld(&bar[XB_XGEN(b.x)]) == gen, bar);
            __builtin_amdgcn_fence(__ATOMIC_ACQUIRE, "agent");
            asm volatile("s_waitcnt vmcnt(0)" ::: "memory");
        }
    }
    __syncthreads();
}

__device__ __forceinline__ void inproj_phase(const P& p, PG8_LAS unsigned char* l3, int c, int G) {
    pg8::Gemm g{(const bf16*)(p.ws + WS_H), (const bf16*)(p.ws + WS_WIN), T, NQKV, D};
    pg8::StaticOrder S; S.init(T, NQKV, G, c);
    const float* cosT = (const float*)(p.ws + WS_ROPE);
    pg8::EpiInProj E{(bf16*)(p.ws + WS_R), cosT, cosT + SEQ * 32, 0.125f * 1.4426950408889634f, 1.f / (Q8_ACT * Q8_W), (unsigned*)(p.ws + WS_CTL) + CW_SMIN, (unsigned*)(p.ws + WS_CTL) + CW_NORM};
    pg8::gemm_phase<pg8::EpiInProj, pg8::StaticOrder, true, true, false, true>(l3, g, S, E);
}
__device__ __forceinline__ void outproj_phase(const P& p, PG8_LAS unsigned char* l3, int c, int G) {
    pg8::Gemm g{(const bf16*)(p.ws + WS_H), (const bf16*)(p.ws + WS_WOUT), T, D, D};
    pg8::StaticOrder S; S.init(T, D, G, c);
    pg8::EpiBf16P E{(bf16*)(p.ws + WS_R), D, 1.f / (Q8_MIX * Q8_W)};
    pg8::gemm_phase<pg8::EpiBf16P, pg8::StaticOrder, true, true, false, true>(l3, g, S, E);
}
__device__ __forceinline__ void moe_setup(const P& p, PG8_LAS unsigned char* ldsx, int c, int G, bool down) {
    const int tid = tid_fresh();
    PG8_LAS int* ts = (PG8_LAS int*)ldsx; PG8_LAS int* ut = (PG8_LAS int*)(ldsx + 256); PG8_LAS int* tab = (PG8_LAS int*)(ldsx + 512);
    const unsigned* cnt = (const unsigned*)(p.ws + WS_CTL); const int* list = (const int*)(p.ws + WS_LIST);
    if (tid == 0) { int s = 0; for (int e = 0; e < NE; ++e) { ts[e] = s; s += ((int)cnt[e * CNT_STRIDE] + 255) >> 8; } ts[NE] = s; }
    __syncthreads();
    if (tid < 8) { const int NU = ts[NE] * 4, cv = down ? (c + G - NU % G) % G : c, L = tid * G + cv;
        if (L < NU) { const int t = L >> 2; int e = 0; for (int q = 1; q < NE; ++q) if (ts[q] <= t) e = q; ut[2 * tid] = t; ut[2 * tid + 1] = e * 4 + (L & 3); } else { ut[2 * tid] = -1; ut[2 * tid + 1] = 0; } }
    __syncthreads();
    for (int idx = tid; idx < 8 * 256; idx += 512) { const int i = idx >> 8, r = idx & 255, pm = ut[2 * i]; int v = down ? -1 : 0;
        if (pm >= 0) { const int e = ut[2 * i + 1] >> 2, k = (pm - ts[e]) * 256 + r; if (k < (int)cnt[e * CNT_STRIDE]) { const int slot = list[e * T + k]; v = down ? slot : (slot >> 1) * D; } }
        tab[idx] = v; }
    __syncthreads();
}
__device__ __forceinline__ void moe1_phase(const P& p, PG8_LAS unsigned char* l3, int c, int G) {
    moe_setup(p, l3 + MOE_LDS, c, G, false);
    pg8::Gemm g{(const bf16*)(p.ws + WS_H), (const bf16*)(p.ws + WS_WGU), 0, 0, D};
    pg8::MoeSched S{(const PG8_LAS int*)(l3 + MOE_LDS + 256), (const PG8_LAS unsigned*)(l3 + MOE_LDS + 512), (unsigned*)(p.ws + WS_CTL) + CW_TILE, 1};
    pg8::EpiSwiGLU E{(bf16*)(p.ws + WS_ACT), 1.f / (Q8_ACT * Q8_W), Q8_ACT2};
    pg8::gemm_phase<pg8::EpiSwiGLU, pg8::MoeSched, true, true, true, true>(l3, g, S, E);
}
__device__ __forceinline__ void moe2_phase(const P& p, PG8_LAS unsigned char* l3, int c, int G) {
    moe_setup(p, l3 + MOE_LDS, c, G, true);
    pg8::Gemm g{(const bf16*)(p.ws + WS_ACT), (const bf16*)(p.ws + WS_WD), 0, 0, DE};
    pg8::MoeSched S{(const PG8_LAS int*)(l3 + MOE_LDS + 256), (const PG8_LAS unsigned*)(l3 + MOE_LDS + 512), (unsigned*)(p.ws + WS_CTL) + CW_TILE, 2};
    pg8::EpiScatter E{(bf16*)(p.ws + WS_R), (const PG8_LAS int*)(l3 + MOE_LDS + 512), 16.f / (Q8_ACT2 * Q8_WD)};
    pg8::gemm_phase<pg8::EpiScatter, pg8::MoeSched, true, true, false, true, true>(l3, g, S, E);
}

namespace attn_body {
using bf16=__hip_bfloat16;
using bf16x8=__attribute__((ext_vector_type(8)))short;
using s16x4=__attribute__((ext_vector_type(4)))short;
using f32x16=__attribute__((ext_vector_type(16)))float;
using u32x4=__attribute__((ext_vector_type(4)))unsigned;
using f32x4v=__attribute__((ext_vector_type(4)))float;
constexpr int SEQ=4096,D=64,QP=3072,OP=1024;
constexpr int NW=8,QBLK=32,QB=QBLK*NW,KVBLK=64,NQB=SEQ/QB;
__device__ __forceinline__ int crow(int r,int hi){return (r&3)+8*(r>>2)+4*hi;}
#define SBAR() __builtin_amdgcn_sched_barrier(0)
__device__ __forceinline__ void cmask(f32x16&p0,f32x16&p1,int jb,int qrel,int hi){
  const float NEG=-INFINITY; int kb=64*jb+4*hi;
  #pragma unroll
  for(int r=0;r<16;++r){int kv=kb+(r&3)+8*(r>>2); if(kv>qrel)p0[r]=NEG; if(kv+32>qrel)p1[r]=NEG;}
}

__device__ __forceinline__ void chmask(f32x16&p0,f32x16&p1,int jb,int wid){
  const float NEG=-INFINITY;
  if(jb>(wid>>1)){
  #pragma unroll
  for(int r=0;r<16;++r){p0[r]=NEG;p1[r]=NEG;}}
}
constexpr int NSLOT=3, SLOTB=8192;
constexpr int LDS_K=0, LDS_V=NSLOT*SLOTB, LDS_WS=LDS_V+2*NSLOT*SLOTB, LDS_OST=LDS_WS+NW*64*4, LDS_BYTES=LDS_OST+NW*4096, LDS_FB=LDS_BYTES, LDS_Y=LDS_OST;
static_assert(LDS_Y+NW*8192<=147456 && LDS_FB+16384<=147456, "attention LDS map");
constexpr float C2=0.125f*1.4426950408889634f;
__device__ __forceinline__ void glds16(const void*gsrc,unsigned lds_dst){unsigned keep;
  asm volatile("s_mov_b32 %0, m0\n\ts_mov_b32 m0, %2\n\ts_nop 0\n\tglobal_load_lds_dwordx4 %1, off\n\ts_mov_b32 m0, %0":"=&s"(keep):"v"(gsrc),"s"(lds_dst):"memory");}
__device__ __forceinline__ void glds16s(const void*sbase0,unsigned voff,unsigned lds_dst){unsigned keep;
  const unsigned long long sb_=(unsigned long long)(uintptr_t)sbase0; const void*sbase=(const void*)(uintptr_t)(((unsigned long long)(unsigned)__builtin_amdgcn_readfirstlane((int)(sb_>>32))<<32)|(unsigned)__builtin_amdgcn_readfirstlane((int)sb_));
  asm volatile("s_mov_b32 %0, m0\n\ts_mov_b32 m0, %2\n\ts_nop 0\n\tglobal_load_lds_dwordx4 %1, %3\n\ts_mov_b32 m0, %0":"=&s"(keep):"v"(voff),"s"(lds_dst),"s"(sbase):"memory");}
__device__ __forceinline__ float max3f(float a,float b,float c){float r;asm("v_max3_f32 %0, %1, %2, %3":"=v"(r):"v"(a),"v"(b),"v"(c));return r;}
__device__ __forceinline__ float max2f(float a,float b){float r;asm("v_max_f32_e32 %0, %1, %2":"=v"(r):"v"(a),"v"(b));return r;}
__device__ __forceinline__ float fadd_s(float a,float b){float r;asm("v_add_f32_e32 %0, %1, %2":"=v"(r):"v"(a),"v"(b));return r;}
__device__ __forceinline__ float fsub_s(float a,float b){float r;asm("v_sub_f32_e32 %0, %1, %2":"=v"(r):"v"(a),"v"(b));return r;}
typedef float f32x2_t __attribute__((ext_vector_type(2))); typedef __bf16 bf16x2_t __attribute__((ext_vector_type(2)));
__device__ __forceinline__ unsigned cvtpk_s(float lo,float hi){f32x2_t v={lo,hi};bf16x2_t b=__builtin_convertvector(v,bf16x2_t);return __builtin_bit_cast(unsigned,b);}
#define WAIT_BAR(N) asm volatile("s_waitcnt vmcnt(" #N ") lgkmcnt(0)\n\ts_barrier":::"memory")

__device__ __forceinline__ void qkt(f32x16&p0,f32x16&p1,const char*Kslot,const bf16x8*qr,const f32x16&negm,int r32,int hi){
  const char*kb=Kslot+hi*1024+r32*16;
  #pragma unroll
  for(int d0=0;d0<4;++d0){
    const bf16x8 b0=*reinterpret_cast<const bf16x8*>(kb+d0*2048);
    const bf16x8 b1=*reinterpret_cast<const bf16x8*>(kb+d0*2048+512);
    if(d0==0){p0=__builtin_amdgcn_mfma_f32_32x32x16_bf16(b0,qr[0],negm,0,0,0);p1=__builtin_amdgcn_mfma_f32_32x32x16_bf16(b1,qr[0],negm,0,0,0);}
    else{p0=__builtin_amdgcn_mfma_f32_32x32x16_bf16(b0,qr[d0],p0,0,0,0);p1=__builtin_amdgcn_mfma_f32_32x32x16_bf16(b1,qr[d0],p1,0,0,0);}}
}
__device__ __forceinline__ void qkt_acc(f32x16&p0,f32x16&p1,const char*Kslot,const bf16x8*qr,int r32,int hi){
  const char*kb=Kslot+hi*1024+r32*16;
  #pragma unroll
  for(int d0=0;d0<4;++d0){
    const bf16x8 b0=*reinterpret_cast<const bf16x8*>(kb+d0*2048);
    const bf16x8 b1=*reinterpret_cast<const bf16x8*>(kb+d0*2048+512);
    p0=__builtin_amdgcn_mfma_f32_32x32x16_bf16(b0,qr[d0],p0,0,0,0);p1=__builtin_amdgcn_mfma_f32_32x32x16_bf16(b1,qr[d0],p1,0,0,0);}
}
typedef __attribute__((address_space(3))) const float* lds_fptr;
__device__ __forceinline__ void bias4(f32x16&p,lds_fptr fb,int g){ const f32x4v v=*(const __attribute__((address_space(3))) f32x4v*)(fb+8*g); p[4*g]=v[0];p[4*g+1]=v[1];p[4*g+2]=v[2];p[4*g+3]=v[3]; }
__device__ __forceinline__ void sub4(f32x16&p,int g,float mh){ p[4*g]-=mh;p[4*g+1]-=mh;p[4*g+2]-=mh;p[4*g+3]-=mh; }
typedef __attribute__((address_space(3))) const char* lds_cptr;
typedef short v4i16_t __attribute__((ext_vector_type(4)));
__device__ __forceinline__ void kload8(bf16x8*kf,lds_cptr kp){
  kf[0]=*(const __attribute__((address_space(3))) bf16x8*)(kp);      kf[1]=*(const __attribute__((address_space(3))) bf16x8*)(kp+512);
  kf[2]=*(const __attribute__((address_space(3))) bf16x8*)(kp+2048); kf[3]=*(const __attribute__((address_space(3))) bf16x8*)(kp+2560);
  kf[4]=*(const __attribute__((address_space(3))) bf16x8*)(kp+4096); kf[5]=*(const __attribute__((address_space(3))) bf16x8*)(kp+4608);
  kf[6]=*(const __attribute__((address_space(3))) bf16x8*)(kp+6144); kf[7]=*(const __attribute__((address_space(3))) bf16x8*)(kp+6656);
}
__device__ __forceinline__ void kload2(bf16x8*kf,lds_cptr kp,int j){ kf[2*j]=*(const __attribute__((address_space(3))) bf16x8*)(kp+j*2048); kf[2*j+1]=*(const __attribute__((address_space(3))) bf16x8*)(kp+j*2048+512); }
__device__ __forceinline__ s16x4 vtr(lds_cptr p){ return __builtin_bit_cast(s16x4,__builtin_amdgcn_ds_read_tr16_b64_v4i16((__attribute__((address_space(3))) v4i16_t*)p)); }
__device__ __forceinline__ float rowmax(const f32x16&p0,const f32x16&p1){
  float a=max3f(p0[0],p0[1],p1[0]),b=max3f(p0[2],p0[3],p1[1]);a=max3f(a,p1[2],p1[3]);
  #pragma unroll
  for(int r=4;r<16;r+=4){a=max3f(a,p0[r],p0[r+1]);b=max3f(b,p0[r+2],p0[r+3]);a=max3f(a,p1[r],p1[r+1]);b=max3f(b,p1[r+2],p1[r+3]);}
  const float m=max2f(a,b);
  auto rr=__builtin_amdgcn_permlane32_swap(__float_as_uint(m),__float_as_uint(m),false,false);
  return max2f(__uint_as_float(rr[0]),__uint_as_float(rr[1]));
}
template<int ND> __device__ __forceinline__ void pv(f32x16*o,int vb,bf16x8 pa0,bf16x8 pa1,bf16x8 pa2,bf16x8 pa3){
  #pragma unroll
  for(int d0=0;d0<ND;++d0){s16x4 lo[4],hi[4];
    #pragma unroll
    for(int ks=0;ks<4;++ks){
      asm volatile("ds_read_b64_tr_b16 %0,%1 offset:%c2":"=&v"(lo[ks]):"v"(vb),"i"(d0*4096+ks*1024):"memory");
      asm volatile("ds_read_b64_tr_b16 %0,%1 offset:%c2":"=&v"(hi[ks]):"v"(vb),"i"(d0*4096+ks*1024+512):"memory");}
    asm volatile("s_waitcnt lgkmcnt(0)":::"memory");SBAR();
    #define PK(k) (bf16x8){lo[k][0],lo[k][1],lo[k][2],lo[k][3],hi[k][0],hi[k][1],hi[k][2],hi[k][3]}
    o[d0]=__builtin_amdgcn_mfma_f32_32x32x16_bf16(pa0,PK(0),o[d0],0,0,0);
    o[d0]=__builtin_amdgcn_mfma_f32_32x32x16_bf16(pa1,PK(1),o[d0],0,0,0);
    o[d0]=__builtin_amdgcn_mfma_f32_32x32x16_bf16(pa2,PK(2),o[d0],0,0,0);
    o[d0]=__builtin_amdgcn_mfma_f32_32x32x16_bf16(pa3,PK(3),o[d0],0,0,0);
    #undef PK
  }
}

#ifndef ATTN_STORE16
#define ATTN_STORE16(p,v) (*(u32x4*)(p)=(v))
#endif
template<int THRL,int MODE,class Epi,bool UREF=false> __device__ __forceinline__ void attn_unit(int qb,int t0,const bf16*Q,const bf16*__restrict__ K,const bf16*__restrict__ V,char*shm,const Epi&epi){
  const int tid=tid_fresh(),lane=tid&63,r32=lane&31,hi=lane>>5; const int wid=__builtin_amdgcn_readfirstlane(tid>>6);
  constexpr int VM=(MODE==1)?2:1, ND=(MODE==1)?4:2;
  const int q0=qb*QB;
  const bf16*Qw=Q+(long)(q0+wid*QBLK)*QP;
  const bf16*Kh=K+(long)t0*KVBLK*QP,*Vh=V+(long)t0*KVBLK*QP;
  const unsigned lds0=(unsigned)(uintptr_t)shm;
  float*wsf=(float*)(shm+LDS_WS)+wid*64;
  const unsigned koff=(unsigned)((lane*QP+wid*8)*2), voff=(unsigned)(((16*(wid&3)+(lane>>2))*QP+(wid>>2)*32+(lane&3)*8)*2);
  const unsigned kdst=lds0+LDS_K+wid*1024, vdst=lds0+LDS_V+wid*1024;
  #define DMA_K(t,slot) glds16s(Kh+(long)(t)*KVBLK*QP,koff,(unsigned)__builtin_amdgcn_readfirstlane(kdst+(slot)))
  #define DMA_V(t,slot) do{ glds16s(Vh+(long)(t)*KVBLK*QP,voff,(unsigned)__builtin_amdgcn_readfirstlane(vdst+VM*(slot))); if constexpr(MODE==1) glds16s(Vh+64+(long)(t)*KVBLK*QP,voff,(unsigned)__builtin_amdgcn_readfirstlane(vdst+VM*(slot)+8192)); }while(0)
  const int vb0=(int)(lds0+LDS_V)+((lane>>4)&1)*32+(lane&3)*8+(4*hi+((lane&15)>>2))*64;
  const char*Kbase=shm+LDS_K; bf16x8 kf[8];
  const lds_cptr shm3=(lds_cptr)shm; const lds_fptr fb0=(lds_fptr)(shm3+LDS_FB)+4*hi; const lds_cptr kp0=shm3+LDS_K+hi*1024+r32*16; const lds_cptr vp0=shm3+LDS_V+((lane>>4)&1)*32+(lane&3)*8+(4*hi+((lane&15)>>2))*64;
  const int NT=(q0+QB)/KVBLK-t0;
  DMA_K(0,0);DMA_V(0,0);DMA_K(1,SLOTB);
  bf16x8 qr[4];
  #pragma unroll
  for(int d0=0;d0<4;++d0)qr[d0]=*reinterpret_cast<const bf16x8*>(&Qw[(long)r32*QP+d0*16+hi*8]);
  const f32x16 zero16=f32x16{}; float mhat=0.f,l_reg=0.f;f32x16 o[ND];
  #pragma unroll
  for(int d_=0;d_<ND;++d_)o[d_]=f32x16{};
  const int qrel=wid*QBLK+r32;
  #define CMASK(P0,P1,t) do{int jb_=(t)-(NT-4); if(jb_>=0){ if constexpr(MODE==0)cmask(P0,P1,jb_,qrel,hi); else chmask(P0,P1,jb_,wid);} }while(0)
  bool resc=false;
  #define START(P0,P1) do{ resc=false; \
    _Pragma("unroll") for(int r=0;r<16;++r)P0[r]=__builtin_amdgcn_exp2f(P0[r]); }while(0)
  #define RESC() do{ if(resc){ asm volatile("s_waitcnt lgkmcnt(0)":::"memory"); \
      _Pragma("unroll") for(int d_=0;d_<ND;++d_) _Pragma("unroll") for(int r=0;r<16;++r)o[d_][r]*=wsf[crow(r,hi)]; } }while(0)
  f32x16 pA0,pA1,pB0,pB1;
  int sl_prev=0,sl_cur=0,sl_next=SLOTB;
  #define ROT() do{sl_prev=sl_cur;sl_cur=sl_next;sl_next=(sl_next==(NSLOT-1)*SLOTB)?0:sl_next+SLOTB;}while(0)
  DMA_K(2,2*SLOTB);
  #define WB(n0,n1) do{ if constexpr(MODE==1){WAIT_BAR(n1);} else {WAIT_BAR(n0);} }while(0)
  WB(3,4);
  if constexpr(MODE==0){ if constexpr(!UREF) mhat=((lds_fptr)(shm3+LDS_FB))[q0-t0*KVBLK+wid*QBLK+r32]+8.0f;
    _Pragma("unroll") for(int g=0;g<4;++g){bias4(pA0,fb0,g);if constexpr(!UREF)sub4(pA0,g,mhat);bias4(pA1,fb0+32,g);if constexpr(!UREF)sub4(pA1,g,mhat);} }
  else { pA0=f32x16{}; pA1=f32x16{}; }
  qkt_acc(pA0,pA1,Kbase,qr,r32,hi);
  asm volatile("s_nop 15\n\ts_nop 7":"+v"(pA0),"+v"(pA1));CMASK(pA0,pA1,0);
  START(pA0,pA1);
  if constexpr(MODE==0){ _Pragma("unroll") for(int g=0;g<4;++g){bias4(pB0,fb0+64,g);if constexpr(!UREF)sub4(pB0,g,mhat);bias4(pB1,fb0+96,g);if constexpr(!UREF)sub4(pB1,g,mhat);} }

  _Pragma("unroll") for(int r=0;r<16;++r)pA1[r]=__builtin_amdgcn_exp2f(pA1[r]);
  WAIT_BAR(0);
  DMA_K(3,0);DMA_V(1,SLOTB);
  ROT();
  kload8(kf,kp0+sl_cur);
  WB(2,3);
  s16x4 vlo[8],vhi[8]; u32x4 pw0,pw1,pw2,pw3;
  #define PKW(P,B) cvtpk_s(P[B],P[B+1])
  #define PAF(k) __builtin_bit_cast(bf16x8,pw##k)
  #define VFR(i) (bf16x8){vlo[i][0],vlo[i][1],vlo[i][2],vlo[i][3],vhi[i][0],vhi[i][1],vhi[i][2],vhi[i][3]}
  #define PIN(x) asm volatile("":"+v"(x))
  #define MX3(a,b,c) __builtin_fmaxf(__builtin_fmaxf((a),(b)),(c))
  #define GAPA(MF,A0,A1,A2,A3,W0,W1,PW) do{ MF; sacc+=A0; sacc+=A1; sacc+=A2; sacc+=A3; PIN(sacc); W0; W1; PIN(PW); SBAR(); }while(0)
  #define EX(v) __builtin_amdgcn_exp2f(v)
  #define GAPB(MF,X,B) do{ MF; X[B]=EX(X[B]); X[B+1]=EX(X[B+1]); X[B+2]=EX(X[B+2]); X[B+3]=EX(X[B+3]); PIN(X); SBAR(); }while(0)
  #define VRD(i) do{ vlo[i]=vtr(vp_+(((i)>>2)*4096+((i)&3)*1024)); vhi[i]=vtr(vp_+(((i)>>2)*4096+((i)&3)*1024+512)); }while(0)
  #define KRD(G,j) do{ if(G){ kload2(kf,kp0+sl_next,j); SBAR(); } }while(0)
  #define CIN(X) (MODE==1?zero16:X)
  #define GAPB2(MF,RD,X,B) do{ MF; RD; X[B]=EX(X[B]); X[B+1]=EX(X[B+1]); PIN(X); SBAR(); }while(0)
  #define VF(k) do{ vlo[(k)&3]=vtr(vp_+(((k)>>3)*8192+((k)&1)*4096+(((k)&7)>>1)*1024)); vhi[(k)&3]=vtr(vp_+(((k)>>3)*8192+((k)&1)*4096+(((k)&7)>>1)*1024+512)); }while(0)
  #define VRDA(i) do{ if constexpr(MODE==0){ VRD(i); } else { if((i)==2){VF(0);} else if((i)==6){VF(1);} else if((i)==3){VF(2);} else if((i)==7){VF(3);} } }while(0)
  #define VFQ(q) (bf16x8){vlo[q][0],vlo[q][1],vlo[q][2],vlo[q][3],vhi[q][0],vhi[q][1],vhi[q][2],vhi[q][3]}
  #define PFM(G,P,g) do{ (void)nm_; }while(0)
  #define PFR(G,P,i,t) do{ if constexpr(MODE==0){ if(G){ bias4(P,fb0+64*((t)+1)+32*((i)>>2),(i)&3); } } }while(0)
  #define PFS(G,P,i) do{ if constexpr(MODE==0&&!UREF){ if(G){ sub4(P,(i)&3,mhat); PIN(P); } } }while(0)
  #define STEP(C0,C1,P0,P1,t,GK,GV,GL) do{ SBAR(); \
    const lds_cptr vp_=vp0+VM*sl_prev; \
    VRDA(0); SBAR(); float sacc=(P0[0]+P0[1]); \
    GAPA(C0=__builtin_amdgcn_mfma_f32_32x32x16_bf16(kf[0],qr[0],CIN(C0),0,0,0), P0[2],P0[3],P0[4],P0[5],     pw0[0]=PKW(P0,0), pw0[1]=PKW(P0,2), pw0); \
    VRDA(4); SBAR(); GAPA(C1=__builtin_amdgcn_mfma_f32_32x32x16_bf16(kf[1],qr[0],CIN(C1),0,0,0), P0[6],P0[7],P0[8],P0[9],     pw0[2]=PKW(P0,4), pw0[3]=PKW(P0,6), pw0); \
    PFR(GL,P0,0,t); VRDA(1); SBAR(); GAPA(C0=__builtin_amdgcn_mfma_f32_32x32x16_bf16(kf[2],qr[1],C0,0,0,0),   P0[10],P0[11],P0[12],P0[13], pw1[0]=PKW(P0,8), pw1[1]=PKW(P0,10), pw1); \
    PFR(GL,P0,1,t); VRDA(5); SBAR(); GAPA(C1=__builtin_amdgcn_mfma_f32_32x32x16_bf16(kf[3],qr[1],C1,0,0,0),   P0[14],P0[15],P1[0],P1[1],   pw1[2]=PKW(P0,12),pw1[3]=PKW(P0,14), pw1); \
    PFR(GL,P0,2,t); VRDA(2); SBAR(); GAPA(C0=__builtin_amdgcn_mfma_f32_32x32x16_bf16(kf[4],qr[2],C0,0,0,0),   P1[2],P1[3],P1[4],P1[5],     pw2[0]=PKW(P1,0), pw2[1]=PKW(P1,2), pw2); \
    PFR(GL,P0,3,t); VRDA(6); SBAR(); GAPA(C1=__builtin_amdgcn_mfma_f32_32x32x16_bf16(kf[5],qr[2],C1,0,0,0),   P1[6],P1[7],P1[8],P1[9],     pw2[2]=PKW(P1,4), pw2[3]=PKW(P1,6), pw2); \
    PFR(GL,P1,4,t); VRDA(3); SBAR(); GAPA(C0=__builtin_amdgcn_mfma_f32_32x32x16_bf16(kf[6],qr[3],C0,0,0,0),   P1[10],P1[11],P1[12],P1[13], pw3[0]=PKW(P1,8), pw3[1]=PKW(P1,10), pw3); \
    PFR(GL,P1,5,t); VRDA(7); SBAR(); GAPA(C1=__builtin_amdgcn_mfma_f32_32x32x16_bf16(kf[7],qr[3],C1,0,0,0),   P1[14],P1[15],0.f,0.f,       pw3[2]=PKW(P1,12),pw3[3]=PKW(P1,14), pw3); \
    l_reg+=sacc; \
    if(GK){DMA_K((t)+3,sl_cur);} if(GV){DMA_V((t)+1,sl_next);} \
    CMASK(C0,C1,t); \
    resc=false; \
    if constexpr(false)   \
    { float a=MX3(C0[0],C0[1],C1[0]),b=MX3(C0[2],C0[3],C1[1]); a=MX3(a,C1[2],C1[3]); \
      _Pragma("unroll") for(int r=4;r<16;r+=4){a=MX3(a,C0[r],C0[r+1]);b=MX3(b,C0[r+2],C0[r+3]);a=MX3(a,C1[r],C1[r+1]);b=MX3(b,C1[r+2],C1[r+3]);} \
      float rm=__builtin_fmaxf(a,b); { auto rr=__builtin_amdgcn_permlane32_swap(__float_as_uint(rm),__float_as_uint(rm),false,false); rm=__builtin_fmaxf(__uint_as_float(rr[0]),__uint_as_float(rr[1])); } \
      resc=false; \
      if(__builtin_expect(__any(rm>(float)THRL),0)){ const float dl=__builtin_fmaxf(rm,0.f); mhat+=dl; \
        _Pragma("unroll") for(int r=0;r<16;++r){C0[r]-=dl;C1[r]-=dl;} \
        const float f=__builtin_amdgcn_exp2f(-dl); l_reg*=f; if(hi==0)wsf[r32]=f; resc=true; } } \
    SBAR(); \
    if constexpr(MODE==0){ \
    PFR(GL,P1,6,t); PFS(GL,P0,0); PFS(GL,P0,1); GAPB(o[0]=__builtin_amdgcn_mfma_f32_32x32x16_bf16(PAF(0),VFR(0),o[0],0,0,0), C0,0); \
    PFR(GL,P1,7,t); PFS(GL,P0,2); PFS(GL,P0,3); GAPB(o[1]=__builtin_amdgcn_mfma_f32_32x32x16_bf16(PAF(0),VFR(4),o[1],0,0,0), C0,4); \
    PFS(GL,P1,4); KRD(GL,0); GAPB(o[0]=__builtin_amdgcn_mfma_f32_32x32x16_bf16(PAF(1),VFR(1),o[0],0,0,0), C0,8); \
    PFS(GL,P1,5); KRD(GL,1); GAPB(o[1]=__builtin_amdgcn_mfma_f32_32x32x16_bf16(PAF(1),VFR(5),o[1],0,0,0), C0,12); \
    PFS(GL,P1,6); KRD(GL,2); GAPB(o[0]=__builtin_amdgcn_mfma_f32_32x32x16_bf16(PAF(2),VFR(2),o[0],0,0,0), C1,0); \
    PFS(GL,P1,7); KRD(GL,3); GAPB(o[1]=__builtin_amdgcn_mfma_f32_32x32x16_bf16(PAF(2),VFR(6),o[1],0,0,0), C1,4); \
    GAPB(o[0]=__builtin_amdgcn_mfma_f32_32x32x16_bf16(PAF(3),VFR(3),o[0],0,0,0), C1,8); \
    GAPB(o[1]=__builtin_amdgcn_mfma_f32_32x32x16_bf16(PAF(3),VFR(7),o[1],0,0,0), C1,12); \
    } else { \
    const float nm_=-mhat; \
    GAPB2(o[0]=__builtin_amdgcn_mfma_f32_32x32x16_bf16(PAF(0),VFQ(0),o[0],0,0,0), VF(4), C0,0); \
    GAPB2(o[1]=__builtin_amdgcn_mfma_f32_32x32x16_bf16(PAF(0),VFQ(1),o[1],0,0,0), VF(5), C0,2); \
    KRD(GL,0); GAPB2(o[0]=__builtin_amdgcn_mfma_f32_32x32x16_bf16(PAF(1),VFQ(2),o[0],0,0,0), VF(6), C0,4); \
    KRD(GL,1); GAPB2(o[1]=__builtin_amdgcn_mfma_f32_32x32x16_bf16(PAF(1),VFQ(3),o[1],0,0,0), VF(7), C0,6); \
    KRD(GL,2); GAPB2(o[0]=__builtin_amdgcn_mfma_f32_32x32x16_bf16(PAF(2),VFQ(0),o[0],0,0,0), VF(8), C0,8); \
    KRD(GL,3); GAPB2(o[1]=__builtin_amdgcn_mfma_f32_32x32x16_bf16(PAF(2),VFQ(1),o[1],0,0,0), VF(9), C0,10); \
    GAPB2(o[0]=__builtin_amdgcn_mfma_f32_32x32x16_bf16(PAF(3),VFQ(2),o[0],0,0,0), VF(10), C0,12); \
    GAPB2(o[1]=__builtin_amdgcn_mfma_f32_32x32x16_bf16(PAF(3),VFQ(3),o[1],0,0,0), VF(11), C0,14); \
    GAPB2(o[2]=__builtin_amdgcn_mfma_f32_32x32x16_bf16(PAF(0),VFQ(0),o[2],0,0,0), VF(12); PFM(GL,P0,0), C1,0); \
    GAPB2(o[3]=__builtin_amdgcn_mfma_f32_32x32x16_bf16(PAF(0),VFQ(1),o[3],0,0,0), VF(13); PFM(GL,P0,1), C1,2); \
    GAPB2(o[2]=__builtin_amdgcn_mfma_f32_32x32x16_bf16(PAF(1),VFQ(2),o[2],0,0,0), VF(14); PFM(GL,P0,2), C1,4); \
    GAPB2(o[3]=__builtin_amdgcn_mfma_f32_32x32x16_bf16(PAF(1),VFQ(3),o[3],0,0,0), VF(15); PFM(GL,P0,3), C1,6); \
    GAPB2(o[2]=__builtin_amdgcn_mfma_f32_32x32x16_bf16(PAF(2),VFQ(0),o[2],0,0,0), (void)0; PFM(GL,P1,0), C1,8); \
    GAPB2(o[3]=__builtin_amdgcn_mfma_f32_32x32x16_bf16(PAF(2),VFQ(1),o[3],0,0,0), (void)0; PFM(GL,P1,1), C1,10); \
    GAPB2(o[2]=__builtin_amdgcn_mfma_f32_32x32x16_bf16(PAF(3),VFQ(2),o[2],0,0,0), (void)0; PFM(GL,P1,2), C1,12); \
    GAPB2(o[3]=__builtin_amdgcn_mfma_f32_32x32x16_bf16(PAF(3),VFQ(3),o[3],0,0,0), (void)0; PFM(GL,P1,3), C1,14); \
    } \
    }while(0)
  int t=1;
  #undef CMASK
  #define CMASK(P0,P1,t) do{}while(0)
  for(;t+5<NT;t+=2){
    STEP(pB0,pB1,pA0,pA1,t,true,true,true);     WB(2,3); RESC(); ROT();
    STEP(pA0,pA1,pB0,pB1,t+1,true,true,true);   WB(2,3); RESC(); ROT();
  }
  #undef CMASK
  #define CMASK(P0,P1,t) do{int jb_=(t)-(NT-4); if(jb_>=0){ if constexpr(MODE==0)cmask(P0,P1,jb_,qrel,hi); else chmask(P0,P1,jb_,wid);} }while(0)
  #define ENDW(tt) do{ if((tt)+3<NT){WB(2,3);} else if((tt)+2<NT){WB(1,2);} else {WAIT_BAR(0);} }while(0)
  for(;t+1<NT;t+=2){
    STEP(pB0,pB1,pA0,pA1,t,(t+3<NT),(t+1<NT),(t+1<NT));       ENDW(t);   RESC(); ROT();
    STEP(pA0,pA1,pB0,pB1,t+1,(t+4<NT),(t+2<NT),(t+2<NT));     ENDW(t+1); RESC(); ROT();
  }
  STEP(pB0,pB1,pA0,pA1,NT-1,false,false,false); RESC();
  { float sacc=pB0[0]+pB0[1]; _Pragma("unroll") for(int r=2;r<16;++r)sacc+=pB0[r]; _Pragma("unroll") for(int r=0;r<16;++r)sacc+=pB1[r]; l_reg+=sacc;
    pw0=(u32x4){PKW(pB0,0),PKW(pB0,2),PKW(pB0,4),PKW(pB0,6)};pw1=(u32x4){PKW(pB0,8),PKW(pB0,10),PKW(pB0,12),PKW(pB0,14)};pw2=(u32x4){PKW(pB1,0),PKW(pB1,2),PKW(pB1,4),PKW(pB1,6)};pw3=(u32x4){PKW(pB1,8),PKW(pB1,10),PKW(pB1,12),PKW(pB1,14)};
    SBAR(); pv<ND>(o,vb0+VM*sl_cur,PAF(0),PAF(1),PAF(2),PAF(3)); }
  #undef PKW
  #undef PAF
  #undef VFR
  #undef PIN
  #undef MX3
  #undef GAPA
  #undef GAPB
  #undef EX
  #undef VRD
  #undef KRD
  #undef STEP
  #undef CIN
  #undef PFR
  #undef PFS
  #undef GAPB2
  #undef VF
  #undef VRDA
  #undef VFQ
  #undef PFM
  #undef WB
  #undef ENDW
  {auto rr=__builtin_amdgcn_permlane32_swap(__float_as_uint(l_reg),__float_as_uint(l_reg),false,false);l_reg=__uint_as_float(rr[0])+__uint_as_float(rr[1]);}
  if(hi==0)wsf[32+r32]=l_reg;asm volatile("s_waitcnt lgkmcnt(0)":::"memory");
  float rli[16];
  #pragma unroll
  for(int r=0;r<16;++r)rli[r]=__builtin_amdgcn_rcpf(wsf[32+crow(r,hi)]);
  epi(o,rli,shm,q0,wid,lane,r32,hi);
  asm volatile("s_waitcnt lgkmcnt(0)\n\ts_barrier":::"memory");
  #undef DMA_K
  #undef DMA_V
  #undef CMASK
  #undef START
  #undef RESC
  #undef ROT
}

typedef unsigned u32x2q __attribute__((ext_vector_type(2)));
__device__ __forceinline__ unsigned q4i8(float a,float b,float c,float d){ unsigned w=__builtin_amdgcn_cvt_pk_u8_f32((a+128.f),0,0u); w=__builtin_amdgcn_cvt_pk_u8_f32((b+128.f),1,w); w=__builtin_amdgcn_cvt_pk_u8_f32((c+128.f),2,w); w=__builtin_amdgcn_cvt_pk_u8_f32((d+128.f),3,w); return w^0x80808080u; }
constexpr float QMIX=127.f/4.f;
struct EpiFox {
  bf16*O;
  __device__ __forceinline__ void operator()(const f32x16(&o)[2],const float(&rli)[16],char*shm,int q0,int wid,int lane,int r32,int hi)const{
    signed char*Ow=(signed char*)O+(long)(q0+wid*QBLK)*OP; signed char*stg=(signed char*)(shm+LDS_OST)+wid*2048;
    #pragma unroll
    for(int r=0;r<16;++r){const int orow=crow(r,hi);
      #pragma unroll
      for(int d0=0;d0<2;++d0)stg[orow*64+d0*32+r32]=(signed char)__float2int_rn(fminf(fmaxf(o[d0][r]*rli[r]*QMIX,-127.f),127.f));}
    asm volatile("s_waitcnt lgkmcnt(0)":::"memory");
    #pragma unroll
    for(int i=0;i<4;++i){const int row=i*8+(lane>>3),ch=lane&7; const u32x2q v=*(const u32x2q*)(stg+row*64+ch*8); *(u32x2q*)(Ow+(long)row*OP+ch*8)=v;} }
};
struct EpiDiff {
  bf16*O; const float*gsub; float lam; int map;
  __device__ __forceinline__ void operator()(const f32x16(&o)[4],const float(&rli)[16],char*shm,int q0,int wid,int lane,int r32,int hi)const{
    bf16*Y=(bf16*)(shm+LDS_Y)+wid*4096;
    if(map==0){
      #pragma unroll
      for(int r=0;r<16;++r){const int orow=crow(r,hi);
        #pragma unroll
        for(int d0=0;d0<4;++d0)Y[orow*128+d0*32+r32]=__float2bfloat16(o[d0][r]*rli[r]);}
    } else {
      #pragma unroll
      for(int r=0;r<16;++r){const int orow=crow(r,hi);
        #pragma unroll
        for(int d0=0;d0<4;++d0){const int idx=orow*128+d0*32+r32; Y[idx]=__float2bfloat16(__bfloat162float(Y[idx])-lam*(o[d0][r]*rli[r]));}}
      asm volatile("s_waitcnt lgkmcnt(0)":::"memory");
      signed char*Ow=(signed char*)O+(long)(q0+wid*QBLK)*OP;
      #pragma unroll
      for(int i=0;i<8;++i){const int row=i*4+(lane>>4),ch=lane&15; const u32x4 v=*(const u32x4*)(Y+row*128+ch*8);
        float f[8];
        #pragma unroll
        for(int e=0;e<4;++e){f[2*e]=__builtin_bit_cast(float,v[e]<<16);f[2*e+1]=__builtin_bit_cast(float,v[e]&0xffff0000u);}
        float ss=0.f;
        #pragma unroll
        for(int e=0;e<8;++e)ss+=f[e]*f[e];
        ss+=__shfl_xor(ss,1);ss+=__shfl_xor(ss,2);ss+=__shfl_xor(ss,4);ss+=__shfl_xor(ss,8);
        const float rinv=rsqrtf(ss*(1.f/128.f)+1e-6f)*0.8f;
        const f32x4v g0=*(const f32x4v*)(gsub+ch*8),g1=*(const f32x4v*)(gsub+ch*8+4);
        const float rq=rinv*QMIX; u32x2q w; w[0]=q4i8(f[0]*rq*g0[0],f[1]*rq*g0[1],f[2]*rq*g0[2],f[3]*rq*g0[3]); w[1]=q4i8(f[4]*rq*g1[0],f[5]*rq*g1[1],f[6]*rq*g1[2],f[7]*rq*g1[3]);
        *(u32x2q*)(Ow+(long)row*OP+ch*8)=w; }
    }
  }
};
#undef SBAR
#undef WAIT_BAR
}

__device__ __forceinline__ void attn_phase(const P& p, char* lds, int c, int G) {
    using attn_body::QP; using attn_body::OP; using attn_body::LDS_FB; using attn_body::EpiDiff; using attn_body::EpiFox; using attn_body::attn_unit;
    const int tid = tid_fresh(), lane = tid & 63;
    const int vcu = (G % 8 == 0) ? (c % 8) * (G / 8) + c / 8 : c;
    const attn_body::bf16* QKV = (const attn_body::bf16*)(p.ws + WS_R); attn_body::bf16* MIX = (attn_body::bf16*)(p.ws + WS_H);
    const float lam = ((const float*)(p.ws + WS_SCAL))[0];
    const float* FB = (const float*)(p.ws + WS_F);
    for (int item = vcu; item < 256; item += G) {
        const int bh = item >> 3, s = item & 7, b = bh >> 2, h = bh & 3;
        const attn_body::bf16* base = QKV + (size_t)b * SEQ * QP;
        for (int qi = 0; qi < 2; ++qi) { const int qb = qi ? s : 15 - s;
            for (int map = 0; map < 2; ++map) {
                const EpiDiff E{(attn_body::bf16*)((signed char*)MIX + (size_t)b * SEQ * OP + h * 128), p.g_subln, lam, map};
                attn_unit<8, 1>(qb, 0, base + (2 * h + map) * 64, base + 512 + (2 * h + map) * 64, base + 1024 + h * 128, lds, E);
                if (qi == 0) { const int nr = (CV_ITEMS - CV_IN + G * 8 - 1) / (G * 8), hr = (nr + 1) / 2;
                    convert_items(p, (unsigned char*)lds, c, G, CV_IN, CV_ITEMS, map ? hr : 0, map ? nr : hr); } } }
    }
    {
        unsigned* ctl = (unsigned*)(p.ws + WS_CTL); volatile int* ubox = (volatile int*)(lds + LDS_FB + 16384);
        const int nb_q = (G % 8 == 0) ? 1 : 8;
        for (int bi = 0; bi < nb_q; ++bi) { const int b = (G % 8 == 0) ? (c % 8) : bi;
            for (;;) {
                if (tid == 0) *ubox = (int)atomicAdd(ctl + CW_FOXQ + 64 * b, 1u);
                __syncthreads();
                const int u = __builtin_amdgcn_readfirstlane(*ubox);
                __syncthreads();
                if (u >= 128) break;
                const int qb = 15 - (u >> 3), h = u & 7;
                const float* Fg = FB + (size_t)(b * 8 + h) * SEQ; const unsigned* nr = ctl + CW_NORM + (b * 8 + h) * 4;
                const float qn = sqrtf(__uint_as_float(nr[0]) + __uint_as_float(nr[1])), kn = sqrtf(__uint_as_float(nr[2]) + __uint_as_float(nr[3]));
                const int* sm = (const int*)ctl + CW_SMIN + ((b * 8 + h) * 16 + qb) * 2; const int s0 = sm[0], s1 = sm[1];
                const float sself = __int_as_float(s0 >= 0 ? s0 : s0 ^ 0x7fffffff) + __int_as_float(s1 >= 0 ? s1 : s1 ^ 0x7fffffff);
                const float bound = 1.03f * qn * kn - sself;
                float drop = lane < 4 * qb ? 64.f * __builtin_amdgcn_exp2f(bound + (Fg[64 * lane + 63] - Fg[256 * qb])) : 0.f;
#pragma unroll
                for (int o = 1; o < 64; o <<= 1) { const float t = __shfl_up(drop, o); if (lane >= o) drop += t; }
                const bool skip = lane < 4 * qb && drop < 5.9604645e-8f;
                const int t0 = __builtin_amdgcn_readfirstlane(__builtin_popcountll(__ballot(skip)) & ~1);
                const attn_body::bf16* base = QKV + (size_t)b * SEQ * QP;
                float* fb = (float*)(lds + LDS_FB); const int nk = (qb + 1) * 256 - 64 * t0;
                const EpiFox E{(attn_body::bf16*)((signed char*)MIX + (size_t)b * SEQ * OP + 512 + h * 64)};
                const float fend = Fg[256 * qb + 255], fbeg = Fg[256 * qb];
                if (__builtin_amdgcn_readfirstlane((int)(fend - fbeg < 64.f))) {
                    const float ref = fend + 8.f;
                    for (int i = tid; i < nk; i += 512) fb[i] = Fg[64 * t0 + i] - ref;
                    attn_unit<16, 0, EpiFox, true>(qb, t0, base + 1536 + h * 64, base + 2048 + h * 64, base + 2560 + h * 64, lds, E);
                } else {
                    for (int i = tid; i < nk; i += 512) fb[i] = Fg[64 * t0 + i];
                    attn_unit<16, 0, EpiFox, false>(qb, t0, base + 1536 + h * 64, base + 2048 + h * 64, base + 2560 + h * 64, lds, E);
                }
            }
        }
    }
}

#ifndef MK_N_LAUNCHES
#define MK_N_LAUNCHES 1
#endif
constexpr int N_PHASES = 9;
#define REP_PRO 1
#define REP_NORM1 1
#define REP_INPROJ 1
#define REP_ATTN 1
#define REP_OUTPROJ 1
#define REP_MOE1 1
#define REP_MOE2 1
#define REPEAT(n) _Pragma("nounroll") for (int r_ = 0; r_ < (n); ++r_)
struct Args { P p; int ph_lo, ph_hi; };
__global__ void __launch_bounds__(512, 2) mega(Args a) {
    extern __shared__ __attribute__((aligned(16))) unsigned char lds[];
    const P& p = a.p;
    PG8_LAS unsigned char* l3 = (PG8_LAS unsigned char*)lds;
    const int G = (int)gridDim.x, c = (int)blockIdx.x;
    volatile LAS unsigned* MISC = (volatile LAS unsigned*)(l3 + MISC_OFF);
    if (threadIdx.x < 32) MISC[threadIdx.x] = 0u;
    __syncthreads();
    XcdBarrier bar; bar.bar = (unsigned*)(p.ws + WS_CTL) + CW_BAR; bar.x = 0; bar.st = nullptr;
    if (MK_N_LAUNCHES == 1) bar = xcd_barrier_post((unsigned*)(p.ws + WS_CTL) + CW_BAR, MISC + 8);
    const int lo = a.ph_lo, hi = a.ph_hi;
#define IN(k) (lo <= (k) && (k) < hi)
#define SEAM(k) do { if (IN(k) && IN((k) + 1)) xcd_barrier(bar); } while (0)
    if (IN(0)) { REPEAT(REP_PRO) { prologue_phase(p, lds, c, G); __syncthreads(); } } SEAM(0);
    if (IN(1)) { REPEAT(REP_NORM1) { norm1_phase(p, lds, c, G); __syncthreads(); } } SEAM(1);
    if (IN(2)) { scan_phase(p, (float*)(lds + 1024), c, G); __syncthreads(); REPEAT(REP_INPROJ) inproj_phase(p, l3, c, G); } SEAM(2);
    if (IN(3)) { REPEAT(REP_ATTN) attn_phase(p, (char*)lds, c, G); } SEAM(3);
    if (IN(4)) { REPEAT(REP_OUTPROJ) outproj_phase(p, l3, c, G); } SEAM(4);
    if (IN(5)) { router_phase(p, lds, c, G); } SEAM(5);
    if (IN(6)) { moe1_phase(p, l3, c, G); moe2_phase(p, l3, c, G); }
    SEAM(7);
    if (IN(8)) { final_phase(p, c, G); }
#undef IN
#undef SEAM
}
}

extern "C" void kernel_launch(void* const* d_in, const int* in_sizes, int n_in, void* d_out, int out_size, void* d_ws, size_t ws_size, hipStream_t stream) {
    if (n_in != 23 || out_size != T * D || ws_size < WS_END) { fprintf(stderr, "kernel_launch: unexpected shapes (n_in %d, out %d, ws %zu)\n", n_in, out_size, ws_size); return; }
    static int grid = 0;
    if (grid == 0) {
        int dev = 0, cus = 0, per_cu = 0;
        if (hipGetDevice(&dev) != hipSuccess || hipDeviceGetAttribute(&cus, hipDeviceAttributeMultiprocessorCount, dev) != hipSuccess) { fprintf(stderr, "kernel_launch: device query failed\n"); grid = -1; return; }
        if (hipFuncSetAttribute((const void*)mega, hipFuncAttributeMaxDynamicSharedMemorySize, LDS_BYTES) != hipSuccess) { fprintf(stderr, "kernel_launch: hipFuncSetAttribute failed\n"); grid = -1; return; }
        if (hipOccupancyMaxActiveBlocksPerMultiprocessor(&per_cu, (const void*)mega, 512, LDS_BYTES) != hipSuccess || per_cu < 1) fprintf(stderr, "kernel_launch: note: occupancy query reports %d workgroups per CU\n", per_cu);
        (void)hipGetLastError();
        grid = cus;
    }
    if (grid < 0) return;
    (void)hipMemsetAsync((char*)d_ws + WS_CTL, 0, CTL_BYTES, stream);
    Args a{};
    const float** f = (const float**)&a.p;
    for (int i = 0; i < 23; ++i) f[i] = (const float*)d_in[i];
    a.p.out = (float*)d_out; a.p.ws = (unsigned char*)d_ws;
    if (MK_N_LAUNCHES == 1) { a.ph_lo = 0; a.ph_hi = N_PHASES; hipLaunchKernelGGL(mega, dim3(grid), dim3(512), LDS_BYTES, stream, a); }
    else for (int k = 0; k < N_PHASES; ++k) { a.ph_lo = k; a.ph_hi = k + 1; hipLaunchKernelGGL(mega, dim3(grid), dim3(512), LDS_BYTES, stream, a); }
}
```

```cpp
#include <hip/hip_runtime.h>
#include <hip/hip_bf16.h>
#include <cstdio>
#include <cstdint>
#include <cmath>

namespace {
constexpr int NB = 8, SEQ = 4096, T = NB * SEQ, D = 1024, NQKV = 3072, INC = 3080, NE = 32, DE = 512;
constexpr float EPS = 1e-6f;
constexpr size_t MiB = 1u << 20;
constexpr size_t WS_CTL = 0, CTL_BYTES = 131072;
constexpr size_t WS_MOD = 1 * MiB;
constexpr size_t WS_SCAL = WS_MOD + 256 * 1024;
constexpr size_t WS_WF = WS_MOD + 512 * 1024;
constexpr size_t WS_ROPE = 2 * MiB;
constexpr size_t WS_LOGF = 3 * MiB;
constexpr size_t WS_F = 4 * MiB;
constexpr size_t WS_TOKE = 5 * MiB;
constexpr size_t WS_TOKW = WS_TOKE + 256 * 1024;
constexpr size_t WS_LIST = 6 * MiB;
constexpr size_t WS_WIN = 10 * MiB;
constexpr size_t WS_WOUT = 16 * MiB;
constexpr size_t WS_WGU = 18 * MiB;
constexpr size_t WS_WD = 82 * MiB;
constexpr size_t WS_H = 114 * MiB;
constexpr size_t WS_R = 178 * MiB;
constexpr size_t WS_X1 = WS_R + 64 * MiB;
constexpr size_t WS_ACT = WS_R + 128 * MiB;
constexpr size_t WS_END = WS_R + 192 * MiB;

typedef unsigned short bf16;
typedef unsigned v4u __attribute__((ext_vector_type(4)));
typedef unsigned v2u __attribute__((ext_vector_type(2)));
typedef float f32x4 __attribute__((ext_vector_type(4)));

__device__ __forceinline__ unsigned f2bf(float f) { unsigned u = __builtin_bit_cast(unsigned, f); return (u + 0x7fffu + ((u >> 16) & 1u)) >> 16; }
typedef float pk2f_t __attribute__((ext_vector_type(2))); typedef __bf16 pk2b_t __attribute__((ext_vector_type(2)));
__device__ __forceinline__ unsigned pk2(float lo, float hi) { const pk2f_t v = {lo, hi}; return __builtin_bit_cast(unsigned, __builtin_convertvector(v, pk2b_t)); }
__device__ __forceinline__ float bf2f(unsigned short b) { return __builtin_bit_cast(float, (unsigned)b << 16); }
__device__ __forceinline__ float bflo(unsigned w) { return __builtin_bit_cast(float, w << 16); }
__device__ __forceinline__ float bfhi(unsigned w) { return __builtin_bit_cast(float, w & 0xffff0000u); }
__device__ __forceinline__ float wave_sum(float v) {
#pragma unroll
    for (int o = 1; o < 64; o <<= 1) v += __shfl_xor(v, o);
    return v;
}
__device__ __forceinline__ float wave_max(float v) {
#pragma unroll
    for (int o = 1; o < 64; o <<= 1) v = fmaxf(v, __shfl_xor(v, o));
    return v;
}
__device__ __forceinline__ int tid_fresh() { int t = threadIdx.x; asm volatile("" : "+v"(t)); return t; }
__device__ __forceinline__ float siluf(float v) { return v / (1.f + __expf(-v)); }

struct P {
    const float *x, *c, *w_ada, *b_ada, *g_pre_attn, *g_post_attn, *w_in, *b_forget, *lq1, *lk1, *lq2, *lk2, *g_subln, *w_out, *g_pre_ffn, *g_post_ffn,
        *w_group, *b_group, *w_router, *b_router, *w_gate, *w_up, *w_down;
    float* out; unsigned char* ws;
};

__device__ __forceinline__ void transpose_item(const float* W, int ldw, int K, bf16* WT, int k0, int n0, int dst_row0, float* scr, int lane) {
#pragma unroll 8
    for (int i = 0; i < 32; ++i) { const int kk = 2 * i + (lane >> 5); scr[kk * 33 + (lane & 31)] = __builtin_nontemporal_load(W + (size_t)(k0 + kk) * ldw + n0 + (lane & 31)); }
    __builtin_amdgcn_s_waitcnt(0xc07f); asm volatile("" ::: "memory");
    const int c = lane & 7;
#pragma unroll
    for (int j = 0; j < 4; ++j) { const int n = (lane >> 3) + 8 * j; const float* s = scr + (8 * c) * 33 + n;
        v4u o; o.x = pk2(s[0 * 33], s[1 * 33]); o.y = pk2(s[2 * 33], s[3 * 33]); o.z = pk2(s[4 * 33], s[5 * 33]); o.w = pk2(s[6 * 33], s[7 * 33]);
        *(v4u*)(WT + (size_t)(dst_row0 + n) * K + k0 + 8 * c) = o; }
    __builtin_amdgcn_s_waitcnt(0xc07f); asm volatile("" ::: "memory");
}

constexpr float Q8_ACT = 127.f / 6.f, Q8_W = 127.f / 0.14f;
constexpr float Q8_ACT2 = 127.f / 8.f, Q8_WD = 127.f / 0.2f;
constexpr float Q8_X1 = 127.f / 6.f;
constexpr float Q8_MIX = 127.f / 4.f;
__device__ __forceinline__ unsigned pk4_i8(float a, float b, float c, float d, float s) {
    unsigned w = __builtin_amdgcn_cvt_pk_u8_f32(__builtin_fmaf(a, s, 128.f), 0, 0u); w = __builtin_amdgcn_cvt_pk_u8_f32(__builtin_fmaf(b, s, 128.f), 1, w);
    w = __builtin_amdgcn_cvt_pk_u8_f32(__builtin_fmaf(c, s, 128.f), 2, w); w = __builtin_amdgcn_cvt_pk_u8_f32(__builtin_fmaf(d, s, 128.f), 3, w); return w ^ 0x80808080u; }
__device__ __forceinline__ void transpose_item_i8(const float* W, int ldw, int Kp, unsigned char* WT8, int k0, int n0, int dst_row0, float* scr, int lane, float qs) {
#pragma unroll 8
    for (int i = 0; i < 32; ++i) { const int kk = 2 * i + (lane >> 5); scr[kk * 33 + (lane & 31)] = __builtin_nontemporal_load(W + (size_t)(k0 + kk) * ldw + n0 + (lane & 31)); }
    __builtin_amdgcn_s_waitcnt(0xc07f); asm volatile("" ::: "memory");
    const int c = lane & 7;
#pragma unroll
    for (int j = 0; j < 4; ++j) { const int n = (lane >> 3) + 8 * j; const float* s = scr + (8 * c) * 33 + n;
        v2u o; o.x = pk4_i8(s[0 * 33], s[1 * 33], s[2 * 33], s[3 * 33], qs); o.y = pk4_i8(s[4 * 33], s[5 * 33], s[6 * 33], s[7 * 33], qs);
        *(v2u*)(WT8 + (size_t)(dst_row0 + n) * Kp + k0 + 8 * c) = o; }
    __builtin_amdgcn_s_waitcnt(0xc07f); asm volatile("" ::: "memory");
}
constexpr int CW_ADA = 3584;
constexpr int CV_IN = 16 * 96, CV_OUT = 16 * 32, CV_G = 16 * 16, CV_D = 8 * 32, CV_E = 2 * CV_G + CV_D, CV_ITEMS = CV_IN + CV_OUT + NE * CV_E;
__device__ __forceinline__ void convert_items(const P& p, unsigned char* lds, int bid, int nblk, int it0, int it1, int k0, int k1) {
    const int tid = tid_fresh(), lane = tid & 63, wv = __builtin_amdgcn_readfirstlane(tid >> 6);
    unsigned char* WinT = p.ws + WS_WIN; unsigned char* WoutT = p.ws + WS_WOUT; unsigned char* WguT = p.ws + WS_WGU; unsigned char* WdT = p.ws + WS_WD;
    float* scr = (float*)(lds + wv * 8448);
    const int gw = bid * 8 + wv, ngw = nblk * 8;
    struct TrItem { const float* W; unsigned char* WT8; int ldw, Kp, k0, n0, dst_row0; float qs; };
    auto decode = [&](int r) __attribute__((always_inline)) -> TrItem {
        TrItem t;
        if (r < CV_IN) { const int kb = r / 96, nb = r % 96, n0 = 32 * nb, hh = n0 >> 6, hf = (n0 >> 5) & 1;
            const int fo = n0 - 1536 - (n0 >= 2048 ? 512 : 0);
            t.W = p.w_in; t.WT8 = WinT; t.ldw = INC; t.Kp = D; t.k0 = 64 * kb; t.n0 = n0; t.qs = Q8_W;
            t.dst_row0 = n0 < 1024 ? (hh >> 2) * 256 + hf * 128 + (hh & 3) * 32 : (n0 >= 1536 && n0 < 2560) ? (6 + (fo >> 7)) * 256 + (n0 >= 2048 ? 128 : 0) + (fo & 127) : n0; return t; }
        r -= CV_IN;
        if (r < CV_OUT) { const int kb = r / 32, nb = r % 32; t.W = p.w_out; t.WT8 = WoutT; t.ldw = D; t.Kp = D; t.k0 = 64 * kb; t.n0 = 32 * nb; t.dst_row0 = 32 * nb; t.qs = Q8_W; return t; }
        r -= CV_OUT;
        const int e = r / CV_E; r -= e * CV_E;
        if (r < 2 * CV_G) { const int half = r / CV_G; r -= half * CV_G; const int kb = r / 16, nb = r % 16, j0 = 32 * nb;
            t.W = (half ? p.w_up : p.w_gate) + (size_t)e * D * DE; t.WT8 = WguT + (size_t)e * D * D; t.ldw = DE; t.Kp = D; t.k0 = 64 * kb; t.n0 = j0; t.dst_row0 = (j0 >> 7) * 256 + half * 128 + (j0 & 127); t.qs = Q8_W; return t; }
        r -= 2 * CV_G;
        { const int kb = r / 32, nb = r % 32; t.W = p.w_down + (size_t)e * DE * D; t.WT8 = WdT + (size_t)e * D * DE; t.ldw = D; t.Kp = DE; t.k0 = 64 * kb; t.n0 = 32 * nb; t.dst_row0 = 32 * nb; t.qs = Q8_WD; return t; }
    };
    int it = it0 + gw + k0 * ngw;
    if (k0 < k1 && it < it1) {
        float v[32];
        TrItem cur = decode(it);
#pragma unroll
        for (int i = 0; i < 32; ++i) v[i] = __builtin_nontemporal_load(cur.W + (size_t)(cur.k0 + 2 * i + (lane >> 5)) * cur.ldw + cur.n0 + (lane & 31));
        for (int k = k0; k < k1 && it < it1; ++k, it += ngw) {
#pragma unroll
            for (int i = 0; i < 32; ++i) scr[(2 * i + (lane >> 5)) * 33 + (lane & 31)] = v[i];
            const bool more = k + 1 < k1 && it + ngw < it1;
            const TrItem nxt = decode(more ? it + ngw : it);
            if (more) {
#pragma unroll
                for (int i = 0; i < 32; ++i) v[i] = __builtin_nontemporal_load(nxt.W + (size_t)(nxt.k0 + 2 * i + (lane >> 5)) * nxt.ldw + nxt.n0 + (lane & 31)); }
            __builtin_amdgcn_s_waitcnt(0xc07f); asm volatile("" ::: "memory");
            const int c = lane & 7;
#pragma unroll
            for (int j = 0; j < 4; ++j) { const int n = (lane >> 3) + 8 * j; const float* sp = scr + (8 * c) * 33 + n;
                v2u o; o.x = pk4_i8(sp[0 * 33], sp[1 * 33], sp[2 * 33], sp[3 * 33], cur.qs); o.y = pk4_i8(sp[4 * 33], sp[5 * 33], sp[6 * 33], sp[7 * 33], cur.qs);
                __builtin_nontemporal_store(o, (v2u*)(cur.WT8 + (size_t)(cur.dst_row0 + n) * cur.Kp + cur.k0 + 8 * c)); }
            __builtin_amdgcn_s_waitcnt(0xc07f); asm volatile("" ::: "memory");
            cur = nxt;
        }
    }
    __syncthreads();
}
__device__ __forceinline__ void prologue_phase(const P& p, unsigned char* lds, int bid, int nblk) {
    const int tid = tid_fresh(), lane = tid & 63, wave = tid >> 6;
    unsigned char* WinT = p.ws + WS_WIN; unsigned char* WoutT = p.ws + WS_WOUT; unsigned char* WguT = p.ws + WS_WGU; unsigned char* WdT = p.ws + WS_WD;
    float* mod = (float*)(p.ws + WS_MOD);
    {
        float* sc = (float*)lds;
        float* part = (float*)(lds + 32768);
        bool loaded = false;
        for (int it = bid; it < 192; it += nblk) {
            const int kr = lane >> 3, cq = lane & 7, kb = wave * 128 + kr;
            const float* wp = p.w_ada + (size_t)kb * 6144 + it * 32 + 4 * cq;
            f32x4 w[16];
#pragma unroll
            for (int i = 0; i < 16; ++i) w[i] = __builtin_nontemporal_load((const f32x4*)(wp + (size_t)(8 * i) * 6144));
            if (!loaded) { for (int i = tid; i < 8192; i += 512) { const int b = i >> 10, k = i & 1023; sc[k * 8 + b] = siluf(p.c[i]); } loaded = true; __syncthreads(); }
            f32x4 acc[8];
#pragma unroll
            for (int b = 0; b < 8; ++b) acc[b] = (f32x4){0.f, 0.f, 0.f, 0.f};
#pragma unroll
            for (int i = 0; i < 16; ++i) { const f32x4 s0 = *(const f32x4*)(sc + (kb + 8 * i) * 8), s1 = *(const f32x4*)(sc + (kb + 8 * i) * 8 + 4);
                acc[0] += w[i] * s0.x; acc[1] += w[i] * s0.y; acc[2] += w[i] * s0.z; acc[3] += w[i] * s0.w; acc[4] += w[i] * s1.x; acc[5] += w[i] * s1.y; acc[6] += w[i] * s1.z; acc[7] += w[i] * s1.w; }
#pragma unroll
            for (int b = 0; b < 8; ++b) *(f32x4*)(part + (((wave * 8 + kr) * 8 + b) * 32) + 4 * cq) = acc[b];
            __syncthreads();
            if (tid < 256) { const int b = tid >> 5, cc = tid & 31; float s = p.b_ada[it * 32 + cc];
#pragma unroll 8
                for (int g = 0; g < 64; ++g) s += part[(g * 8 + b) * 32 + cc];
                mod[b * 6144 + it * 32 + cc] = s; }
            asm volatile("s_waitcnt vmcnt(0)" ::: "memory");
            __syncthreads();
            if (it < 64 && tid == 0) { __builtin_amdgcn_fence(__ATOMIC_RELEASE, "agent"); asm volatile("s_waitcnt vmcnt(0)" ::: "memory");
                __hip_atomic_fetch_add((unsigned*)(p.ws + WS_CTL) + CW_ADA, 1u, __ATOMIC_RELAXED, __HIP_MEMORY_SCOPE_AGENT); }
        }
        __syncthreads();
    }
    if (nblk > 192) { if (bid >= 192) convert_items(p, lds, bid - 192, nblk - 192, 0, CV_IN, 0, 1 << 20); }
    else convert_items(p, lds, bid, nblk, 0, CV_IN, 0, 1 << 20);
    {
        const bool sub = nblk > 192;
        const int gt = (sub ? (bid + 128) % 192 : bid) * 512 + tid, ngt = (sub ? 192 : nblk) * 512;
        float* cosT = (float*)(p.ws + WS_ROPE); float* sinT = cosT + SEQ * 32;
        if (!sub || bid < 192) for (int i = gt; i < SEQ * 32; i += ngt) { const int pos = i >> 5, f = i & 31;
            const float inv = exp2f((float)f * (-13.287712379549449f / 32.f)); const float ang = (float)pos * inv;
            float sn, cs; sincosf(ang, &sn, &cs); cosT[i] = cs; sinT[i] = sn; }
        if (bid == (nblk > 100 ? 100 : 0) && tid < 64) {
            float a = p.lq1[tid] * p.lk1[tid], b = p.lq2[tid] * p.lk2[tid];
#pragma unroll
            for (int o = 32; o; o >>= 1) { a += __shfl_xor(a, o); b += __shfl_xor(b, o); }
            if (tid == 0) ((float*)(p.ws + WS_SCAL))[0] = expf(a) - expf(b) + 0.2f; }
    }
}

template <int CTRL> __device__ __forceinline__ float dppf(float x) { return __builtin_bit_cast(float, __builtin_amdgcn_mov_dpp(__builtin_bit_cast(int, x), CTRL, 0xf, 0xf, true)); }
template <int M> struct DppCtl { static constexpr int v = M == 1 ? 0xB1 : M == 2 ? 0x4E : M == 4 ? 0x141 : 0x128; };
__device__ __forceinline__ float swap32_add(float a, float b) { auto r = __builtin_amdgcn_permlane32_swap(__float_as_uint(a), __float_as_uint(b), false, false); return __uint_as_float(r[0]) + __uint_as_float(r[1]); }
__device__ __forceinline__ float swap16_add(float a, float b) { auto r = __builtin_amdgcn_permlane16_swap(__float_as_uint(a), __float_as_uint(b), false, false); return __uint_as_float(r[0]) + __uint_as_float(r[1]); }
__device__ __forceinline__ float wave_sum_v(float v) { v += dppf<0xB1>(v); v += dppf<0x4E>(v); v += dppf<0x141>(v); v += dppf<0x128>(v); v = swap16_add(v, v); return swap32_add(v, v); }
template <int N, int TOT, int M> struct WRM {
    static __device__ __forceinline__ void run(float (&v)[TOT], int lane) {
        if constexpr (M == 32) {
#pragma unroll
            for (int i = 0; i < N / 2; ++i) v[i] = swap32_add(v[i], v[i + N / 2]);
        } else if constexpr (M == 16) {
#pragma unroll
            for (int i = 0; i < N / 2; ++i) v[i] = swap16_add(v[i], v[i + N / 2]);
        } else {
            const bool up = (lane & M) != 0;
#pragma unroll
            for (int i = 0; i < N / 2; ++i) { const float send = up ? v[i] : v[i + N / 2]; const float keep = up ? v[i + N / 2] : v[i]; v[i] = keep + dppf<DppCtl<M>::v>(send); }
        }
        WRM<N / 2, TOT, M / 2>::run(v, lane);
    }
};
template <int TOT, int M> struct WRM<1, TOT, M> { static __device__ __forceinline__ void run(float (&v)[TOT], int lane) {
    if constexpr (M == 32) v[0] = swap32_add(v[0], v[0]); else if constexpr (M == 16) v[0] = swap16_add(v[0], v[0]); else v[0] += dppf<DppCtl<M>::v>(v[0]);
    WRM<1, TOT, M / 2>::run(v, lane); } };
template <int TOT> struct WRM<1, TOT, 0> { static __device__ __forceinline__ void run(float (&)[TOT], int) {} };
template <int N> __device__ __forceinline__ void wave_reduce_multi(float (&v)[N], int lane) { WRM<N, N, 32>::run(v, lane); }
__device__ __forceinline__ float dot4(const f32x4 a, const f32x4 b) { return (a.x * b.x + a.y * b.y) + (a.z * b.z + a.w * b.w); }
__device__ __forceinline__ float hsum4(const f32x4 a) { const pk2f_t t = (pk2f_t){a.x, a.y} + (pk2f_t){a.z, a.w}; return t.x + t.y; }
__device__ __forceinline__ float sumsq4(const f32x4 a) { return (a.x * a.x + a.y * a.y) + (a.z * a.z + a.w * a.w); }

__device__ __forceinline__ void norm1_phase(const P& p, unsigned char* lds, int c, int G) {
    const int tid = tid_fresh(), lane = tid & 63, gw = c * 8 + (tid >> 6), ngw = G * 8;
    const float* mod = (const float*)(p.ws + WS_MOD);
    unsigned char* H8 = p.ws + WS_H; float* logf_ = (float*)(p.ws + WS_LOGF);
    signed char* wq8 = (signed char*)lds;
    for (int i = tid; i < 8192; i += 512) { const int col = i >> 3, q = i & 7; const float w = p.w_in[(size_t)col * INC + NQKV + q];
        const int l_ = (col & 255) >> 2, j_ = col >> 8, e_ = col & 3;
        wq8[q * 1024 + l_ * 16 + j_ * 4 + e_] = (signed char)__float2int_rn(fminf(fmaxf(w * Q8_W, -127.f), 127.f)); }
    if (tid == 0) { unsigned* f = (unsigned*)(p.ws + WS_CTL) + CW_ADA; unsigned sp = 0;
        while (__hip_atomic_load(f, __ATOMIC_RELAXED, __HIP_MEMORY_SCOPE_AGENT) < 64u && ++sp < (1u << 22)) __builtin_amdgcn_s_sleep(1);
        __builtin_amdgcn_fence(__ATOMIC_ACQUIRE, "agent"); asm volatile("s_waitcnt vmcnt(0)" ::: "memory"); }
    __syncthreads();
    const int rpw = (((T + ngw - 1) / ngw) + 1) & ~1, r_begin = gw * rpw, r_end = min(T, r_begin + rpw);
    const float bfg = lane < 8 ? p.b_forget[lane] : 0.f;
    for (int seg = r_begin; seg < r_end;) {
        const int b = seg >> 12, seg_end = min(r_end, (b + 1) << 12);
        f32x4 xn[2][4], gs[4], sh[4];
#pragma unroll
        for (int j = 0; j < 4; ++j) { const int col = 4 * lane + 256 * j; const f32x4 g = *(const f32x4*)(p.g_pre_attn + col), sc = *(const f32x4*)(mod + b * 6144 + 1024 + col);
            sh[j] = *(const f32x4*)(mod + b * 6144 + col); gs[j] = g * (1.f + sc); }
#pragma unroll
        for (int r = 0; r < 2; ++r)
#pragma unroll
            for (int j = 0; j < 4; ++j) xn[r][j] = __builtin_nontemporal_load((const f32x4*)(p.x + (size_t)(seg + r) * D) + lane + 64 * j);
        __builtin_amdgcn_s_waitcnt(0x0f70);
        for (int r0 = seg; r0 < seg_end; r0 += 2) {
            f32x4 x[2][4];
#pragma unroll
            for (int r = 0; r < 2; ++r)
#pragma unroll
                for (int j = 0; j < 4; ++j) x[r][j] = xn[r][j];
            { const int rp = r0 + 2 < seg_end ? r0 + 2 : r0, lm = r0 + 2 < seg_end ? 1 : 0;
#pragma unroll
                for (int r = 0; r < 2; ++r)
#pragma unroll
                    for (int j = 0; j < 4; ++j) xn[r][j] = __builtin_nontemporal_load((const f32x4*)(p.x + (size_t)(rp + r) * D) + (lane + 64 * j) * lm);
            }
            float ss[2]; unsigned hq[2][4];
#pragma unroll
            for (int r = 0; r < 2; ++r) ss[r] = hsum4((x[r][0] * x[r][0] + x[r][1] * x[r][1]) + (x[r][2] * x[r][2] + x[r][3] * x[r][3]));
#pragma unroll
            for (int r = 0; r < 2; ++r) ss[r] = wave_sum_v(ss[r]);
#pragma unroll
            for (int r = 0; r < 2; ++r) { const float rinv = rsqrtf(ss[r] * (1.f / D) + EPS);
#pragma unroll
                for (int j = 0; j < 4; ++j) { x[r][j] = x[r][j] * rinv * gs[j] + sh[j];
                    hq[r][j] = pk4_i8(x[r][j].x, x[r][j].y, x[r][j].z, x[r][j].w, Q8_ACT);
                    *(unsigned*)(H8 + (size_t)(r0 + r) * D + 4 * lane + 256 * j) = hq[r][j]; } }
            float fl[16];
#pragma unroll
            for (int q = 0; q < 8; ++q) { const v4u w = *(const v4u*)(wq8 + q * 1024 + lane * 16); int a0 = 0, a1 = 0;
                a0 = __builtin_amdgcn_sdot4((int)hq[0][0], (int)w.x, a0, false); a0 = __builtin_amdgcn_sdot4((int)hq[0][1], (int)w.y, a0, false); a0 = __builtin_amdgcn_sdot4((int)hq[0][2], (int)w.z, a0, false); a0 = __builtin_amdgcn_sdot4((int)hq[0][3], (int)w.w, a0, false);
                a1 = __builtin_amdgcn_sdot4((int)hq[1][0], (int)w.x, a1, false); a1 = __builtin_amdgcn_sdot4((int)hq[1][1], (int)w.y, a1, false); a1 = __builtin_amdgcn_sdot4((int)hq[1][2], (int)w.z, a1, false); a1 = __builtin_amdgcn_sdot4((int)hq[1][3], (int)w.w, a1, false);
                fl[q] = (float)a0; fl[8 + q] = (float)a1; }
            wave_reduce_multi<16>(fl, lane);
            const float bq = __shfl(bfg, (lane >> 2) & 7);
            if ((lane & 3) == 0) { const int r = lane >> 5, q = (lane >> 2) & 7; const float z = fl[0] * (1.f / (Q8_ACT * Q8_W)) + bq;
                logf_[(size_t)(r0 + r) * 8 + q] = fminf(z, 0.f) - log1pf(expf(-fabsf(z))); }
        }
        seg = seg_end;
    }
}

__device__ __forceinline__ void scan_phase(const P& p, float* red  , int bid, int nblk) {
    const int tid = tid_fresh(), lane = tid & 63, wave = tid >> 6;
    const float* logf_ = (const float*)(p.ws + WS_LOGF); float* F = (float*)(p.ws + WS_F);
    for (int it = bid; it < 64; it += nblk) {
        const int b = it >> 3, h = it & 7;
        float v[8]; float s = 0.f;
#pragma unroll
        for (int i = 0; i < 8; ++i) { v[i] = logf_[((size_t)b * SEQ + tid * 8 + i) * 8 + h]; s += v[i]; v[i] = s; }
        float incl = s;
#pragma unroll
        for (int o = 1; o < 64; o <<= 1) { const float t = __shfl_up(incl, o); if (lane >= o) incl += t; }
        if (lane == 63) red[wave] = incl;
        __syncthreads();
        float base = incl - s;
        for (int w = 0; w < wave; ++w) base += red[w];
#pragma unroll
        for (int i = 0; i < 8; ++i) F[((size_t)b * 8 + h) * SEQ + tid * 8 + i] = -(base + v[i]) * 1.4426950408889634f;
        __syncthreads();
    }
}

constexpr int RT_WG = 131072, RT_CTL = 148480;
constexpr int CW_NORM = 2048, CW_FOXQ = 2304;
constexpr int CW_TILE = 10240;
constexpr int CW_KT = 16384, CW_QB = 24576;
constexpr int CW_SMIN = 8192;
constexpr int CNT_STRIDE = 64;
__device__ __forceinline__ void router_phase(const P& p, unsigned char* lds, int c, int G) {
    const int tid = tid_fresh(), lane = tid & 63, gw = c * 8 + (tid >> 6), ngw = G * 8;
    const float* mod = (const float*)(p.ws + WS_MOD); const bf16* mixed = (const bf16*)(p.ws + WS_R);
    unsigned char* H8 = p.ws + WS_H; unsigned char* X1 = p.ws + WS_X1; unsigned* cnt = (unsigned*)(p.ws + WS_CTL);
    float* tokw = (float*)(p.ws + WS_TOKW); int* list = (int*)(p.ws + WS_LIST);
    float* wr = (float*)lds; float* wg = (float*)(lds + RT_WG);
    int* lcnt = (int*)(lds + RT_CTL); int* lbase = lcnt + 32; int* lassign = lcnt + 64;
    if (tid < 32) lcnt[tid] = 0;
    const int rpw = (((T + ngw - 1) / ngw) + 1) & ~1, r_begin = gw * rpw, r_end = min(T, r_begin + rpw);
    f32x4 xn[2][4]; v2u mn[2][4];
    {
        f32x4 wv[16];
#pragma unroll
        for (int k = 0; k < 16; ++k) { const int i = tid + 512 * k; wv[k] = *(const f32x4*)(p.w_router + (i >> 3) * 32 + (i & 7) * 4); }
        const f32x4 wg0 = *(const f32x4*)(p.w_group + tid * 4), wg1 = *(const f32x4*)(p.w_group + (tid + 512) * 4);
        asm volatile("" ::: "memory");
        { const int rf = r_begin < r_end ? r_begin : 0;
#pragma unroll
            for (int r = 0; r < 2; ++r)
#pragma unroll
                for (int j = 0; j < 4; ++j) { xn[r][j] = __builtin_nontemporal_load((const f32x4*)(p.x + (size_t)(rf + r) * D) + lane + 64 * j); mn[r][j] = __builtin_nontemporal_load((const v2u*)(mixed + (size_t)(rf + r) * D) + lane + 64 * j); } }
        asm volatile("" ::: "memory");
#pragma unroll
        for (int k = 0; k < 16; ++k) { const int i = tid + 512 * k, col = i >> 3, e0 = (i & 7) * 4;
            wr[(e0 + 0) * 1024 + col] = wv[k].x; wr[(e0 + 1) * 1024 + col] = wv[k].y; wr[(e0 + 2) * 1024 + col] = wv[k].z; wr[(e0 + 3) * 1024 + col] = wv[k].w; }
        wg[tid] = wg0.x; wg[1024 + tid] = wg0.y; wg[2048 + tid] = wg0.z; wg[3072 + tid] = wg0.w;
        wg[tid + 512] = wg1.x; wg[1024 + tid + 512] = wg1.y; wg[2048 + tid + 512] = wg1.z; wg[3072 + tid + 512] = wg1.w;
    }
    __syncthreads();
    const int blk_row0 = c * 8 * rpw, blk_slot0 = blk_row0 * 2, blk_nassign = max(0, min(T, blk_row0 + 8 * rpw) - blk_row0) * 2;
    const float bgl = p.b_group[(lane >> 3) & 3]; const float brt = lane < 32 ? p.b_router[lane] : 0.f;
    for (int seg = r_begin; seg < r_end;) {
        const int b = seg >> 12, seg_end = min(r_end, (b + 1) << 12);
        f32x4 gta[4], gf[4], shf[4];
#pragma unroll
        for (int j = 0; j < 4; ++j) { const int col = 4 * lane + 256 * j;
            gta[j] = *(const f32x4*)(p.g_post_attn + col) * *(const f32x4*)(mod + b * 6144 + 2048 + col);
            gf[j] = *(const f32x4*)(p.g_pre_ffn + col) * (1.f + *(const f32x4*)(mod + b * 6144 + 4096 + col)); shf[j] = *(const f32x4*)(mod + b * 6144 + 3072 + col); }
        if (seg != r_begin) {
#pragma unroll
            for (int r = 0; r < 2; ++r)
#pragma unroll
                for (int j = 0; j < 4; ++j) { xn[r][j] = __builtin_nontemporal_load((const f32x4*)(p.x + (size_t)(seg + r) * D) + lane + 64 * j); mn[r][j] = __builtin_nontemporal_load((const v2u*)(mixed + (size_t)(seg + r) * D) + lane + 64 * j); } }
        __builtin_amdgcn_s_waitcnt(0x0f70);
        for (int r0 = seg; r0 < seg_end; r0 += 2) {
            f32x4 x[2][4], m[2][4];
#pragma unroll
            for (int r = 0; r < 2; ++r)
#pragma unroll
                for (int j = 0; j < 4; ++j) { x[r][j] = xn[r][j]; const v2u w = mn[r][j]; m[r][j].x = bflo(w.x); m[r][j].y = bfhi(w.x); m[r][j].z = bflo(w.y); m[r][j].w = bfhi(w.y); }
            { const int rp = r0 + 2 < seg_end ? r0 + 2 : r0, lm = r0 + 2 < seg_end ? 1 : 0;
#pragma unroll
                for (int r = 0; r < 2; ++r)
#pragma unroll
                    for (int j = 0; j < 4; ++j) { xn[r][j] = __builtin_nontemporal_load((const f32x4*)(p.x + (size_t)(rp + r) * D) + (lane + 64 * j) * lm); mn[r][j] = __builtin_nontemporal_load((const v2u*)(mixed + (size_t)(rp + r) * D) + (lane + 64 * j) * lm); }
            }
            float s1[2], s2[2];
#pragma unroll
            for (int r = 0; r < 2; ++r) s1[r] = hsum4((m[r][0] * m[r][0] + m[r][1] * m[r][1]) + (m[r][2] * m[r][2] + m[r][3] * m[r][3]));
#pragma unroll
            for (int r = 0; r < 2; ++r) s1[r] = wave_sum_v(s1[r]);
#pragma unroll
            for (int r = 0; r < 2; ++r) { const float rinv = rsqrtf(s1[r] * (1.f / D) + EPS); f32x4 sq = (f32x4){0.f, 0.f, 0.f, 0.f};
#pragma unroll
                for (int j = 0; j < 4; ++j) { x[r][j] = x[r][j] + gta[j] * (m[r][j] * rinv); sq += x[r][j] * x[r][j];
                    *(unsigned*)(X1 + (size_t)(r0 + r) * D + 4 * lane + 256 * j) = pk4_i8(x[r][j].x, x[r][j].y, x[r][j].z, x[r][j].w, Q8_X1); }
                s2[r] = hsum4(sq); }
#pragma unroll
            for (int r = 0; r < 2; ++r) s2[r] = wave_sum_v(s2[r]);
#pragma unroll
            for (int r = 0; r < 2; ++r) { const float rinv = rsqrtf(s2[r] * (1.f / D) + EPS);
#pragma unroll
                for (int j = 0; j < 4; ++j) { x[r][j] = x[r][j] * rinv * gf[j] + shf[j];
                    *(unsigned*)(H8 + (size_t)(r0 + r) * D + 4 * lane + 256 * j) = pk4_i8(x[r][j].x, x[r][j].y, x[r][j].z, x[r][j].w, Q8_ACT); } }
            float gl[8];
#pragma unroll
            for (int q = 0; q < 4; ++q) { f32x4 a0 = (f32x4){0.f, 0.f, 0.f, 0.f}, a1 = a0;
#pragma unroll
                for (int j = 0; j < 4; ++j) { const f32x4 w = *(const f32x4*)(wg + q * 1024 + 4 * lane + 256 * j); a0 += x[0][j] * w; a1 += x[1][j] * w; }
                gl[q] = hsum4(a0); gl[4 + q] = hsum4(a1); if (q & 1) asm volatile("" ::: "memory"); }
            wave_reduce_multi<8>(gl, lane);
            const float glv = gl[0] + bgl;
            float v4[4];
#pragma unroll
            for (int q = 0; q < 4; ++q) v4[q] = __shfl(glv, (lane & 32) + q * 8);
            int bi = 0; float bm = v4[0];
#pragma unroll
            for (int q = 1; q < 4; ++q) if (v4[q] > bm) { bm = v4[q]; bi = q; }
            float gsum = 0.f;
#pragma unroll
            for (int q = 0; q < 4; ++q) gsum += __expf(v4[q] - bm);
            const float gwtl = 1.f / gsum;
            int gi[2]; gi[0] = __builtin_amdgcn_readlane(bi, 0); gi[1] = __builtin_amdgcn_readlane(bi, 32);
            float el[16];
#pragma unroll
            for (int r = 0; r < 2; ++r) { const float* wb = wr + gi[r] * 8192 + 4 * lane;
#pragma unroll
                for (int q = 0; q < 8; ++q) { f32x4 a = (f32x4){0.f, 0.f, 0.f, 0.f};
#pragma unroll
                    for (int j = 0; j < 4; ++j) a += x[r][j] * *(const f32x4*)(wb + q * 1024 + 256 * j);
                    el[r * 8 + q] = hsum4(a); if (q & 1) asm volatile("" ::: "memory"); } }
            wave_reduce_multi<16>(el, lane);
            {
                const float elv = el[0] + __shfl(brt, bi * 8 + ((lane >> 2) & 7));
                float v[8];
#pragma unroll
                for (int q = 0; q < 8; ++q) v[q] = __shfl(elv, (lane & 32) + q * 4);
                int i1 = 0; float v1 = v[0];
#pragma unroll
                for (int q = 1; q < 8; ++q) if (v[q] > v1) { v1 = v[q]; i1 = q; }
                int i2 = -1; float v2 = -3.0e38f;
#pragma unroll
                for (int q = 0; q < 8; ++q) if (q != i1 && v[q] > v2) { v2 = v[q]; i2 = q; }
                const float e2 = __expf(v2 - v1); const float w1 = gwtl / (1.f + e2), w2 = gwtl * e2 / (1.f + e2);
                if ((lane & 31) < 2) { const int r = lane >> 5, sl = lane & 1; const int e = bi * 8 + (sl ? i2 : i1); const float w = sl ? w2 : w1; const int slot = (r0 + r) * 2 + sl;
                    tokw[slot] = w; const int lpos = atomicAdd(lcnt + e, 1); lassign[slot - blk_slot0] = e | (lpos << 8); }
            }
        }
        seg = seg_end;
    }
    __syncthreads();
    if (tid < 32) lbase[tid] = lcnt[tid] ? (int)atomicAdd(cnt + tid * CNT_STRIDE, (unsigned)lcnt[tid]) : 0;
    __syncthreads();
    for (int i = tid; i < blk_nassign; i += 512) { const int v = lassign[i], e = v & 255; list[e * T + lbase[e] + (v >> 8)] = blk_slot0 + i; }
}

typedef float f32x2 __attribute__((ext_vector_type(2)));
__device__ __forceinline__ f32x4 fp8x4_to_f32(unsigned w) { const f32x2 lo = __builtin_amdgcn_cvt_pk_f32_fp8((int)w, false), hi = __builtin_amdgcn_cvt_pk_f32_fp8((int)w, true); return (f32x4){lo.x, lo.y, hi.x, hi.y}; }
__device__ __forceinline__ void final_phase(const P& p, int c, int G) {
    const int tid = tid_fresh(), lane = tid & 63, gw = c * 8 + (tid >> 6), ngw = G * 8;
    const float* mod = (const float*)(p.ws + WS_MOD); const unsigned char* YS = p.ws + WS_R; const unsigned char* X1 = p.ws + WS_X1; const float* tokw = (const float*)(p.ws + WS_TOKW);
    const int rpw = (((T + ngw - 1) / ngw) + 1) & ~1, r_begin = gw * rpw, r_end = min(T, r_begin + rpw);
    for (int seg = r_begin; seg < r_end;) {
        const int b = seg >> 12, seg_end = min(r_end, (b + 1) << 12);
        f32x4 gtf[4]; unsigned xn[2][4]; unsigned yn[2][2][4]; float wn[2][2];
#pragma unroll
        for (int j = 0; j < 4; ++j) { const int col = 4 * lane + 256 * j; gtf[j] = *(const f32x4*)(p.g_post_ffn + col) * *(const f32x4*)(mod + b * 6144 + 5120 + col); }
#pragma unroll
        for (int r = 0; r < 2; ++r)
#pragma unroll
            for (int j = 0; j < 4; ++j) { xn[r][j] = *((const unsigned*)(X1 + (size_t)(seg + r) * D) + lane + 64 * j);
                yn[r][0][j] = *((const unsigned*)(YS + (size_t)((seg + r) * 2) * D) + lane + 64 * j); yn[r][1][j] = *((const unsigned*)(YS + (size_t)((seg + r) * 2 + 1) * D) + lane + 64 * j); }
#pragma unroll
        for (int r = 0; r < 2; ++r) { wn[r][0] = tokw[(seg + r) * 2]; wn[r][1] = tokw[(seg + r) * 2 + 1]; }
        __builtin_amdgcn_s_waitcnt(0x0f70);
        for (int r0 = seg; r0 < seg_end; r0 += 2) {
            f32x4 x[2][4], y[2][4];
#pragma unroll
            for (int r = 0; r < 2; ++r) { const float w0 = wn[r][0] * 0.0625f, w1 = wn[r][1] * 0.0625f;
#pragma unroll
                for (int j = 0; j < 4; ++j) { const unsigned xv = xn[r][j] ^ 0x80808080u;
                    x[r][j] = (f32x4){(float)(xv & 0xffu), (float)((xv >> 8) & 0xffu), (float)((xv >> 16) & 0xffu), (float)(xv >> 24)} * (1.f / Q8_X1) - (128.f / Q8_X1);
                    y[r][j] = fp8x4_to_f32(yn[r][0][j]) * w0 + fp8x4_to_f32(yn[r][1][j]) * w1; } }
            { const int rp = r0 + 2 < seg_end ? r0 + 2 : r0, lm = r0 + 2 < seg_end ? 1 : 0;
#pragma unroll
                for (int r = 0; r < 2; ++r)
#pragma unroll
                    for (int j = 0; j < 4; ++j) { xn[r][j] = *((const unsigned*)(X1 + (size_t)(rp + r) * D) + (lane + 64 * j) * lm);
                        yn[r][0][j] = *((const unsigned*)(YS + (size_t)((rp + r) * 2) * D) + (lane + 64 * j) * lm); yn[r][1][j] = *((const unsigned*)(YS + (size_t)((rp + r) * 2 + 1) * D) + (lane + 64 * j) * lm); }
#pragma unroll
                for (int r = 0; r < 2; ++r) { wn[r][0] = tokw[(rp + r) * 2]; wn[r][1] = tokw[(rp + r) * 2 + 1]; }
            }
            float ss[2];
#pragma unroll
            for (int r = 0; r < 2; ++r) ss[r] = hsum4((y[r][0] * y[r][0] + y[r][1] * y[r][1]) + (y[r][2] * y[r][2] + y[r][3] * y[r][3]));
#pragma unroll
            for (int r = 0; r < 2; ++r) ss[r] = wave_sum_v(ss[r]);
#pragma unroll
            for (int r = 0; r < 2; ++r) { const float rinv = rsqrtf(ss[r] * (1.f / D) + EPS);
#pragma unroll
                for (int j = 0; j < 4; ++j) *((f32x4*)(p.out + (size_t)(r0 + r) * D) + lane + 64 * j) = x[r][j] + gtf[j] * (y[r][j] * rinv); }
        }
        seg = seg_end;
    }
}

namespace pg8 {
#define PG8_LAS __attribute__((address_space(3)))
typedef unsigned short bf16_t;
typedef short bf16x8 __attribute__((ext_vector_type(8)));
typedef float f32x4 __attribute__((ext_vector_type(4)));
typedef unsigned u32x4 __attribute__((ext_vector_type(4)));
constexpr int BM = 256, BK = 64, HALF = 128, HTB = HALF * BK * 2  , STAGE_BYTES = 8 * HTB, NXCD = 8, WGM = 4;

__host__ __device__ __forceinline__ int lds_byte(int r, int c) { const int st = (r >> 4) * 2 + (c >> 5), rr = r & 15, cc = c & 31, ob = rr * 64 + cc * 2; return st * 1024 + (ob ^ (((ob >> 9) & 1) << 5)); }
__host__ __device__ __forceinline__ void stage_rc(int b, int& R, int& C) { const int st = b / 1024, sb = b % 1024, swz = sb ^ (((sb >> 9) & 1) << 5); R = (st >> 1) * 16 + swz / 64; C = (st & 1) * 32 + (swz % 64) / 2; }
__host__ __device__ __forceinline__ int perm32(int rho) { const int n = rho >> 4, i = rho & 15; return 8 * (i >> 2) + 4 * n + (i & 3); }

struct Unit { int pm, pn, aux; };
struct Gemm { const bf16_t* A; const bf16_t* Bt; int M, N, K; };

struct StaticOrder {
    int nM, nN, nwg, G, c;
    __host__ __device__ void init(int M, int N, int G_, int c_) { nM = M / BM; nN = N / BM; nwg = nM * nN; G = G_; c = c_; }
    __host__ __device__ bool next(int i, Unit& u) const {
        const long L = (long)i * G + c; if (L >= nwg) return false;
        int wgid = (int)L; { const int q = nwg / NXCD, r = nwg % NXCD, xcd = wgid % NXCD, off = wgid / NXCD; wgid = (xcd < r ? xcd * (q + 1) : r * (q + 1) + (xcd - r) * q) + off; }
        const int nig = WGM * nN, gid = wgid / nig, fm = gid * WGM, gsz = (nM - fm) < WGM ? (nM - fm) : WGM;
        u.pm = fm + ((wgid % nig) % gsz); u.pn = (wgid % nig) / gsz; return true;
    }
    __device__ __forceinline__ void a_ready(const Unit&) const {}
    __device__ __forceinline__ void done(const Unit&) const {}
};

__device__ __forceinline__ unsigned cvt_pk_bf16(float lo, float hi) { unsigned r; asm volatile("v_cvt_pk_bf16_f32 %0, %1, %2" : "=v"(r) : "v"(lo), "v"(hi)); return r; }
typedef float f32x2 __attribute__((ext_vector_type(2)));

typedef int i32x4 __attribute__((ext_vector_type(4)));
struct NoPreG { __device__ __forceinline__ void operator()() const {} };
template <class Epi, class Sched, bool ALIGN_EPI = false, bool SP2 = true, bool GATHER = false, bool I8 = false, bool ACOH = false, class Pre = NoPreG, class Mid = NoPreG>
__device__ __forceinline__ void gemm_phase(PG8_LAS unsigned char* lds, const Gemm g, const Sched& S, const Epi& E, const Pre& pre = Pre(), const Mid& mid = Mid()) {
    const int tid = tid_fresh(), wid = __builtin_amdgcn_readfirstlane(tid >> 6), lane = tid & 63, wr = wid >> 2, wc = wid & 3, fr = lane & 15, fq = lane >> 4;
    constexpr int ES = I8 ? 1 : 2;
    const int K = g.K, nt = K * ES / (BK * 2);
    unsigned voffA[2], voffB[2];
#pragma unroll
    for (int i = 0; i < 2; ++i) { int R, C; stage_rc(tid * 16 + i * 8192, R, C); const int Rb = Epi::PERM ? ((R & ~31) + perm32(R & 31)) : R;
        voffA[i] = (unsigned)(R * K * ES + C * 2); voffB[i] = (unsigned)(Rb * K * ES + C * 2); }
    unsigned offC[2][2], offN[2][2]; int gR[2], gC[2];
#pragma unroll
    for (int i = 0; i < 2; ++i) { int R, C; stage_rc(tid * 16 + i * 8192, R, C); gR[i] = R; gC[i] = C * 2; }
#pragma unroll
    for (int h = 0; h < 2; ++h)
#pragma unroll
        for (int i = 0; i < 2; ++i) { offC[h][i] = 0u; offN[h][i] = 0u; }
    const char* gA = (const char*)g.A;
    const size_t kstep = (size_t)(BK * 2);
    const size_t hstep = (size_t)HALF * K * ES;
    const size_t tstep = 2 * hstep;
    const unsigned ldsw = (unsigned)wid * 1024u;
    const int aoff = lds_byte(wr * 64 + fr, fq * 8), boff = lds_byte(wc * 32 + fr, fq * 8);
#define PG8_SA(b, h) (((b) * 2 + (h)) * HTB)
#define PG8_SB(b, h) ((4 + (b) * 2 + (h)) * HTB)
#define PG8_STAGE(bufoff, gbase, voff) do { _Pragma("unroll") for (int _i = 0; _i < 2; ++_i) \
        __builtin_amdgcn_global_load_lds((const unsigned*)((const char*)(gbase) + (voff)[_i]), (PG8_LAS unsigned*)(lds + (bufoff) + ldsw + _i * 8192), 16, 0, 0); } while (0)
#define PG8_STAGE_C(bufoff, gbase, voff) do { _Pragma("unroll") for (int _i = 0; _i < 2; ++_i) \
        __builtin_amdgcn_global_load_lds((const unsigned*)((const char*)(gbase) + (voff)[_i]), (PG8_LAS unsigned*)(lds + (bufoff) + ldsw + _i * 8192), 16, 0, 17); } while (0)
#define PG8_STA(b, h, nb, gb, off) do { if constexpr (GATHER) PG8_STAGE(PG8_SA(b, h), gb, off[h]); else if constexpr (ACOH) PG8_STAGE_C(PG8_SA(b, h), (nb) + (h) * hstep, voffA); else PG8_STAGE(PG8_SA(b, h), (nb) + (h) * hstep, voffA); } while (0)
#define PG8_LDA(dst, b, h) do { _Pragma("unroll") for (int m = 0; m < 4; ++m) _Pragma("unroll") for (int k = 0; k < 2; ++k) dst[m][k] = *(const PG8_LAS bf16x8*)(lds + PG8_SA(b, h) + aoff + m * 2048 + k * 1024); } while (0)
#define PG8_LDB(dst, b, h) do { _Pragma("unroll") for (int n = 0; n < 2; ++n) _Pragma("unroll") for (int k = 0; k < 2; ++k) dst[n][k] = *(const PG8_LAS bf16x8*)(lds + PG8_SB(b, h) + boff + n * 2048 + k * 1024); } while (0)
#define PG8_MMA(ai, bj, At, Bt) do { __builtin_amdgcn_s_setprio(1); _Pragma("unroll") for (int m = 0; m < 4; ++m) _Pragma("unroll") for (int n = 0; n < 2; ++n) _Pragma("unroll") for (int k = 0; k < 2; ++k) { \
        if constexpr (I8) acc[ai][bj][m][n] = __builtin_bit_cast(f32x4, __builtin_amdgcn_mfma_i32_16x16x64_i8(__builtin_bit_cast(i32x4, Bt[n][k]), __builtin_bit_cast(i32x4, At[m][k]), __builtin_bit_cast(i32x4, acc[ai][bj][m][n]), 0, 0, 0)); \
        else acc[ai][bj][m][n] = __builtin_amdgcn_mfma_f32_16x16x32_bf16(Bt[n][k], At[m][k], acc[ai][bj][m][n], 0, 0, 0); } __builtin_amdgcn_s_setprio(0); } while (0)
#define PG8_WAIT_V(n) asm volatile("s_waitcnt vmcnt(" #n ")" ::: "memory")
#define PG8_WAIT_L(n) asm volatile("s_waitcnt lgkmcnt(" #n ")" ::: "memory")
#define PG8_BAR __builtin_amdgcn_s_barrier()
#define PG8_SCHED __builtin_amdgcn_sched_barrier(0)
    Unit cur, nxt; int ui = 0;
    if (!S.next(0, cur)) return;
    f32x4 acc[2][2][4][2];
#pragma unroll
    for (int a = 0; a < 2; ++a)
#pragma unroll
        for (int b = 0; b < 2; ++b)
#pragma unroll
            for (int m = 0; m < 4; ++m)
#pragma unroll
                for (int n = 0; n < 2; ++n) acc[a][b][m][n] = (f32x4){0.f, 0.f, 0.f, 0.f};
    bf16x8 At[4][2], B0[2][2], B1[2][2];
    const char* cA = (const char*)g.A + (size_t)cur.pm * tstep; const char* cB = (const char*)g.Bt + (size_t)cur.pn * tstep;
    S.a_ready(cur);
    static_assert(!GATHER || SP2, "GATHER needs the SP2 loop");
    if constexpr (SP2) {
        PG8_STAGE(PG8_SB(0, 0), cB, voffB); PG8_STAGE(PG8_SB(0, 1), cB + hstep, voffB);
        mid();
        if constexpr (GATHER) {
#pragma unroll
            for (int h = 0; h < 2; ++h)
#pragma unroll
                for (int i = 0; i < 2; ++i) { offC[h][i] = S.arow(0, 128 * h + gR[i]) + (unsigned)gC[i]; offN[h][i] = offC[h][i]; } }
        PG8_STA(0, 0, cA, gA, offC); PG8_STA(0, 1, cA, gA, offC);
        pre();
        if (wr == 1) PG8_BAR;
        PG8_WAIT_V(2); PG8_BAR;
        PG8_STAGE(PG8_SB(1, 0), cB + kstep, voffB); PG8_STA(1, 0, cA + kstep, gA + kstep, offC); PG8_STAGE(PG8_SB(1, 1), cB + hstep + kstep, voffB);
        PG8_WAIT_V(6); PG8_BAR;
    } else {
        PG8_STAGE(PG8_SB(0, 0), cB, voffB); PG8_STAGE(PG8_SA(0, 0), cA, voffA); PG8_STAGE(PG8_SB(0, 1), cB + hstep, voffB); PG8_STAGE(PG8_SA(0, 1), cA + hstep, voffA);
        if (wr == 1) PG8_BAR;
        PG8_WAIT_V(4); PG8_BAR;
        PG8_STAGE(PG8_SB(1, 0), cB + kstep, voffB); PG8_STAGE(PG8_SA(1, 0), cA + kstep, voffA); PG8_STAGE(PG8_SB(1, 1), cB + hstep + kstep, voffB);
        PG8_WAIT_V(6); PG8_BAR;
    }
    for (;;) {
        const bool has_next = S.next(ui + 1, nxt);
        if (has_next) S.a_ready(nxt);
        if constexpr (GATHER) { if (has_next) {
#pragma unroll
            for (int h = 0; h < 2; ++h)
#pragma unroll
                for (int i = 0; i < 2; ++i) offN[h][i] = S.arow(ui + 1, 128 * h + gR[i]) + (unsigned)gC[i]; } }
        const char* nA = has_next ? (const char*)g.A + (size_t)nxt.pm * tstep : cA; const char* nB = has_next ? (const char*)g.Bt + (size_t)nxt.pn * tstep : cB;
        for (int t = 0; t < nt; t += 2) {
            const bool last = (t == nt - 2);
            const char* a1 = cA + (size_t)(t + 1) * kstep;
            const char* a2 = last ? nA : cA + (size_t)(t + 2) * kstep; const char* b2 = last ? nB : cB + (size_t)(t + 2) * kstep;
            const char* a3 = a2 + kstep; const char* b3 = b2 + kstep;
            const char* g2 = gA + (last ? (size_t)0 : (size_t)(t + 2) * kstep); unsigned offS[2][2];
#pragma unroll
            for (int h = 0; h < 2; ++h)
#pragma unroll
                for (int i = 0; i < 2; ++i) offS[h][i] = last ? offN[h][i] : offC[h][i];
            (void)g2; (void)offS;
            if constexpr (SP2) {
            PG8_LDB(B0, 0, 0); PG8_LDB(B1, 0, 1); PG8_SCHED; PG8_LDA(At, 0, 0); PG8_STA(1, 1, a1, gA + (size_t)(t + 1) * kstep, offC);
            PG8_WAIT_V(8); PG8_WAIT_L(0); PG8_BAR; PG8_MMA(0, 0, At, B0); PG8_MMA(0, 1, At, B1); PG8_BAR; PG8_SCHED;
            PG8_LDA(At, 0, 1); PG8_STAGE(PG8_SB(0, 0), b2, voffB); PG8_STAGE(PG8_SB(0, 1), b2 + hstep, voffB); PG8_STA(0, 0, a2, g2, offS);
            PG8_WAIT_V(8); PG8_WAIT_L(0); PG8_BAR; PG8_MMA(1, 0, At, B0); PG8_MMA(1, 1, At, B1); PG8_BAR; PG8_SCHED;
            PG8_LDB(B0, 1, 0); PG8_LDB(B1, 1, 1); PG8_SCHED; PG8_LDA(At, 1, 0); PG8_STA(0, 1, a2, g2, offS);
            PG8_WAIT_V(8); PG8_WAIT_L(0); PG8_BAR; PG8_MMA(0, 0, At, B0); PG8_MMA(0, 1, At, B1); PG8_BAR; PG8_SCHED;
            PG8_LDA(At, 1, 1); PG8_STAGE(PG8_SB(1, 0), b3, voffB); PG8_STAGE(PG8_SB(1, 1), b3 + hstep, voffB); PG8_STA(1, 0, a3, g2 + kstep, offS);
            PG8_WAIT_V(8); PG8_WAIT_L(0); PG8_BAR; PG8_MMA(1, 0, At, B0); PG8_MMA(1, 1, At, B1); PG8_BAR; PG8_SCHED;
            } else {
            PG8_LDB(B0, 0, 0); PG8_SCHED; PG8_LDA(At, 0, 0); PG8_STAGE(PG8_SA(1, 1), a1 + hstep, voffA);
            PG8_WAIT_L(8); PG8_BAR; PG8_WAIT_L(0); PG8_MMA(0, 0, At, B0); PG8_BAR; PG8_SCHED;
            PG8_LDB(B1, 0, 1); PG8_STAGE(PG8_SB(0, 0), b2, voffB);
            PG8_BAR; PG8_WAIT_L(0); PG8_MMA(0, 1, At, B1); PG8_BAR;
            PG8_LDA(At, 0, 1); PG8_STAGE(PG8_SA(0, 0), a2, voffA);
            PG8_BAR; PG8_WAIT_L(0); PG8_MMA(1, 0, At, B0); PG8_BAR; PG8_SCHED;
            PG8_STAGE(PG8_SB(0, 1), b2 + hstep, voffB);
            PG8_WAIT_V(6); PG8_BAR; PG8_MMA(1, 1, At, B1); PG8_BAR;
            PG8_LDB(B0, 1, 0); PG8_SCHED; PG8_LDA(At, 1, 0); PG8_STAGE(PG8_SA(0, 1), a2 + hstep, voffA);
            PG8_WAIT_L(8); PG8_BAR; PG8_WAIT_L(0); PG8_MMA(0, 0, At, B0); PG8_BAR; PG8_SCHED;
            PG8_LDB(B1, 1, 1); PG8_STAGE(PG8_SB(1, 0), b3, voffB);
            PG8_BAR; PG8_WAIT_L(0); PG8_MMA(0, 1, At, B1); PG8_BAR;
            PG8_LDA(At, 1, 1); PG8_STAGE(PG8_SA(1, 0), a3, voffA);
            PG8_BAR; PG8_WAIT_L(0); PG8_MMA(1, 0, At, B0); PG8_BAR; PG8_SCHED;
            PG8_STAGE(PG8_SB(1, 1), b3 + hstep, voffB);
            PG8_WAIT_V(6); PG8_BAR; PG8_MMA(1, 1, At, B1); PG8_BAR;
            }
        }
        if constexpr (ALIGN_EPI) { if (wr == 0) PG8_BAR; }
        if constexpr (!Epi::AFTER_DRAIN) { E(acc, cur, wr, wc, fr, fq); S.done(cur); }
        if (!has_next) break;
#pragma unroll
        for (int a = 0; a < 2; ++a)
#pragma unroll
            for (int b = 0; b < 2; ++b)
#pragma unroll
                for (int m = 0; m < 4; ++m)
#pragma unroll
                    for (int n = 0; n < 2; ++n) acc[a][b][m][n] = (f32x4){0.f, 0.f, 0.f, 0.f};
        cur = nxt; cA = nA; cB = nB; ++ui;
#pragma unroll
        for (int h = 0; h < 2; ++h)
#pragma unroll
            for (int i = 0; i < 2; ++i) offC[h][i] = offN[h][i];
        if constexpr (ALIGN_EPI) { if (wr == 1) PG8_BAR; }
    }
    PG8_WAIT_V(0);
    if constexpr (!ALIGN_EPI) { if (wr == 0) PG8_BAR; }
    PG8_BAR;
    if constexpr (Epi::AFTER_DRAIN) { E.fused(acc, cur, wr, wc, fr, fq, lds, wid, lane); S.done(cur); }
#undef PG8_SA
#undef PG8_SB
#undef PG8_STAGE
#undef PG8_STAGE_C
#undef PG8_STA
#undef PG8_LDA
#undef PG8_LDB
#undef PG8_MMA
#undef PG8_WAIT_V
#undef PG8_WAIT_L
#undef PG8_BAR
#undef PG8_SCHED
}

typedef unsigned u32x4e __attribute__((ext_vector_type(4)));
__device__ __forceinline__ f32x4 i2f4r(const f32x4 r) { const float a = r.x, b = r.y, c = r.z, d = r.w; return (f32x4){(float)__float_as_int(a), (float)__float_as_int(b), (float)__float_as_int(c), (float)__float_as_int(d)}; }
__device__ __forceinline__ f32x4 i2f4(const f32x4 r, float s) { const float a = r.x, b = r.y, c = r.z, d = r.w; return (f32x4){(float)__float_as_int(a) * s, (float)__float_as_int(b) * s, (float)__float_as_int(c) * s, (float)__float_as_int(d) * s}; }
typedef unsigned u32x2e __attribute__((ext_vector_type(2)));
struct EpiInProj {
    static constexpr bool PERM = true, AFTER_DRAIN = false;
    bf16_t* O; const float* cosT; const float* sinT; float qscale, dq;
    unsigned* smn;
    unsigned* nrm;
    __device__ __forceinline__ void operator()(const f32x4 (&acc)[2][2][4][2], const Unit& u, int wr, int wc, int fr, int fq) const {
        const int row0 = u.pm * BM + wr * 64 + fr;
        if (u.pn < 4) {
            const float sc = (u.pn < 2 ? qscale : 1.f) * dq; const int colb = (u.pn * 4 + wc) * 64 + 8 * fq;
            f32x4 tb[2][4];
            { const int pos = row0 & 4095; tb[0][0] = *(const f32x4*)(cosT + pos * 32 + 8 * fq); tb[0][1] = *(const f32x4*)(cosT + pos * 32 + 8 * fq + 4); tb[0][2] = *(const f32x4*)(sinT + pos * 32 + 8 * fq); tb[0][3] = *(const f32x4*)(sinT + pos * 32 + 8 * fq + 4); }
#pragma unroll
            for (int ai = 0; ai < 2; ++ai)
#pragma unroll
                for (int m = 0; m < 4; ++m) { const int row = row0 + ai * HALF + m * 16; constexpr int dummy_ = 0; (void)dummy_;
                    const int cur = (ai * 4 + m) & 1;
                    if (ai * 4 + m < 7) { const int nrow = row0 + ((ai * 4 + m + 1) >> 2) * HALF + ((ai * 4 + m + 1) & 3) * 16, npos = nrow & 4095;
                        tb[cur ^ 1][0] = *(const f32x4*)(cosT + npos * 32 + 8 * fq); tb[cur ^ 1][1] = *(const f32x4*)(cosT + npos * 32 + 8 * fq + 4); tb[cur ^ 1][2] = *(const f32x4*)(sinT + npos * 32 + 8 * fq); tb[cur ^ 1][3] = *(const f32x4*)(sinT + npos * 32 + 8 * fq + 4); }
                    const f32x4 c0 = tb[cur][0], c1 = tb[cur][1], s0 = tb[cur][2], s1 = tb[cur][3];
                    const f32x4 a0 = i2f4r(acc[ai][0][m][0]), a1 = i2f4r(acc[ai][0][m][1]), b0 = i2f4r(acc[ai][1][m][0]), b1 = i2f4r(acc[ai][1][m][1]);
                    const f32x4 p0 = (a0 * c0 - b0 * s0) * sc, p1 = (a1 * c1 - b1 * s1) * sc, q0 = (b0 * c0 + a0 * s0) * sc, q1 = (b1 * c1 + a1 * s1) * sc;
                    u32x4e w; w.x = cvt_pk_bf16(p0[0], p0[1]); w.y = cvt_pk_bf16(p0[2], p0[3]); w.z = cvt_pk_bf16(p1[0], p1[1]); w.w = cvt_pk_bf16(p1[2], p1[3]);
                    bf16_t* rp = O + (size_t)row * 3072 + colb; *(u32x4e*)rp = w;
                    w.x = cvt_pk_bf16(q0[0], q0[1]); w.y = cvt_pk_bf16(q0[2], q0[3]); w.z = cvt_pk_bf16(q1[0], q1[1]); w.w = cvt_pk_bf16(q1[2], q1[3]); *(u32x4e*)(rp + 32) = w; }
        } else {
            if (u.pn >= 6 && u.pn <= 9) {
                const int hp = u.pn - 6, colq = 1536 + hp * 128 + wc * 32 + 8 * fq; const float sq_ = qscale * dq * dq;
                float nq = 0.f, nk[2] = {0.f, 0.f}, smin = 3.0e38f;
#pragma unroll
                for (int ai = 0; ai < 2; ++ai)
#pragma unroll
                    for (int m = 0; m < 4; ++m) { bf16_t* rp = O + (size_t)(row0 + ai * HALF + m * 16) * 3072 + colq;
                        const f32x4 q0 = i2f4(acc[ai][0][m][0], sq_), q1 = i2f4(acc[ai][0][m][1], sq_), k0 = i2f4r(acc[ai][1][m][0]), k1 = i2f4r(acc[ai][1][m][1]);
                        u32x4e w; w.x = cvt_pk_bf16(q0[0], q0[1]); w.y = cvt_pk_bf16(q0[2], q0[3]); w.z = cvt_pk_bf16(q1[0], q1[1]); w.w = cvt_pk_bf16(q1[2], q1[3]); *(u32x4e*)rp = w;
                        w.x = cvt_pk_bf16(k0[0], k0[1]); w.y = cvt_pk_bf16(k0[2], k0[3]); w.z = cvt_pk_bf16(k1[0], k1[1]); w.w = cvt_pk_bf16(k1[2], k1[3]); *(u32x4e*)(rp + 512) = w;
                        float a = hsum4(q0 * q0 + q1 * q1), b_ = hsum4(k0 * k0 + k1 * k1), d = hsum4(q0 * k0 + q1 * k1);
                        a = swap16_add(a, a); a = swap32_add(a, a); b_ = swap16_add(b_, b_); b_ = swap32_add(b_, b_); d = swap16_add(d, d); d = swap32_add(d, d);
                        nq = fmaxf(nq, a); nk[ai] = fmaxf(nk[ai], b_); smin = fminf(smin, d); }
                nq = fmaxf(nq, dppf<0xB1>(nq)); nq = fmaxf(nq, dppf<0x4E>(nq)); nq = fmaxf(nq, dppf<0x141>(nq)); nq = fmaxf(nq, dppf<0x128>(nq));
#pragma unroll
                for (int ai = 0; ai < 2; ++ai) { float v = nk[ai]; v = fmaxf(v, dppf<0xB1>(v)); v = fmaxf(v, dppf<0x4E>(v)); v = fmaxf(v, dppf<0x141>(v)); v = fmaxf(v, dppf<0x128>(v)); nk[ai] = v; }
                smin = fminf(smin, dppf<0xB1>(smin)); smin = fminf(smin, dppf<0x4E>(smin)); smin = fminf(smin, dppf<0x141>(smin)); smin = fminf(smin, dppf<0x128>(smin));
                if (fr == 0 && fq == 0) { const int b = (u.pm * BM) >> 12, qb = u.pm & 15, h = hp * 2 + (wc >> 1);
                    atomicMax(nrm + (CW_QB - CW_NORM) + ((b * 8 + h) * 16 + qb) * 2 + (wc & 1), __float_as_uint(nq));
                    atomicMax(nrm + (CW_KT - CW_NORM) + ((b * 8 + h) * 64 + qb * 4 + wr) * 2 + (wc & 1), __float_as_uint(nk[0]));
                    atomicMax(nrm + (CW_KT - CW_NORM) + ((b * 8 + h) * 64 + qb * 4 + 2 + wr) * 2 + (wc & 1), __float_as_uint(nk[1]));
                    const int si = __float_as_int(smin); atomicMin((int*)smn + (((b * 8 + h) * 16 + qb) * 2 + (wc & 1)), si >= 0 ? si : si ^ 0x7fffffff); }
            } else {
            const int col0 = u.pn * BM + wc * 32 + 8 * fq;
#pragma unroll
            for (int ai = 0; ai < 2; ++ai)
#pragma unroll
                for (int m = 0; m < 4; ++m) { bf16_t* rp = O + (size_t)(row0 + ai * HALF + m * 16) * 3072 + col0;
#pragma unroll
                    for (int bj = 0; bj < 2; ++bj) { const f32x4 v0 = i2f4r(acc[ai][bj][m][0]), v1 = i2f4r(acc[ai][bj][m][1]);
                        u32x4e w; w.x = cvt_pk_bf16(v0[0], v0[1]); w.y = cvt_pk_bf16(v0[2], v0[3]); w.z = cvt_pk_bf16(v1[0], v1[1]); w.w = cvt_pk_bf16(v1[2], v1[3]); *(u32x4e*)(rp + bj * HALF) = w; } }
            }
        }
    }
};
struct EpiBf16P {
    static constexpr bool PERM = true, AFTER_DRAIN = false;
    bf16_t* C; int ldc; float dq;
    __device__ __forceinline__ void operator()(const f32x4 (&acc)[2][2][4][2], const Unit& u, int wr, int wc, int fr, int fq) const {
        const int row0 = u.pm * BM + wr * 64 + fr, col0 = u.pn * BM + wc * 32 + 8 * fq;
#pragma unroll
        for (int ai = 0; ai < 2; ++ai)
#pragma unroll
            for (int m = 0; m < 4; ++m) { bf16_t* rp = C + (size_t)(row0 + ai * HALF + m * 16) * ldc + col0;
#pragma unroll
                for (int bj = 0; bj < 2; ++bj) { const f32x4 v0 = i2f4(acc[ai][bj][m][0], dq), v1 = i2f4(acc[ai][bj][m][1], dq);
                    u32x4e w; w.x = cvt_pk_bf16(v0[0], v0[1]); w.y = cvt_pk_bf16(v0[2], v0[3]); w.z = cvt_pk_bf16(v1[0], v1[1]); w.w = cvt_pk_bf16(v1[2], v1[3]); *(u32x4e*)(rp + bj * HALF) = w; } }
    }
};
struct EpiF32 {
    static constexpr bool PERM = false, AFTER_DRAIN = false;
    float* C; int ldc;
    __device__ __forceinline__ void operator()(const f32x4 (&acc)[2][2][4][2], const Unit& u, int wr, int wc, int fr, int fq) const {
        const int row0 = u.pm * BM + wr * 64 + fr, col0 = u.pn * BM + wc * 32 + 4 * fq;
#pragma unroll
        for (int ai = 0; ai < 2; ++ai)
#pragma unroll
            for (int m = 0; m < 4; ++m) { float* rp = C + (size_t)(row0 + ai * HALF + m * 16) * ldc + col0;
#pragma unroll
                for (int bj = 0; bj < 2; ++bj)
#pragma unroll
                    for (int n = 0; n < 2; ++n) *(f32x4*)(rp + bj * HALF + n * 16) = acc[ai][bj][m][n]; }
    }
};

__device__ __forceinline__ unsigned qpk4(float a, float b, float c, float d, float s) {
    unsigned w = __builtin_amdgcn_cvt_pk_u8_f32(__builtin_fmaf(a, s, 128.f), 0, 0u); w = __builtin_amdgcn_cvt_pk_u8_f32(__builtin_fmaf(b, s, 128.f), 1, w);
    w = __builtin_amdgcn_cvt_pk_u8_f32(__builtin_fmaf(c, s, 128.f), 2, w); w = __builtin_amdgcn_cvt_pk_u8_f32(__builtin_fmaf(d, s, 128.f), 3, w); return w ^ 0x80808080u; }
struct EpiSwiGLU {
    static constexpr bool PERM = true, AFTER_DRAIN = false;
    bf16_t* ACT; float dq, qa;
    __device__ __forceinline__ void operator()(const f32x4 (&acc)[2][2][4][2], const Unit& u, int wr, int wc, int fr, int fq) const {
        const int row0 = u.pm * BM + wr * 64 + fr, col0 = (u.pn & 3) * 128 + wc * 32 + 8 * fq;
        const float nl2 = -dq * 1.4426950408889634f, c3 = dq * dq * qa; const f32x2 nl2v = {nl2, nl2}, c3v = {c3, c3}, onev = {1.f, 1.f}, b128v = {128.f, 128.f};
#pragma unroll
        for (int ai = 0; ai < 2; ++ai)
#pragma unroll
            for (int m = 0; m < 4; ++m) { u32x2e w;
#pragma unroll
                for (int n = 0; n < 2; ++n) { const f32x4 gr = acc[ai][0][m][n], ur = acc[ai][1][m][n];
                    const float g0 = gr.x, g1 = gr.y, g2 = gr.z, g3 = gr.w, u0 = ur.x, u1 = ur.y, u2 = ur.z, u3 = ur.w;
                    const f32x2 ga = {(float)__float_as_int(g0), (float)__float_as_int(g1)}, gb = {(float)__float_as_int(g2), (float)__float_as_int(g3)};
                    const f32x2 ua = {(float)__float_as_int(u0), (float)__float_as_int(u1)}, ub = {(float)__float_as_int(u2), (float)__float_as_int(u3)};
                    const f32x2 ta = ga * nl2v, tb = gb * nl2v;
                    const f32x2 ea = (f32x2){__builtin_amdgcn_exp2f(ta.x), __builtin_amdgcn_exp2f(ta.y)} + onev, eb = (f32x2){__builtin_amdgcn_exp2f(tb.x), __builtin_amdgcn_exp2f(tb.y)} + onev;
                    const f32x2 ra = {__builtin_amdgcn_rcpf(ea.x), __builtin_amdgcn_rcpf(ea.y)}, rb = {__builtin_amdgcn_rcpf(eb.x), __builtin_amdgcn_rcpf(eb.y)};
                    const f32x2 pa = (ga * ra) * (ua * c3v) + b128v, pb = (gb * rb) * (ub * c3v) + b128v;
                    unsigned q = __builtin_amdgcn_cvt_pk_u8_f32(pa.x, 0, 0u); q = __builtin_amdgcn_cvt_pk_u8_f32(pa.y, 1, q); q = __builtin_amdgcn_cvt_pk_u8_f32(pb.x, 2, q); q = __builtin_amdgcn_cvt_pk_u8_f32(pb.y, 3, q);
                    if (n == 0) w.x = q ^ 0x80808080u; else w.y = q ^ 0x80808080u; }
                asm volatile("global_store_dwordx2 %0, %1, off sc0 sc1" :: "v"((unsigned char*)ACT + (size_t)(row0 + ai * HALF + m * 16) * 512 + col0), "v"(w) : "memory"); }
    }
};
struct EpiScatter {
    static constexpr bool PERM = true, AFTER_DRAIN = false;
    bf16_t* YS; const PG8_LAS int* stab; float dq;
    __device__ __forceinline__ void operator()(const f32x4 (&acc)[2][2][4][2], const Unit& u, int wr, int wc, int fr, int fq) const {
        const int col0 = (u.pn & 3) * BM + wc * 32 + 8 * fq;
#pragma unroll
        for (int ai = 0; ai < 2; ++ai)
#pragma unroll
            for (int m = 0; m < 4; ++m) { const int slot = stab[u.aux * 256 + ai * HALF + wr * 64 + m * 16 + fr];
                if (slot >= 0) { unsigned char* rp = (unsigned char*)YS + (size_t)slot * 1024 + col0;
#pragma unroll
                    for (int bj = 0; bj < 2; ++bj) { const f32x4 r0 = acc[ai][bj][m][0], r1 = acc[ai][bj][m][1];
                        const f32x4 v0 = (f32x4){(float)__float_as_int(r0.x), (float)__float_as_int(r0.y), (float)__float_as_int(r0.z), (float)__float_as_int(r0.w)} * dq, v1 = (f32x4){(float)__float_as_int(r1.x), (float)__float_as_int(r1.y), (float)__float_as_int(r1.z), (float)__float_as_int(r1.w)} * dq;
                        u32x2e w; w.x = (unsigned)__builtin_amdgcn_cvt_pk_fp8_f32(v0[2], v0[3], __builtin_amdgcn_cvt_pk_fp8_f32(v0[0], v0[1], 0, false), true);
                        w.y = (unsigned)__builtin_amdgcn_cvt_pk_fp8_f32(v1[2], v1[3], __builtin_amdgcn_cvt_pk_fp8_f32(v1[0], v1[1], 0, false), true); *(u32x2e*)(rp + bj * HALF) = w; } } }
    }
};
struct MoeSched {
    const PG8_LAS int* ut;
    const PG8_LAS unsigned* tab;
    __device__ __forceinline__ bool next(int i, Unit& u) const { if (i >= 8) return false; const int pm = __builtin_amdgcn_readfirstlane(ut[2 * i]); if (pm < 0) return false;
        u.pm = pm; u.pn = __builtin_amdgcn_readfirstlane(ut[2 * i + 1]); u.aux = i; return true; }
    unsigned* tc; int mode;
    __device__ __forceinline__ unsigned arow(int ui, int r) const { return tab[ui * 256 + r]; }
    __device__ __forceinline__ void a_ready(const Unit& u) const { if (mode == 2) { unsigned* q = tc + u.pm * 16;
        while (__hip_atomic_load(q, __ATOMIC_RELAXED, __HIP_MEMORY_SCOPE_AGENT) < 32u) __builtin_amdgcn_s_sleep(2);
        asm volatile("" ::: "memory"); } }
    __device__ __forceinline__ void done(const Unit& u) const { if (mode == 1) { asm volatile("s_waitcnt vmcnt(0)" ::: "memory");
        if ((threadIdx.x & 63) == 0) __hip_atomic_fetch_add(tc + u.pm * 16, 1u, __ATOMIC_RELAXED, __HIP_MEMORY_SCOPE_AGENT); } }
};
}

constexpr int LDS_BYTES = 151552;
constexpr int MOE_LDS = 131072;
constexpr int MISC_OFF = 147712;
constexpr int CW_BAR = 4096;
#define GAS __attribute__((address_space(1)))
#define LAS __attribute__((address_space(3)))
typedef GAS unsigned gu32;
typedef GAS unsigned long long gu64;
#define RLX_AGENT __ATOMIC_RELAXED, __HIP_MEMORY_SCOPE_AGENT
#define LDS_WAIT() asm volatile("s_waitcnt lgkmcnt(0)" ::: "memory")
#define VM_WAIT() asm volatile("s_waitcnt vmcnt(0)" ::: "memory")
#define XB_TMO      128
#define XB_XCNT(j)  (256  + 64 * (j))
#define XB_XSUB(j)  (1280 + 64 * (j))
#define XB_XGEN(j)  (2304 + 64 * (j))
#define XB_TOP      3328
#define XB_TOPGEN   3392
#define XCD_BAR_WORDS 3456
#define XB_SPIN_CAP (1u << 22)

__device__ __forceinline__ unsigned xb_ld(unsigned* p)              { return __hip_atomic_load(p, __ATOMIC_RELAXED, __HIP_MEMORY_SCOPE_AGENT); }
__device__ __forceinline__ unsigned xb_add(unsigned* p, unsigned v) { return __hip_atomic_fetch_add(p, v, __ATOMIC_RELAXED, __HIP_MEMORY_SCOPE_AGENT); }
__device__ __forceinline__ unsigned xb_xcc_id() { return (unsigned)__builtin_amdgcn_s_getreg((3 << 11) | 20) & 0xFu; }
#define XB_SPIN(cond, bar) do { unsigned _sp = 0; while (cond) { __builtin_amdgcn_s_sleep(1); \
    if ((++_sp & 255u) == 0u) { if (xb_ld(&(bar)[XB_TMO])) break; if (_sp > XB_SPIN_CAP) { atomicAdd(&(bar)[XB_TMO], 1u); break; } } } } while (0)

struct XcdBarrier {
    unsigned* bar; unsigned x;
    volatile LAS unsigned* st;
};

__device__ __forceinline__ XcdBarrier xcd_barrier_post(unsigned* bar, volatile LAS unsigned* st) {
    XcdBarrier b; b.bar = bar; b.x = xb_xcc_id(); b.st = st;
    if (threadIdx.x == 0) (void)xb_add(&bar[XB_XCNT(b.x)], 1u);
    return b;
}
__device__ __forceinline__ void xcd_barrier_complete(unsigned* bar, unsigned x, unsigned& nloc, unsigned& nx) {
    const unsigned G = gridDim.x * gridDim.y * gridDim.z;
    unsigned sum, cnt, mine, sp = 0u;
    for (;;) {
        sum = 0u; cnt = 0u; mine = 0u;
#pragma unroll
        for (unsigned j = 0; j < 16; ++j) { const unsigned c = xb_ld(&bar[XB_XCNT(j)]); sum += c; cnt += (c > 0u) ? 1u : 0u; mine = (j == x) ? c : mine; }
        if (sum == G) break;
        __builtin_amdgcn_s_sleep(1);
        if ((++sp & 255u) == 0u) { if (xb_ld(&bar[XB_TMO])) break; if (sp > XB_SPIN_CAP) { atomicAdd(&bar[XB_TMO], 1u); break; } }
    }
    nloc = mine > 0u ? mine : 1u; nx = cnt > 0u ? cnt : 1u;
}

__device__ __forceinline__ void xcd_barrier(const XcdBarrier& b) {
    asm volatile("s_waitcnt vmcnt(0)" ::: "memory");
    __syncthreads();
    if (threadIdx.x == 0) {
        unsigned* bar = b.bar;
        __builtin_amdgcn_s_waitcnt(0);
        unsigned nloc = b.st[0], nx = b.st[1];
        if (nloc == 0u) { xcd_barrier_complete(bar, b.x, nloc, nx); b.st[0] = nloc; b.st[1] = nx; }
        const unsigned old = xb_add(&bar[XB_XSUB(b.x)], 1u);
        const unsigned gen = old / nloc;
        if (old + 1u == (gen + 1u) * nloc) {
            __builtin_amdgcn_fence(__ATOMIC_RELEASE, "agent");
            asm volatile("s_waitcnt vmcnt(0)" ::: "memory");
            const unsigned og = xb_add(&bar[XB_TOP], 1u);
            const unsigned tg = og / nx;
            if (og + 1u == (tg + 1u) * nx) xb_add(&bar[XB_TOPGEN], 1u);
            else XB_SPIN(xb_ld(&bar[XB_TOPGEN]) == tg, bar);
            __builtin_amdgcn_fence(__ATOMIC_ACQUIRE, "agent");
            xb_add(&bar[XB_XGEN(b.x)], 1u);
            asm volatile("s_waitcnt vmcnt(0)" ::: "memory");
        } else {
            XB_SPIN(xb_ld(&bar[XB_XGEN(b.x)]) == gen, bar);
            __builtin_amdgcn_fence(__ATOMIC_ACQUIRE, "agent");
            asm volatile("s_waitcnt vmcnt(0)" ::: "memory");
        }
    }
    __syncthreads();
}

__device__ __forceinline__ void inproj_phase(const P& p, PG8_LAS unsigned char* l3, int c, int G) {
    pg8::Gemm g{(const bf16*)(p.ws + WS_H), (const bf16*)(p.ws + WS_WIN), T, NQKV, D};
    pg8::StaticOrder S; S.init(T, NQKV, G, c);
    const float* cosT = (const float*)(p.ws + WS_ROPE);
    pg8::EpiInProj E{(bf16*)(p.ws + WS_R), cosT, cosT + SEQ * 32, 0.125f * 1.4426950408889634f, 1.f / (Q8_ACT * Q8_W), (unsigned*)(p.ws + WS_CTL) + CW_SMIN, (unsigned*)(p.ws + WS_CTL) + CW_NORM};
    auto pre = [&]() __attribute__((always_inline)) { scan_phase(p, (float*)((unsigned char*)l3 + MOE_LDS), c, G); };
    pg8::gemm_phase<pg8::EpiInProj, pg8::StaticOrder, true, true, false, true, false, decltype(pre)>(l3, g, S, E, pre);
}
__device__ __forceinline__ void outproj_phase(const P& p, PG8_LAS unsigned char* l3, int c, int G) {
    pg8::Gemm g{(const bf16*)(p.ws + WS_H), (const bf16*)(p.ws + WS_WOUT), T, D, D};
    pg8::StaticOrder S; S.init(T, D, G, c);
    pg8::EpiBf16P E{(bf16*)(p.ws + WS_R), D, 1.f / (Q8_MIX * Q8_W)};
    pg8::gemm_phase<pg8::EpiBf16P, pg8::StaticOrder, true, true, false, true>(l3, g, S, E);
}
__device__ __forceinline__ void moe_setup(const P& p, PG8_LAS unsigned char* ldsx, int c, int G, bool down, int part = 0) {
    const int tid = tid_fresh();
    PG8_LAS int* ts = (PG8_LAS int*)ldsx; PG8_LAS int* ut = (PG8_LAS int*)(ldsx + 256); PG8_LAS int* tab = (PG8_LAS int*)(ldsx + 512);
    const unsigned* cnt = (const unsigned*)(p.ws + WS_CTL); const int* list = (const int*)(p.ws + WS_LIST);
    PG8_LAS int* cn = (PG8_LAS int*)(ldsx + 8704);
    if (!down && part != 2) {
        if (tid == 0) { int s = 0; for (int e = 0; e < NE; ++e) { const int n = (int)cnt[e * CNT_STRIDE]; cn[e] = n; ts[e] = s; s += (n + 255) >> 8; } ts[NE] = s; }
        __syncthreads(); }
    if (part != 2) {
    if (tid < 8) { const int NU = ts[NE] * 4, cx = (G % 8 == 0) ? (c % 8) * (G / 8) + c / 8 : c, cv = down ? (cx + G - NU % G) % G : cx, L = tid * G + cv;
        if (L < NU) { const int t = L >> 2; int e = 0; for (int q = 1; q < NE; ++q) if (ts[q] <= t) e = q; ut[2 * tid] = t; ut[2 * tid + 1] = e * 4 + (L & 3); } else { ut[2 * tid] = -1; ut[2 * tid + 1] = 0; } }
    __syncthreads();
    }
    if (part == 1) return;
    for (int idx = tid; idx < 8 * 256; idx += 512) { const int i = idx >> 8, r = idx & 255, pm = ut[2 * i]; int v = down ? -1 : 0;
        if (pm >= 0) { const int e = ut[2 * i + 1] >> 2, k = (pm - ts[e]) * 256 + r; if (k < cn[e]) { const int slot = list[e * T + k]; v = down ? slot : (slot >> 1) * D; } }
        tab[idx] = v; }
    __syncthreads();
}
__device__ __forceinline__ void moe1_phase(const P& p, PG8_LAS unsigned char* l3, int c, int G) {
    moe_setup(p, l3 + MOE_LDS, c, G, false, 1);
    auto mid = [&]() __attribute__((always_inline)) { moe_setup(p, l3 + MOE_LDS, c, G, false, 2); };
    pg8::Gemm g{(const bf16*)(p.ws + WS_H), (const bf16*)(p.ws + WS_WGU), 0, 0, D};
    pg8::MoeSched S{(const PG8_LAS int*)(l3 + MOE_LDS + 256), (const PG8_LAS unsigned*)(l3 + MOE_LDS + 512), (unsigned*)(p.ws + WS_CTL) + CW_TILE, 1};
    pg8::EpiSwiGLU E{(bf16*)(p.ws + WS_ACT), 1.f / (Q8_ACT * Q8_W), Q8_ACT2};
    pg8::gemm_phase<pg8::EpiSwiGLU, pg8::MoeSched, true, true, true, true, false, pg8::NoPreG, decltype(mid)>(l3, g, S, E, pg8::NoPreG(), mid);
}
__device__ __forceinline__ void moe2_phase(const P& p, PG8_LAS unsigned char* l3, int c, int G) {
    moe_setup(p, l3 + MOE_LDS, c, G, true, 1);
    auto pre = [&]() __attribute__((always_inline)) { moe_setup(p, l3 + MOE_LDS, c, G, true, 2); };
    pg8::Gemm g{(const bf16*)(p.ws + WS_ACT), (const bf16*)(p.ws + WS_WD), 0, 0, DE};
    pg8::MoeSched S{(const PG8_LAS int*)(l3 + MOE_LDS + 256), (const PG8_LAS unsigned*)(l3 + MOE_LDS + 512), (unsigned*)(p.ws + WS_CTL) + CW_TILE, 2};
    pg8::EpiScatter E{(bf16*)(p.ws + WS_R), (const PG8_LAS int*)(l3 + MOE_LDS + 512), 16.f / (Q8_ACT2 * Q8_WD)};
    pg8::gemm_phase<pg8::EpiScatter, pg8::MoeSched, true, true, false, true, true, decltype(pre)>(l3, g, S, E, pre);
}

namespace attn_body {
using bf16=__hip_bfloat16;
using bf16x8=__attribute__((ext_vector_type(8)))short;
using s16x4=__attribute__((ext_vector_type(4)))short;
using f32x16=__attribute__((ext_vector_type(16)))float;
using u32x4=__attribute__((ext_vector_type(4)))unsigned;
using f32x4v=__attribute__((ext_vector_type(4)))float;
constexpr int SEQ=4096,D=64,QP=3072,OP=1024;
constexpr int NW=8,QBLK=32,QB=QBLK*NW,KVBLK=64,NQB=SEQ/QB;
__device__ __forceinline__ int crow(int r,int hi){return (r&3)+8*(r>>2)+4*hi;}
#define SBAR() __builtin_amdgcn_sched_barrier(0)
__device__ __forceinline__ void cmask(f32x16&p0,f32x16&p1,int jb,int qrel,int hi){
  const float NEG=-INFINITY; int kb=64*jb+4*hi;
  #pragma unroll
  for(int r=0;r<16;++r){int kv=kb+(r&3)+8*(r>>2); if(kv>qrel)p0[r]=NEG; if(kv+32>qrel)p1[r]=NEG;}
}

__device__ __forceinline__ void chmask(f32x16&p0,f32x16&p1,int jb,int wid){
  const float NEG=-INFINITY;
  if(jb>(wid>>1)){
  #pragma unroll
  for(int r=0;r<16;++r){p0[r]=NEG;p1[r]=NEG;}}
}
constexpr int NSLOT=3, SLOTB=8192;
constexpr int LDS_K=0, LDS_V=NSLOT*SLOTB, LDS_WS=LDS_V+2*NSLOT*SLOTB, LDS_OST=LDS_WS+NW*64*4, LDS_BYTES=LDS_OST+NW*4096, LDS_FB=LDS_BYTES, LDS_Y=LDS_OST;
static_assert(LDS_Y+NW*8192<=147456 && LDS_FB+16384<=147456, "attention LDS map");
constexpr float C2=0.125f*1.4426950408889634f;
__device__ __forceinline__ void glds16(const void*gsrc,unsigned lds_dst){unsigned keep;
  asm volatile("s_mov_b32 %0, m0\n\ts_mov_b32 m0, %2\n\ts_nop 0\n\tglobal_load_lds_dwordx4 %1, off\n\ts_mov_b32 m0, %0":"=&s"(keep):"v"(gsrc),"s"(lds_dst):"memory");}
__device__ __forceinline__ void glds16s(const void*sbase0,unsigned voff,unsigned lds_dst){unsigned keep;
  const unsigned long long sb_=(unsigned long long)(uintptr_t)sbase0; const void*sbase=(const void*)(uintptr_t)(((unsigned long long)(unsigned)__builtin_amdgcn_readfirstlane((int)(sb_>>32))<<32)|(unsigned)__builtin_amdgcn_readfirstlane((int)sb_));
  asm volatile("s_mov_b32 %0, m0\n\ts_mov_b32 m0, %2\n\ts_nop 0\n\tglobal_load_lds_dwordx4 %1, %3\n\ts_mov_b32 m0, %0":"=&s"(keep):"v"(voff),"s"(lds_dst),"s"(sbase):"memory");}
__device__ __forceinline__ float max3f(float a,float b,float c){float r;asm("v_max3_f32 %0, %1, %2, %3":"=v"(r):"v"(a),"v"(b),"v"(c));return r;}
__device__ __forceinline__ float max2f(float a,float b){float r;asm("v_max_f32_e32 %0, %1, %2":"=v"(r):"v"(a),"v"(b));return r;}
__device__ __forceinline__ float fadd_s(float a,float b){float r;asm("v_add_f32_e32 %0, %1, %2":"=v"(r):"v"(a),"v"(b));return r;}
__device__ __forceinline__ float fsub_s(float a,float b){float r;asm("v_sub_f32_e32 %0, %1, %2":"=v"(r):"v"(a),"v"(b));return r;}
typedef float f32x2_t __attribute__((ext_vector_type(2))); typedef __bf16 bf16x2_t __attribute__((ext_vector_type(2)));
__device__ __forceinline__ unsigned cvtpk_s(float lo,float hi){f32x2_t v={lo,hi};bf16x2_t b=__builtin_convertvector(v,bf16x2_t);return __builtin_bit_cast(unsigned,b);}
#define WAIT_BAR(N) asm volatile("s_waitcnt vmcnt(" #N ") lgkmcnt(0)\n\ts_barrier":::"memory")

__device__ __forceinline__ void qkt(f32x16&p0,f32x16&p1,const char*Kslot,const bf16x8*qr,const f32x16&negm,int r32,int hi){
  const char*kb=Kslot+hi*1024+r32*16;
  #pragma unroll
  for(int d0=0;d0<4;++d0){
    const bf16x8 b0=*reinterpret_cast<const bf16x8*>(kb+d0*2048);
    const bf16x8 b1=*reinterpret_cast<const bf16x8*>(kb+d0*2048+512);
    if(d0==0){p0=__builtin_amdgcn_mfma_f32_32x32x16_bf16(b0,qr[0],negm,0,0,0);p1=__builtin_amdgcn_mfma_f32_32x32x16_bf16(b1,qr[0],negm,0,0,0);}
    else{p0=__builtin_amdgcn_mfma_f32_32x32x16_bf16(b0,qr[d0],p0,0,0,0);p1=__builtin_amdgcn_mfma_f32_32x32x16_bf16(b1,qr[d0],p1,0,0,0);}}
}
__device__ __forceinline__ void qkt_acc(f32x16&p0,f32x16&p1,const char*Kslot,const bf16x8*qr,int r32,int hi){
  const char*kb=Kslot+hi*1024+r32*16;
  #pragma unroll
  for(int d0=0;d0<4;++d0){
    const bf16x8 b0=*reinterpret_cast<const bf16x8*>(kb+d0*2048);
    const bf16x8 b1=*reinterpret_cast<const bf16x8*>(kb+d0*2048+512);
    p0=__builtin_amdgcn_mfma_f32_32x32x16_bf16(b0,qr[d0],p0,0,0,0);p1=__builtin_amdgcn_mfma_f32_32x32x16_bf16(b1,qr[d0],p1,0,0,0);}
}
typedef __attribute__((address_space(3))) const float* lds_fptr;
__device__ __forceinline__ void bias4(f32x16&p,lds_fptr fb,int g){ const f32x4v v=*(const __attribute__((address_space(3))) f32x4v*)(fb+8*g); p[4*g]=v[0];p[4*g+1]=v[1];p[4*g+2]=v[2];p[4*g+3]=v[3]; }
__device__ __forceinline__ void sub4(f32x16&p,int g,float mh){ p[4*g]-=mh;p[4*g+1]-=mh;p[4*g+2]-=mh;p[4*g+3]-=mh; }
typedef __attribute__((address_space(3))) const char* lds_cptr;
typedef short v4i16_t __attribute__((ext_vector_type(4)));
__device__ __forceinline__ void kload8(bf16x8*kf,lds_cptr kp){
  kf[0]=*(const __attribute__((address_space(3))) bf16x8*)(kp);      kf[1]=*(const __attribute__((address_space(3))) bf16x8*)(kp+512);
  kf[2]=*(const __attribute__((address_space(3))) bf16x8*)(kp+2048); kf[3]=*(const __attribute__((address_space(3))) bf16x8*)(kp+2560);
  kf[4]=*(const __attribute__((address_space(3))) bf16x8*)(kp+4096); kf[5]=*(const __attribute__((address_space(3))) bf16x8*)(kp+4608);
  kf[6]=*(const __attribute__((address_space(3))) bf16x8*)(kp+6144); kf[7]=*(const __attribute__((address_space(3))) bf16x8*)(kp+6656);
}
__device__ __forceinline__ void kload2(bf16x8*kf,lds_cptr kp,int j){ kf[2*j]=*(const __attribute__((address_space(3))) bf16x8*)(kp+j*2048); kf[2*j+1]=*(const __attribute__((address_space(3))) bf16x8*)(kp+j*2048+512); }
__device__ __forceinline__ s16x4 vtr(lds_cptr p){ return __builtin_bit_cast(s16x4,__builtin_amdgcn_ds_read_tr16_b64_v4i16((__attribute__((address_space(3))) v4i16_t*)p)); }
__device__ __forceinline__ float rowmax(const f32x16&p0,const f32x16&p1){
  float a=max3f(p0[0],p0[1],p1[0]),b=max3f(p0[2],p0[3],p1[1]);a=max3f(a,p1[2],p1[3]);
  #pragma unroll
  for(int r=4;r<16;r+=4){a=max3f(a,p0[r],p0[r+1]);b=max3f(b,p0[r+2],p0[r+3]);a=max3f(a,p1[r],p1[r+1]);b=max3f(b,p1[r+2],p1[r+3]);}
  const float m=max2f(a,b);
  auto rr=__builtin_amdgcn_permlane32_swap(__float_as_uint(m),__float_as_uint(m),false,false);
  return max2f(__uint_as_float(rr[0]),__uint_as_float(rr[1]));
}
template<int ND> __device__ __forceinline__ void pv(f32x16*o,int vb,bf16x8 pa0,bf16x8 pa1,bf16x8 pa2,bf16x8 pa3){
  #pragma unroll
  for(int d0=0;d0<ND;++d0){s16x4 lo[4],hi[4];
    #pragma unroll
    for(int ks=0;ks<4;++ks){
      asm volatile("ds_read_b64_tr_b16 %0,%1 offset:%c2":"=&v"(lo[ks]):"v"(vb),"i"(d0*4096+ks*1024):"memory");
      asm volatile("ds_read_b64_tr_b16 %0,%1 offset:%c2":"=&v"(hi[ks]):"v"(vb),"i"(d0*4096+ks*1024+512):"memory");}
    asm volatile("s_waitcnt lgkmcnt(0)":::"memory");SBAR();
    #define PK(k) (bf16x8){lo[k][0],lo[k][1],lo[k][2],lo[k][3],hi[k][0],hi[k][1],hi[k][2],hi[k][3]}
    o[d0]=__builtin_amdgcn_mfma_f32_32x32x16_bf16(pa0,PK(0),o[d0],0,0,0);
    o[d0]=__builtin_amdgcn_mfma_f32_32x32x16_bf16(pa1,PK(1),o[d0],0,0,0);
    o[d0]=__builtin_amdgcn_mfma_f32_32x32x16_bf16(pa2,PK(2),o[d0],0,0,0);
    o[d0]=__builtin_amdgcn_mfma_f32_32x32x16_bf16(pa3,PK(3),o[d0],0,0,0);
    #undef PK
  }
}

#ifndef ATTN_STORE16
#define ATTN_STORE16(p,v) (*(u32x4*)(p)=(v))
#endif
template<int THRL,int MODE,class Epi,bool UREF=false> __device__ __forceinline__ void attn_unit(int qb,int t0,const bf16*Q,const bf16*__restrict__ K,const bf16*__restrict__ V,char*shm,const Epi&epi){
  const int tid=tid_fresh(),lane=tid&63,r32=lane&31,hi=lane>>5; const int wid=__builtin_amdgcn_readfirstlane(tid>>6);
  constexpr int VM=(MODE==1)?2:1, ND=(MODE==1)?4:2;
  const int q0=qb*QB;
  const bf16*Qw=Q+(long)(q0+wid*QBLK)*QP;
  const bf16*Kh=K+(long)t0*KVBLK*QP,*Vh=V+(long)t0*KVBLK*QP;
  const unsigned lds0=(unsigned)(uintptr_t)shm;
  float*wsf=(float*)(shm+LDS_WS)+wid*64;
  const unsigned koff=(unsigned)((lane*QP+wid*8)*2), voff=(unsigned)(((16*(wid&3)+(lane>>2))*QP+(wid>>2)*32+(lane&3)*8)*2);
  const unsigned kdst=lds0+LDS_K+wid*1024, vdst=lds0+LDS_V+wid*1024;
  #define DMA_K(t,slot) glds16s(Kh+(long)(t)*KVBLK*QP,koff,(unsigned)__builtin_amdgcn_readfirstlane(kdst+(slot)))
  #define DMA_V(t,slot) do{ glds16s(Vh+(long)(t)*KVBLK*QP,voff,(unsigned)__builtin_amdgcn_readfirstlane(vdst+VM*(slot))); if constexpr(MODE==1) glds16s(Vh+64+(long)(t)*KVBLK*QP,voff,(unsigned)__builtin_amdgcn_readfirstlane(vdst+VM*(slot)+8192)); }while(0)
  const int vb0=(int)(lds0+LDS_V)+((lane>>4)&1)*32+(lane&3)*8+(4*hi+((lane&15)>>2))*64;
  const char*Kbase=shm+LDS_K; bf16x8 kf[8];
  const lds_cptr shm3=(lds_cptr)shm; const lds_fptr fb0=(lds_fptr)(shm3+LDS_FB)+4*hi; const lds_cptr kp0=shm3+LDS_K+hi*1024+r32*16; const lds_cptr vp0=shm3+LDS_V+((lane>>4)&1)*32+(lane&3)*8+(4*hi+((lane&15)>>2))*64;
  const int NT=(q0+QB)/KVBLK-t0;
  DMA_K(0,0);DMA_V(0,0);DMA_K(1,SLOTB);
  bf16x8 qr[4];
  #pragma unroll
  for(int d0=0;d0<4;++d0)qr[d0]=*reinterpret_cast<const bf16x8*>(&Qw[(long)r32*QP+d0*16+hi*8]);
  const f32x16 zero16=f32x16{}; float mhat=0.f,l_reg=0.f;f32x16 o[ND];
  #pragma unroll
  for(int d_=0;d_<ND;++d_)o[d_]=f32x16{};
  const int qrel=wid*QBLK+r32;
  #define CMASK(P0,P1,t) do{int jb_=(t)-(NT-4); if(jb_>=0){ if constexpr(MODE==0)cmask(P0,P1,jb_,qrel,hi); else chmask(P0,P1,jb_,wid);} }while(0)
  bool resc=false;
  #define START(P0,P1) do{ resc=false; \
    _Pragma("unroll") for(int r=0;r<16;++r)P0[r]=__builtin_amdgcn_exp2f(P0[r]); }while(0)
  #define RESC() do{ if(resc){ asm volatile("s_waitcnt lgkmcnt(0)":::"memory"); \
      _Pragma("unroll") for(int d_=0;d_<ND;++d_) _Pragma("unroll") for(int r=0;r<16;++r)o[d_][r]*=wsf[crow(r,hi)]; } }while(0)
  f32x16 pA0,pA1,pB0,pB1;
  int sl_prev=0,sl_cur=0,sl_next=SLOTB;
  #define ROT() do{sl_prev=sl_cur;sl_cur=sl_next;sl_next=(sl_next==(NSLOT-1)*SLOTB)?0:sl_next+SLOTB;}while(0)
  DMA_K(2,2*SLOTB);
  #define WB(n0,n1) do{ if constexpr(MODE==1){WAIT_BAR(n1);} else {WAIT_BAR(n0);} }while(0)
  WB(3,4);
  if constexpr(MODE==0){ if constexpr(!UREF) mhat=((lds_fptr)(shm3+LDS_FB))[q0-t0*KVBLK+wid*QBLK+r32]+8.0f;
    _Pragma("unroll") for(int g=0;g<4;++g){bias4(pA0,fb0,g);if constexpr(!UREF)sub4(pA0,g,mhat);bias4(pA1,fb0+32,g);if constexpr(!UREF)sub4(pA1,g,mhat);} }
  else { pA0=f32x16{}; pA1=f32x16{}; }
  qkt_acc(pA0,pA1,Kbase,qr,r32,hi);
  asm volatile("s_nop 15\n\ts_nop 7":"+v"(pA0),"+v"(pA1));CMASK(pA0,pA1,0);
  START(pA0,pA1);
  if constexpr(MODE==0){ _Pragma("unroll") for(int g=0;g<4;++g){bias4(pB0,fb0+64,g);if constexpr(!UREF)sub4(pB0,g,mhat);bias4(pB1,fb0+96,g);if constexpr(!UREF)sub4(pB1,g,mhat);} }

  _Pragma("unroll") for(int r=0;r<16;++r)pA1[r]=__builtin_amdgcn_exp2f(pA1[r]);
  WAIT_BAR(0);
  DMA_K(3,0);DMA_V(1,SLOTB);
  ROT();
  kload8(kf,kp0+sl_cur);
  WB(2,3);
  s16x4 vlo[8],vhi[8]; u32x4 pw0,pw1,pw2,pw3;
  #define PKW(P,B) cvtpk_s(P[B],P[B+1])
  #define PAF(k) __builtin_bit_cast(bf16x8,pw##k)
  #define VFR(i) (bf16x8){vlo[i][0],vlo[i][1],vlo[i][2],vlo[i][3],vhi[i][0],vhi[i][1],vhi[i][2],vhi[i][3]}
  #define PIN(x) asm volatile("":"+v"(x))
  #define MX3(a,b,c) __builtin_fmaxf(__builtin_fmaxf((a),(b)),(c))
  #define GAPA(MF,A0,A1,A2,A3,W0,W1,PW) do{ MF; sacc+=A0; sacc+=A1; sacc+=A2; sacc+=A3; PIN(sacc); W0; W1; PIN(PW); SBAR(); }while(0)
  #define EX(v) __builtin_amdgcn_exp2f(v)
  #define GAPB(MF,X,B) do{ MF; X[B]=EX(X[B]); X[B+1]=EX(X[B+1]); X[B+2]=EX(X[B+2]); X[B+3]=EX(X[B+3]); PIN(X); SBAR(); }while(0)
  #define VRD(i) do{ vlo[i]=vtr(vp_+(((i)>>2)*4096+((i)&3)*1024)); vhi[i]=vtr(vp_+(((i)>>2)*4096+((i)&3)*1024+512)); }while(0)
  #define KRD(G,j) do{ if(G){ kload2(kf,kp0+sl_next,j); SBAR(); } }while(0)
  #define CIN(X) (MODE==1?zero16:X)
  #define GAPB2(MF,RD,X,B) do{ MF; RD; X[B]=EX(X[B]); X[B+1]=EX(X[B+1]); PIN(X); SBAR(); }while(0)
  #define VF(k) do{ vlo[(k)&3]=vtr(vp_+(((k)>>3)*8192+((k)&1)*4096+(((k)&7)>>1)*1024)); vhi[(k)&3]=vtr(vp_+(((k)>>3)*8192+((k)&1)*4096+(((k)&7)>>1)*1024+512)); }while(0)
  #define VRDA(i) do{ if constexpr(MODE==0){ VRD(i); } else { if((i)==2){VF(0);} else if((i)==6){VF(1);} else if((i)==3){VF(2);} else if((i)==7){VF(3);} } }while(0)
  #define VFQ(q) (bf16x8){vlo[q][0],vlo[q][1],vlo[q][2],vlo[q][3],vhi[q][0],vhi[q][1],vhi[q][2],vhi[q][3]}
  #define PFM(G,P,g) do{ (void)nm_; }while(0)
  #define PFR(G,P,i,t) do{ if constexpr(MODE==0){ if(G){ bias4(P,fb0+64*((t)+1)+32*((i)>>2),(i)&3); } } }while(0)
  #define PFS(G,P,i) do{ if constexpr(MODE==0&&!UREF){ if(G){ sub4(P,(i)&3,mhat); PIN(P); } } }while(0)
  #define STEP(C0,C1,P0,P1,t,GK,GV,GL) do{ SBAR(); \
    const lds_cptr vp_=vp0+VM*sl_prev; \
    VRDA(0); SBAR(); float sacc=(P0[0]+P0[1]); \
    GAPA(C0=__builtin_amdgcn_mfma_f32_32x32x16_bf16(kf[0],qr[0],CIN(C0),0,0,0), P0[2],P0[3],P0[4],P0[5],     pw0[0]=PKW(P0,0), pw0[1]=PKW(P0,2), pw0); \
    VRDA(4); SBAR(); GAPA(C1=__builtin_amdgcn_mfma_f32_32x32x16_bf16(kf[1],qr[0],CIN(C1),0,0,0), P0[6],P0[7],P0[8],P0[9],     pw0[2]=PKW(P0,4), pw0[3]=PKW(P0,6), pw0); \
    PFR(GL,P0,0,t); VRDA(1); SBAR(); GAPA(C0=__builtin_amdgcn_mfma_f32_32x32x16_bf16(kf[2],qr[1],C0,0,0,0),   P0[10],P0[11],P0[12],P0[13], pw1[0]=PKW(P0,8), pw1[1]=PKW(P0,10), pw1); \
    PFR(GL,P0,1,t); VRDA(5); SBAR(); GAPA(C1=__builtin_amdgcn_mfma_f32_32x32x16_bf16(kf[3],qr[1],C1,0,0,0),   P0[14],P0[15],P1[0],P1[1],   pw1[2]=PKW(P0,12),pw1[3]=PKW(P0,14), pw1); \
    PFR(GL,P0,2,t); VRDA(2); SBAR(); GAPA(C0=__builtin_amdgcn_mfma_f32_32x32x16_bf16(kf[4],qr[2],C0,0,0,0),   P1[2],P1[3],P1[4],P1[5],     pw2[0]=PKW(P1,0), pw2[1]=PKW(P1,2), pw2); \
    PFR(GL,P0,3,t); VRDA(6); SBAR(); GAPA(C1=__builtin_amdgcn_mfma_f32_32x32x16_bf16(kf[5],qr[2],C1,0,0,0),   P1[6],P1[7],P1[8],P1[9],     pw2[2]=PKW(P1,4), pw2[3]=PKW(P1,6), pw2); \
    PFR(GL,P1,4,t); VRDA(3); SBAR(); GAPA(C0=__builtin_amdgcn_mfma_f32_32x32x16_bf16(kf[6],qr[3],C0,0,0,0),   P1[10],P1[11],P1[12],P1[13], pw3[0]=PKW(P1,8), pw3[1]=PKW(P1,10), pw3); \
    PFR(GL,P1,5,t); VRDA(7); SBAR(); GAPA(C1=__builtin_amdgcn_mfma_f32_32x32x16_bf16(kf[7],qr[3],C1,0,0,0),   P1[14],P1[15],0.f,0.f,       pw3[2]=PKW(P1,12),pw3[3]=PKW(P1,14), pw3); \
    l_reg+=sacc; \
    if(GK){DMA_K((t)+3,sl_cur);} if(GV){DMA_V((t)+1,sl_next);} \
    CMASK(C0,C1,t); \
    resc=false; \
    if constexpr(false)   \
    { float a=MX3(C0[0],C0[1],C1[0]),b=MX3(C0[2],C0[3],C1[1]); a=MX3(a,C1[2],C1[3]); \
      _Pragma("unroll") for(int r=4;r<16;r+=4){a=MX3(a,C0[r],C0[r+1]);b=MX3(b,C0[r+2],C0[r+3]);a=MX3(a,C1[r],C1[r+1]);b=MX3(b,C1[r+2],C1[r+3]);} \
      float rm=__builtin_fmaxf(a,b); { auto rr=__builtin_amdgcn_permlane32_swap(__float_as_uint(rm),__float_as_uint(rm),false,false); rm=__builtin_fmaxf(__uint_as_float(rr[0]),__uint_as_float(rr[1])); } \
      resc=false; \
      if(__builtin_expect(__any(rm>(float)THRL),0)){ const float dl=__builtin_fmaxf(rm,0.f); mhat+=dl; \
        _Pragma("unroll") for(int r=0;r<16;++r){C0[r]-=dl;C1[r]-=dl;} \
        const float f=__builtin_amdgcn_exp2f(-dl); l_reg*=f; if(hi==0)wsf[r32]=f; resc=true; } } \
    SBAR(); \
    if constexpr(MODE==0){ \
    PFR(GL,P1,6,t); PFS(GL,P0,0); PFS(GL,P0,1); GAPB(o[0]=__builtin_amdgcn_mfma_f32_32x32x16_bf16(PAF(0),VFR(0),o[0],0,0,0), C0,0); \
    PFR(GL,P1,7,t); PFS(GL,P0,2); PFS(GL,P0,3); GAPB(o[1]=__builtin_amdgcn_mfma_f32_32x32x16_bf16(PAF(0),VFR(4),o[1],0,0,0), C0,4); \
    PFS(GL,P1,4); KRD(GL,0); GAPB(o[0]=__builtin_amdgcn_mfma_f32_32x32x16_bf16(PAF(1),VFR(1),o[0],0,0,0), C0,8); \
    PFS(GL,P1,5); KRD(GL,1); GAPB(o[1]=__builtin_amdgcn_mfma_f32_32x32x16_bf16(PAF(1),VFR(5),o[1],0,0,0), C0,12); \
    PFS(GL,P1,6); KRD(GL,2); GAPB(o[0]=__builtin_amdgcn_mfma_f32_32x32x16_bf16(PAF(2),VFR(2),o[0],0,0,0), C1,0); \
    PFS(GL,P1,7); KRD(GL,3); GAPB(o[1]=__builtin_amdgcn_mfma_f32_32x32x16_bf16(PAF(2),VFR(6),o[1],0,0,0), C1,4); \
    GAPB(o[0]=__builtin_amdgcn_mfma_f32_32x32x16_bf16(PAF(3),VFR(3),o[0],0,0,0), C1,8); \
    GAPB(o[1]=__builtin_amdgcn_mfma_f32_32x32x16_bf16(PAF(3),VFR(7),o[1],0,0,0), C1,12); \
    } else { \
    const float nm_=-mhat; \
    GAPB2(o[0]=__builtin_amdgcn_mfma_f32_32x32x16_bf16(PAF(0),VFQ(0),o[0],0,0,0), VF(4), C0,0); \
    GAPB2(o[1]=__builtin_amdgcn_mfma_f32_32x32x16_bf16(PAF(0),VFQ(1),o[1],0,0,0), VF(5), C0,2); \
    KRD(GL,0); GAPB2(o[0]=__builtin_amdgcn_mfma_f32_32x32x16_bf16(PAF(1),VFQ(2),o[0],0,0,0), VF(6), C0,4); \
    KRD(GL,1); GAPB2(o[1]=__builtin_amdgcn_mfma_f32_32x32x16_bf16(PAF(1),VFQ(3),o[1],0,0,0), VF(7), C0,6); \
    KRD(GL,2); GAPB2(o[0]=__builtin_amdgcn_mfma_f32_32x32x16_bf16(PAF(2),VFQ(0),o[0],0,0,0), VF(8), C0,8); \
    KRD(GL,3); GAPB2(o[1]=__builtin_amdgcn_mfma_f32_32x32x16_bf16(PAF(2),VFQ(1),o[1],0,0,0), VF(9), C0,10); \
    GAPB2(o[0]=__builtin_amdgcn_mfma_f32_32x32x16_bf16(PAF(3),VFQ(2),o[0],0,0,0), VF(10), C0,12); \
    GAPB2(o[1]=__builtin_amdgcn_mfma_f32_32x32x16_bf16(PAF(3),VFQ(3),o[1],0,0,0), VF(11), C0,14); \
    GAPB2(o[2]=__builtin_amdgcn_mfma_f32_32x32x16_bf16(PAF(0),VFQ(0),o[2],0,0,0), VF(12); PFM(GL,P0,0), C1,0); \
    GAPB2(o[3]=__builtin_amdgcn_mfma_f32_32x32x16_bf16(PAF(0),VFQ(1),o[3],0,0,0), VF(13); PFM(GL,P0,1), C1,2); \
    GAPB2(o[2]=__builtin_amdgcn_mfma_f32_32x32x16_bf16(PAF(1),VFQ(2),o[2],0,0,0), VF(14); PFM(GL,P0,2), C1,4); \
    GAPB2(o[3]=__builtin_amdgcn_mfma_f32_32x32x16_bf16(PAF(1),VFQ(3),o[3],0,0,0), VF(15); PFM(GL,P0,3), C1,6); \
    GAPB2(o[2]=__builtin_amdgcn_mfma_f32_32x32x16_bf16(PAF(2),VFQ(0),o[2],0,0,0), (void)0; PFM(GL,P1,0), C1,8); \
    GAPB2(o[3]=__builtin_amdgcn_mfma_f32_32x32x16_bf16(PAF(2),VFQ(1),o[3],0,0,0), (void)0; PFM(GL,P1,1), C1,10); \
    GAPB2(o[2]=__builtin_amdgcn_mfma_f32_32x32x16_bf16(PAF(3),VFQ(2),o[2],0,0,0), (void)0; PFM(GL,P1,2), C1,12); \
    GAPB2(o[3]=__builtin_amdgcn_mfma_f32_32x32x16_bf16(PAF(3),VFQ(3),o[3],0,0,0), (void)0; PFM(GL,P1,3), C1,14); \
    } \
    }while(0)
  int t=1;
  #undef CMASK
  #define CMASK(P0,P1,t) do{}while(0)
  for(;t+5<NT;t+=2){
    STEP(pB0,pB1,pA0,pA1,t,true,true,true);     WB(2,3); RESC(); ROT();
    STEP(pA0,pA1,pB0,pB1,t+1,true,true,true);   WB(2,3); RESC(); ROT();
  }
  #undef CMASK
  #define CMASK(P0,P1,t) do{int jb_=(t)-(NT-4); if(jb_>=0){ if constexpr(MODE==0)cmask(P0,P1,jb_,qrel,hi); else chmask(P0,P1,jb_,wid);} }while(0)
  #define ENDW(tt) do{ if((tt)+3<NT){WB(2,3);} else if((tt)+2<NT){WB(1,2);} else {WAIT_BAR(0);} }while(0)
  for(;t+1<NT;t+=2){
    STEP(pB0,pB1,pA0,pA1,t,(t+3<NT),(t+1<NT),(t+1<NT));       ENDW(t);   RESC(); ROT();
    STEP(pA0,pA1,pB0,pB1,t+1,(t+4<NT),(t+2<NT),(t+2<NT));     ENDW(t+1); RESC(); ROT();
  }
  STEP(pB0,pB1,pA0,pA1,NT-1,false,false,false); RESC();
  { float sacc=pB0[0]+pB0[1]; _Pragma("unroll") for(int r=2;r<16;++r)sacc+=pB0[r]; _Pragma("unroll") for(int r=0;r<16;++r)sacc+=pB1[r]; l_reg+=sacc;
    pw0=(u32x4){PKW(pB0,0),PKW(pB0,2),PKW(pB0,4),PKW(pB0,6)};pw1=(u32x4){PKW(pB0,8),PKW(pB0,10),PKW(pB0,12),PKW(pB0,14)};pw2=(u32x4){PKW(pB1,0),PKW(pB1,2),PKW(pB1,4),PKW(pB1,6)};pw3=(u32x4){PKW(pB1,8),PKW(pB1,10),PKW(pB1,12),PKW(pB1,14)};
    SBAR(); pv<ND>(o,vb0+VM*sl_cur,PAF(0),PAF(1),PAF(2),PAF(3)); }
  #undef PKW
  #undef PAF
  #undef VFR
  #undef PIN
  #undef MX3
  #undef GAPA
  #undef GAPB
  #undef EX
  #undef VRD
  #undef KRD
  #undef STEP
  #undef CIN
  #undef PFR
  #undef PFS
  #undef GAPB2
  #undef VF
  #undef VRDA
  #undef VFQ
  #undef PFM
  #undef WB
  #undef ENDW
  {auto rr=__builtin_amdgcn_permlane32_swap(__float_as_uint(l_reg),__float_as_uint(l_reg),false,false);l_reg=__uint_as_float(rr[0])+__uint_as_float(rr[1]);}
  if(hi==0)wsf[32+r32]=l_reg;asm volatile("s_waitcnt lgkmcnt(0)":::"memory");
  float rli[16];
  #pragma unroll
  for(int r=0;r<16;++r)rli[r]=__builtin_amdgcn_rcpf(wsf[32+crow(r,hi)]);
  epi(o,rli,shm,q0,wid,lane,r32,hi);
  asm volatile("s_waitcnt lgkmcnt(0)\n\ts_barrier":::"memory");
  #undef DMA_K
  #undef DMA_V
  #undef CMASK
  #undef START
  #undef RESC
  #undef ROT
}

typedef unsigned u32x2q __attribute__((ext_vector_type(2)));
__device__ __forceinline__ unsigned q4i8(float a,float b,float c,float d){ unsigned w=__builtin_amdgcn_cvt_pk_u8_f32((a+128.f),0,0u); w=__builtin_amdgcn_cvt_pk_u8_f32((b+128.f),1,w); w=__builtin_amdgcn_cvt_pk_u8_f32((c+128.f),2,w); w=__builtin_amdgcn_cvt_pk_u8_f32((d+128.f),3,w); return w^0x80808080u; }
constexpr float QMIX=127.f/4.f;
constexpr float DQV=1.f/(Q8_ACT*Q8_W);
struct EpiFox {
  bf16*O;
  __device__ __forceinline__ void operator()(const f32x16(&o)[2],const float(&rli)[16],char*shm,int q0,int wid,int lane,int r32,int hi)const{
    signed char*Ow=(signed char*)O+(long)(q0+wid*QBLK)*OP; signed char*stg=(signed char*)(shm+LDS_OST)+wid*2048;
    #pragma unroll
    for(int r=0;r<16;++r){const int orow=crow(r,hi);
      #pragma unroll
      for(int d0=0;d0<2;++d0)stg[orow*64+d0*32+r32]=(signed char)__float2int_rn(fminf(fmaxf(o[d0][r]*rli[r]*(QMIX*DQV),-127.f),127.f));}
    asm volatile("s_waitcnt lgkmcnt(0)":::"memory");
    #pragma unroll
    for(int i=0;i<4;++i){const int row=i*8+(lane>>3),ch=lane&7; const u32x2q v=*(const u32x2q*)(stg+row*64+ch*8); *(u32x2q*)(Ow+(long)row*OP+ch*8)=v;} }
};
struct EpiDiff {
  bf16*O; const float*gsub; float lam; int map;
  __device__ __forceinline__ void operator()(const f32x16(&o)[4],const float(&rli)[16],char*shm,int q0,int wid,int lane,int r32,int hi)const{
    bf16*Y=(bf16*)(shm+LDS_Y)+wid*4096;
    if(map==0){
      #pragma unroll
      for(int r=0;r<16;++r){const int orow=crow(r,hi);
        #pragma unroll
        for(int d0=0;d0<4;++d0)Y[orow*128+d0*32+r32]=__float2bfloat16(o[d0][r]*rli[r]);}
    } else {
      #pragma unroll
      for(int r=0;r<16;++r){const int orow=crow(r,hi);
        #pragma unroll
        for(int d0=0;d0<4;++d0){const int idx=orow*128+d0*32+r32; Y[idx]=__float2bfloat16(__bfloat162float(Y[idx])-lam*(o[d0][r]*rli[r]));}}
      asm volatile("s_waitcnt lgkmcnt(0)":::"memory");
      signed char*Ow=(signed char*)O+(long)(q0+wid*QBLK)*OP;
      #pragma unroll
      for(int i=0;i<8;++i){const int row=i*4+(lane>>4),ch=lane&15; const u32x4 v=*(const u32x4*)(Y+row*128+ch*8);
        float f[8];
        #pragma unroll
        for(int e=0;e<4;++e){f[2*e]=__builtin_bit_cast(float,v[e]<<16);f[2*e+1]=__builtin_bit_cast(float,v[e]&0xffff0000u);}
        float ss=0.f;
        #pragma unroll
        for(int e=0;e<8;++e)ss+=f[e]*f[e];
        ss+=__shfl_xor(ss,1);ss+=__shfl_xor(ss,2);ss+=__shfl_xor(ss,4);ss+=__shfl_xor(ss,8);
        const float rinv=rsqrtf(ss*(DQV*DQV/128.f)+1e-6f)*(0.8f*DQV);
        const f32x4v g0=*(const f32x4v*)(gsub+ch*8),g1=*(const f32x4v*)(gsub+ch*8+4);
        const float rq=rinv*QMIX; u32x2q w; w[0]=q4i8(f[0]*rq*g0[0],f[1]*rq*g0[1],f[2]*rq*g0[2],f[3]*rq*g0[3]); w[1]=q4i8(f[4]*rq*g1[0],f[5]*rq*g1[1],f[6]*rq*g1[2],f[7]*rq*g1[3]);
        *(u32x2q*)(Ow+(long)row*OP+ch*8)=w; }
    }
  }
};
#undef SBAR
#undef WAIT_BAR
}

__device__ __forceinline__ void attn_phase(const P& p, char* lds, int c, int G) {
    using attn_body::QP; using attn_body::OP; using attn_body::LDS_FB; using attn_body::EpiDiff; using attn_body::EpiFox; using attn_body::attn_unit;
    const int tid = tid_fresh(), lane = tid & 63;
    const int vcu = (G % 8 == 0) ? (c % 8) * (G / 8) + c / 8 : c;
    const attn_body::bf16* QKV = (const attn_body::bf16*)(p.ws + WS_R); attn_body::bf16* MIX = (attn_body::bf16*)(p.ws + WS_H);
    const float lam = ((const float*)(p.ws + WS_SCAL))[0];
    const float* FB = (const float*)(p.ws + WS_F);
    for (int item = vcu; item < 256; item += G) {
        const int bh = item >> 3, s = item & 7, b = bh >> 2, h = bh & 3;
        const attn_body::bf16* base = QKV + (size_t)b * SEQ * QP;
        for (int qi = 0; qi < 2; ++qi) { const int qb = qi ? s : 15 - s;
            for (int map = 0; map < 2; ++map) {
                const EpiDiff E{(attn_body::bf16*)((signed char*)MIX + (size_t)b * SEQ * OP + h * 128), p.g_subln, lam, map};
                attn_unit<8, 1>(qb, 0, base + (2 * h + map) * 64, base + 512 + (2 * h + map) * 64, base + 1024 + h * 128, lds, E);
                if (qi == 0) { const int nr = (CV_ITEMS - CV_IN + G * 8 - 1) / (G * 8), hr = (nr + 1) / 2;
                    convert_items(p, (unsigned char*)lds, c, G, CV_IN, CV_ITEMS, map ? hr : 0, map ? nr : hr); } } }
    }
    {
        unsigned* ctl = (unsigned*)(p.ws + WS_CTL); volatile int* ubox = (volatile int*)(lds + LDS_FB + 16384);
        const int nb_q = (G % 8 == 0) ? 1 : 8;
        for (int bi = 0; bi < nb_q; ++bi) { const int b = (G % 8 == 0) ? (c % 8) : bi;
            for (;;) {
                if (tid == 0) *ubox = (int)atomicAdd(ctl + CW_FOXQ + 64 * b, 1u);
                __syncthreads();
                const int u = __builtin_amdgcn_readfirstlane(*ubox);
                __syncthreads();
                if (u >= 128) break;
                const int qb = 15 - (u >> 3), h = u & 7;
                const float* Fg = FB + (size_t)(b * 8 + h) * SEQ;
                const int nkf = (qb + 1) * 256; float fv[8];
#pragma unroll
                for (int k = 0; k < 8; ++k) { const int i = tid + 512 * k; fv[k] = Fg[i < nkf ? i : 0]; }
                const float fend = Fg[256 * qb + 255], fbeg = Fg[256 * qb];
                const unsigned* nq2 = ctl + CW_QB + ((b * 8 + h) * 16 + qb) * 2; const unsigned* nk2 = ctl + CW_KT + ((b * 8 + h) * 64 + lane) * 2;
                const float qn = sqrtf(__uint_as_float(nq2[0]) + __uint_as_float(nq2[1])), kn = sqrtf(__uint_as_float(nk2[0]) + __uint_as_float(nk2[1]));
                const int* sm = (const int*)ctl + CW_SMIN + ((b * 8 + h) * 16 + qb) * 2; const int s0 = sm[0], s1 = sm[1];
                const float sself = __int_as_float(s0 >= 0 ? s0 : s0 ^ 0x7fffffff) + __int_as_float(s1 >= 0 ? s1 : s1 ^ 0x7fffffff);
                const float bound = 1.03f * qn * kn - sself;
                float drop = lane < 4 * qb ? 64.f * __builtin_amdgcn_exp2f(bound + (Fg[64 * lane + 63] - Fg[256 * qb])) : 0.f;
#pragma unroll
                for (int o = 1; o < 64; o <<= 1) { const float t = __shfl_up(drop, o); if (lane >= o) drop += t; }
                const bool skip = lane < 4 * qb && drop < 5.9604645e-8f;
                const int t0 = __builtin_amdgcn_readfirstlane(__builtin_popcountll(__ballot(skip)) & ~1);
                const attn_body::bf16* base = QKV + (size_t)b * SEQ * QP;
                float* fb = (float*)(lds + LDS_FB); const int nk = (qb + 1) * 256 - 64 * t0;
                const EpiFox E{(attn_body::bf16*)((signed char*)MIX + (size_t)b * SEQ * OP + 512 + h * 64)};
                const bool uref = __builtin_amdgcn_readfirstlane((int)(fend - fbeg < 64.f)) != 0;
                const float ref = uref ? fend + 8.f : 0.f;
#pragma unroll
                for (int k = 0; k < 8; ++k) { const int i = tid + 512 * k - 64 * t0; if (i >= 0 && i < nk) fb[i] = fv[k] - ref; }
                if (uref) attn_unit<16, 0, EpiFox, true>(qb, t0, base + 1536 + h * 64, base + 2048 + h * 64, base + 2560 + h * 64, lds, E);
                else attn_unit<16, 0, EpiFox, false>(qb, t0, base + 1536 + h * 64, base + 2048 + h * 64, base + 2560 + h * 64, lds, E);
            }
        }
    }
}

#ifndef MK_N_LAUNCHES
#define MK_N_LAUNCHES 1
#endif
constexpr int N_PHASES = 9;
#define REP_PRO 1
#define REP_NORM1 1
#define REP_INPROJ 1
#define REP_ATTN 1
#define REP_OUTPROJ 1
#define REP_MOE1 1
#define REP_MOE2 1
#define REPEAT(n) _Pragma("nounroll") for (int r_ = 0; r_ < (n); ++r_)
struct Args { P p; int ph_lo, ph_hi; };
__global__ void __launch_bounds__(512, 2) mega(Args a) {
    extern __shared__ __attribute__((aligned(16))) unsigned char lds[];
    const P& p = a.p;
    PG8_LAS unsigned char* l3 = (PG8_LAS unsigned char*)lds;
    const int G = (int)gridDim.x, c = (int)blockIdx.x;
    volatile LAS unsigned* MISC = (volatile LAS unsigned*)(l3 + MISC_OFF);
    if (threadIdx.x < 32) MISC[threadIdx.x] = 0u;
    __syncthreads();
    XcdBarrier bar; bar.bar = (unsigned*)(p.ws + WS_CTL) + CW_BAR; bar.x = 0; bar.st = nullptr;
    if (MK_N_LAUNCHES == 1) bar = xcd_barrier_post((unsigned*)(p.ws + WS_CTL) + CW_BAR, MISC + 8);
    const int lo = a.ph_lo, hi = a.ph_hi;
#define IN(k) (lo <= (k) && (k) < hi)
#define SEAM(k) do { if (IN(k) && IN((k) + 1)) xcd_barrier(bar); } while (0)
    if (IN(0)) { REPEAT(REP_PRO) { prologue_phase(p, lds, c, G); __syncthreads(); } }
    if (IN(1)) { REPEAT(REP_NORM1) { norm1_phase(p, lds, c, G); __syncthreads(); } } SEAM(1);
    if (IN(2)) { REPEAT(REP_INPROJ) inproj_phase(p, l3, c, G); } SEAM(2);
    if (IN(3)) { REPEAT(REP_ATTN) attn_phase(p, (char*)lds, c, G); } SEAM(3);
    if (IN(4)) { REPEAT(REP_OUTPROJ) outproj_phase(p, l3, c, G); } SEAM(4);
    if (IN(5)) { router_phase(p, lds, c, G); } SEAM(5);
    if (IN(6)) { moe1_phase(p, l3, c, G); moe2_phase(p, l3, c, G); }
    SEAM(7);
    if (IN(8)) { final_phase(p, c, G); }
#undef IN
#undef SEAM
}
}

extern "C" void kernel_launch(void* const* d_in, const int* in_sizes, int n_in, void* d_out, int out_size, void* d_ws, size_t ws_size, hipStream_t stream) {
    if (n_in != 23 || out_size != T * D || ws_size < WS_END) { fprintf(stderr, "kernel_launch: unexpected shapes (n_in %d, out %d, ws %zu)\n", n_in, out_size, ws_size); return; }
    static int grid = 0;
    if (grid == 0) {
        int dev = 0, cus = 0, per_cu = 0;
        if (hipGetDevice(&dev) != hipSuccess || hipDeviceGetAttribute(&cus, hipDeviceAttributeMultiprocessorCount, dev) != hipSuccess) { fprintf(stderr, "kernel_launch: device query failed\n"); grid = -1; return; }
        if (hipFuncSetAttribute((const void*)mega, hipFuncAttributeMaxDynamicSharedMemorySize, LDS_BYTES) != hipSuccess) { fprintf(stderr, "kernel_launch: hipFuncSetAttribute failed\n"); grid = -1; return; }
        if (hipOccupancyMaxActiveBlocksPerMultiprocessor(&per_cu, (const void*)mega, 512, LDS_BYTES) != hipSuccess || per_cu < 1) fprintf(stderr, "kernel_launch: note: occupancy query reports %d workgroups per CU\n", per_cu);
        (void)hipGetLastError();
        grid = cus;
    }
    if (grid < 0) return;
    (void)hipMemsetAsync((char*)d_ws + WS_CTL, 0, CTL_BYTES, stream);
    Args a{};
    const float** f = (const float**)&a.p;
    for (int i = 0; i < 23; ++i) f[i] = (const float*)d_in[i];
    a.p.out = (float*)d_out; a.p.ws = (unsigned char*)d_ws;
    if (MK_N_LAUNCHES == 1) { a.ph_lo = 0; a.ph_hi = N_PHASES; hipLaunchKernelGGL(mega, dim3(grid), dim3(512), LDS_BYTES, stream, a); }
    else for (int k = 0; k < N_PHASES; ++k) { a.ph_lo = k; a.ph_hi = k + 1; hipLaunchKernelGGL(mega, dim3(grid), dim3(512), LDS_BYTES, stream, a); }
}
```
